# Optimizing an MI355X kernel written in HIP

```python
import math
import jax
import jax.numpy as jnp
from jax import lax
import numpy as np

D_MODEL = 2048
BATCH = 2
SEQ = 4096
DEPTH = 4

N_A_LAYERS = DEPTH // 2
N_B_LAYERS = DEPTH - N_A_LAYERS

SSM_WIDTH = D_MODEL // 2
SSM_GROUP = 16
SSM_GROUPS = SSM_WIDTH // SSM_GROUP
SSM_STATE = 64
DT_MIN = 0.001
DT_MAX = 0.1

N_HEADS = 16
HEAD_DIM = 128
N_KV_HEADS = 4
HEADS_PER_KV = N_HEADS // N_KV_HEADS
ATTN_WIDTH = N_HEADS * HEAD_DIM
KV_WIDTH = N_KV_HEADS * HEAD_DIM
N_BRANCH = 3
CMP_BLOCK = 32
CMP_STRIDE = 16
SEL_BLOCK = 64
N_SELECT = 16
WINDOW = 512
Q_BLOCK = 64
B_IN_WIDTH = ATTN_WIDTH * (1 + N_BRANCH) + N_BRANCH * N_HEADS

LN_EPS = 1e-5
DEEPNORM_ALPHA = (2 * DEPTH) ** 0.25
DEEPNORM_BETA = (8 * DEPTH) ** -0.25
MASK_VALUE = -1e30
FORCE_SCORE = 1e6

kernel_name = "yoco_s5_nsa_deepnorm_trunk"


def layer_norm(x, g, b):
    x32 = x.astype(jnp.float32)
    mu = jnp.mean(x32, axis=-1, keepdims=True)
    var = jnp.mean(jnp.square(x32 - mu), axis=-1, keepdims=True)
    return ((x32 - mu) * lax.rsqrt(var + LN_EPS) * g.astype(jnp.float32) + b.astype(jnp.float32)).astype(x.dtype)


def _complex_linear_combine(e1, e2):
    a1r, a1i, b1r, b1i = e1
    a2r, a2i, b2r, b2i = e2
    return (a2r * a1r - a2i * a1i,
            a2r * a1i + a2i * a1r,
            a2r * b1r - a2i * b1i + b2r,
            a2r * b1i + a2i * b1r + b2i)


def s5_mixer(x, w_in, lam_re, lam_im, log_dt, b_re, b_im, c_re, c_im, d_skip, w_glu, b_glu, w_out):
    bsz, seq, _ = x.shape
    f32 = jnp.float32
    u, z = jnp.split(x @ w_in, 2, axis=-1)
    lr = lam_re.astype(f32)
    li = lam_im.astype(f32)
    dt = jnp.exp(log_dt.astype(f32))[:, None]
    mag = jnp.exp(lr * dt)
    ar = mag * jnp.cos(li * dt)
    ai = mag * jnp.sin(li * dt)
    inv_abs2 = 1.0 / (lr * lr + li * li)
    cr = ((ar - 1.0) * lr + ai * li) * inv_abs2
    ci = (ai * lr - (ar - 1.0) * li) * inv_abs2
    br = b_re.astype(f32)
    bi = b_im.astype(f32)
    bbar_r = cr[..., None] * br - ci[..., None] * bi
    bbar_i = cr[..., None] * bi + ci[..., None] * br
    ug = jnp.swapaxes(u, 0, 1).astype(f32).reshape(seq, bsz, SSM_GROUPS, SSM_GROUP)
    bu_r = jnp.einsum('lbgc,gpc->lbgp', ug, bbar_r)
    bu_i = jnp.einsum('lbgc,gpc->lbgp', ug, bbar_i)
    a_shape = (seq, 1, SSM_GROUPS, SSM_STATE)
    _, _, h_r, h_i = lax.associative_scan(
        _complex_linear_combine,
        (jnp.broadcast_to(ar, a_shape), jnp.broadcast_to(ai, a_shape), bu_r, bu_i),
        axis=0)
    y = (jnp.einsum('gcp,lbgp->lbgc', c_re.astype(f32), h_r)
         - jnp.einsum('gcp,lbgp->lbgc', c_im.astype(f32), h_i))
    y = jnp.swapaxes(y.reshape(seq, bsz, SSM_WIDTH), 0, 1).astype(x.dtype) + d_skip * u
    g = jax.nn.gelu(y)
    y = g * jax.nn.sigmoid(g @ w_glu + b_glu)
    return (y * jax.nn.silu(z)) @ w_out


def shared_kv(h, kv_w, pos_k, w1_k, w2_k, pos_v, w1_v, w2_v):
    bsz, seq, _ = h.shape
    kv = (h @ kv_w).reshape(bsz, seq, 2 * N_BRANCH, N_KV_HEADS, HEAD_DIM)
    k_c, v_c, k_s, v_s, k_w, v_w = [kv[:, :, i] for i in range(2 * N_BRANCH)]
    n_cmp = (seq - CMP_BLOCK) // CMP_STRIDE + 1
    idx = jnp.arange(n_cmp)[:, None] * CMP_STRIDE + jnp.arange(CMP_BLOCK)[None, :]

    def compress(t, pos, w1, w2):
        blk = t[:, idx] + pos[None, None, :, None, :]
        blk = jnp.moveaxis(blk, 3, 2).reshape(bsz, n_cmp, N_KV_HEADS, CMP_BLOCK * HEAD_DIM)
        return jax.nn.gelu(blk @ w1) @ w2

    return (compress(k_c, pos_k, w1_k, w2_k), compress(v_c, pos_v, w1_v, w2_v), k_s, v_s, k_w, v_w)


def masked_softmax(s, valid):
    s = jnp.where(valid, s, MASK_VALUE)
    m = jnp.max(s, axis=-1, keepdims=True)
    e = jnp.where(valid, jnp.exp(s - m), 0.0)
    return e / jnp.maximum(jnp.sum(e, axis=-1, keepdims=True), 1e-30)


def nsa_attention(q, k_cmp, v_cmp, k_slc, v_slc, k_win, v_win):
    bsz, seq = q.shape[:2]
    dtype = q.dtype
    f32 = jnp.float32
    n_q = seq // Q_BLOCK
    n_cmp = k_cmp.shape[1]
    n_sblk = seq // SEL_BLOCK
    n_sel = min(N_SELECT, n_sblk)
    scale = HEAD_DIM ** -0.5
    cmp_start = jnp.arange(n_cmp) * CMP_STRIDE
    cmp_end = cmp_start + CMP_BLOCK - 1
    sel_start = jnp.arange(n_sblk) * SEL_BLOCK
    overlap = ((cmp_start[:, None] < sel_start[None, :] + SEL_BLOCK)
               & (cmp_end[:, None] >= sel_start[None, :])).astype(f32)
    kb_s = k_slc.reshape(bsz, n_sblk, SEL_BLOCK, N_KV_HEADS, HEAD_DIM).transpose(0, 3, 1, 2, 4)
    vb_s = v_slc.reshape(bsz, n_sblk, SEL_BLOCK, N_KV_HEADS, HEAD_DIM).transpose(0, 3, 1, 2, 4)
    k_w_pad = jnp.pad(k_win, ((0, 0), (WINDOW, 0), (0, 0), (0, 0)))
    v_w_pad = jnp.pad(v_win, ((0, 0), (WINDOW, 0), (0, 0), (0, 0)))
    qg = q.reshape(bsz, n_q, Q_BLOCK, N_KV_HEADS, HEADS_PER_KV, HEAD_DIM).transpose(1, 0, 2, 3, 4, 5)
    gather_blocks = jax.vmap(jax.vmap(lambda blocks, ids: blocks[ids]))
    blk_ids = jnp.arange(n_sblk)

    def block_fn(args):
        i, qb = args
        t = i * Q_BLOCK + jnp.arange(Q_BLOCK)
        qb = qb * scale
        s = jnp.einsum('bqghd,bngd->bghqn', qb, k_cmp).astype(f32)
        p_cmp = masked_softmax(s, cmp_end[None, :] <= t[:, None])
        o_cmp = jnp.einsum('bghqn,bngd->bqghd', p_cmp.astype(dtype), v_cmp)
        imp = jnp.einsum('bghqn,nj->bgqj', p_cmp, overlap)
        cur = t // SEL_BLOCK
        future = blk_ids[None, :] > cur[:, None]
        forced = ((blk_ids[None, :] == 0) | (blk_ids[None, :] == cur[:, None])
                  | (blk_ids[None, :] == cur[:, None] - 1))
        imp = jnp.where(future, MASK_VALUE, jnp.where(forced, FORCE_SCORE, imp))
        _, sel = lax.top_k(imp, n_sel)
        ks = gather_blocks(kb_s, sel).reshape(bsz, N_KV_HEADS, Q_BLOCK, n_sel * SEL_BLOCK, HEAD_DIM)
        vs = gather_blocks(vb_s, sel).reshape(bsz, N_KV_HEADS, Q_BLOCK, n_sel * SEL_BLOCK, HEAD_DIM)
        pos = (sel[..., None] * SEL_BLOCK + jnp.arange(SEL_BLOCK)).reshape(bsz, N_KV_HEADS, Q_BLOCK, n_sel * SEL_BLOCK)
        valid = (pos <= t[None, None, :, None])[:, :, None]
        s = jnp.einsum('bqghd,bgqkd->bghqk', qb, ks).astype(f32)
        p = masked_softmax(s, valid)
        o_slc = jnp.einsum('bghqk,bgqkd->bqghd', p.astype(dtype), vs)
        kw = lax.dynamic_slice_in_dim(k_w_pad, i * Q_BLOCK, WINDOW + Q_BLOCK, axis=1)
        vw = lax.dynamic_slice_in_dim(v_w_pad, i * Q_BLOCK, WINDOW + Q_BLOCK, axis=1)
        kpos = i * Q_BLOCK - WINDOW + jnp.arange(WINDOW + Q_BLOCK)
        valid = ((kpos[None, :] <= t[:, None]) & (kpos[None, :] > t[:, None] - WINDOW)
                 & (kpos[None, :] >= 0))
        s = jnp.einsum('bqghd,bkgd->bghqk', qb, kw).astype(f32)
        p = masked_softmax(s, valid)
        o_win = jnp.einsum('bghqk,bkgd->bqghd', p.astype(dtype), vw)
        return o_cmp, o_slc, o_win

    o_cmp, o_slc, o_win = lax.map(block_fn, (jnp.arange(n_q), qg))

    def unblock(o):
        return o.transpose(1, 0, 2, 3, 4, 5).reshape(bsz, seq, N_HEADS, HEAD_DIM)

    return (unblock(o_cmp), unblock(o_slc), unblock(o_win))


def nsa_mixer(x, w_in, w_out, shared):
    bsz, seq, _ = x.shape
    proj = x @ w_in
    q = proj[..., :ATTN_WIDTH].reshape(bsz, seq, N_HEADS, HEAD_DIM)
    z = proj[..., ATTN_WIDTH:ATTN_WIDTH * (1 + N_BRANCH)].reshape(bsz, seq, N_BRANCH, N_HEADS, HEAD_DIM)
    gate = jax.nn.sigmoid(proj[..., ATTN_WIDTH * (1 + N_BRANCH):].reshape(bsz, seq, N_BRANCH, N_HEADS))
    o = jnp.stack(nsa_attention(q, *shared), axis=2)
    y = jnp.sum(gate[..., None] * o * jax.nn.silu(z), axis=2).reshape(bsz, seq, ATTN_WIDTH)
    return y @ w_out


def setup_inputs(seed: int = 0) -> dict:
    key = jax.random.key(seed)
    ks = jax.random.split(key, 24)
    nrm = jax.random.normal
    f32 = jnp.float32
    na, nb = N_A_LAYERS, N_B_LAYERS
    g, p, c, e = SSM_GROUPS, SSM_STATE, SSM_GROUP, SSM_WIDTH
    lam_im0 = math.pi * jnp.arange(p, dtype=f32)
    return {
        "x": nrm(ks[0], (BATCH, SEQ, D_MODEL), f32),
        "a_w_in": nrm(ks[1], (na, D_MODEL, 2 * e), f32) * D_MODEL ** -0.5,
        "a_lam_re": -0.5 + 0.01 * nrm(ks[2], (na, g, p), f32),
        "a_lam_im": lam_im0 + 0.01 * nrm(ks[3], (na, g, p), f32),
        "a_log_dt": jax.random.uniform(ks[4], (na, g), f32, math.log(DT_MIN), math.log(DT_MAX)),
        "a_b_re": nrm(ks[5], (na, g, p, c), f32) * (2 * c) ** -0.5,
        "a_b_im": nrm(ks[6], (na, g, p, c), f32) * (2 * c) ** -0.5,
        "a_c_re": nrm(ks[7], (na, g, c, p), f32) * p ** -0.5,
        "a_c_im": nrm(ks[8], (na, g, c, p), f32) * p ** -0.5,
        "a_d": nrm(ks[9], (na, e), f32),
        "a_w_glu": nrm(ks[10], (na, e, e), f32) * e ** -0.5,
        "a_b_glu": 0.01 * nrm(ks[11], (na, e), f32),
        "a_w_out": nrm(ks[12], (na, e, D_MODEL), f32) * e ** -0.5 * DEEPNORM_BETA,
        "kv_w": nrm(ks[13], (D_MODEL, 2 * N_BRANCH * KV_WIDTH), f32) * D_MODEL ** -0.5,
        "cmp_pos_k": 0.02 * nrm(ks[14], (CMP_BLOCK, HEAD_DIM), f32),
        "cmp_w1_k": nrm(ks[15], (CMP_BLOCK * HEAD_DIM, HEAD_DIM), f32) * (CMP_BLOCK * HEAD_DIM) ** -0.5,
        "cmp_w2_k": nrm(ks[16], (HEAD_DIM, HEAD_DIM), f32) * HEAD_DIM ** -0.5,
        "cmp_pos_v": 0.02 * nrm(ks[17], (CMP_BLOCK, HEAD_DIM), f32),
        "cmp_w1_v": nrm(ks[18], (CMP_BLOCK * HEAD_DIM, HEAD_DIM), f32) * (CMP_BLOCK * HEAD_DIM) ** -0.5,
        "cmp_w2_v": nrm(ks[19], (HEAD_DIM, HEAD_DIM), f32) * HEAD_DIM ** -0.5,
        "b_w_in": nrm(ks[20], (nb, D_MODEL, B_IN_WIDTH), f32) * D_MODEL ** -0.5,
        "b_w_out": nrm(ks[21], (nb, ATTN_WIDTH, D_MODEL), f32) * ATTN_WIDTH ** -0.5 * DEEPNORM_BETA,
        "ln_g": 1.0 + 0.01 * nrm(ks[22], (DEPTH, D_MODEL), f32),
        "ln_b": 0.01 * nrm(ks[23], (DEPTH, D_MODEL), f32),
    }


def reference(x, a_w_in, a_lam_re, a_lam_im, a_log_dt, a_b_re, a_b_im, a_c_re, a_c_im, a_d,
              a_w_glu, a_b_glu, a_w_out, kv_w, cmp_pos_k, cmp_w1_k, cmp_w2_k, cmp_pos_v,
              cmp_w1_v, cmp_w2_v, b_w_in, b_w_out, ln_g, ln_b):
    shared = None
    for layer in range(DEPTH):
        if layer < N_A_LAYERS:
            i = layer
            y = s5_mixer(x, a_w_in[i], a_lam_re[i], a_lam_im[i], a_log_dt[i], a_b_re[i], a_b_im[i],
                         a_c_re[i], a_c_im[i], a_d[i], a_w_glu[i], a_b_glu[i], a_w_out[i])
        else:
            i = layer - N_A_LAYERS
            y = nsa_mixer(x, b_w_in[i], b_w_out[i], shared)
        x = layer_norm(DEEPNORM_ALPHA * x + y, ln_g[layer], ln_b[layer])
        if layer == N_A_LAYERS - 1:
            shared = shared_kv(x, kv_w, cmp_pos_k, cmp_w1_k, cmp_w2_k, cmp_pos_v, cmp_w1_v, cmp_w2_v)
    return x
```

```cpp
#include <hip/hip_runtime.h>
#include <hip/hip_cooperative_groups.h>
#include <stdint.h>
#include <stdio.h>
namespace cg = cooperative_groups;

typedef __attribute__((ext_vector_type(8))) short bf16x8;
typedef __attribute__((ext_vector_type(4))) short s16x4;
typedef __attribute__((ext_vector_type(4))) float f32x4;
typedef unsigned short u16;
#define DI __device__ __forceinline__

#define DESYNC_COND (blockIdx.x >= 256)
#ifndef ATT_SAFE
#define ATT_SAFE 0
#endif
#ifndef REPS_ATTN
#define REPS_ATTN 1
#endif
#ifndef REPS_BIN
#define REPS_BIN 1
#endif
#ifndef REPS_SSM
#define REPS_SSM 1
#endif
#ifndef REPS_P0
#define REPS_P0 1
#endif
constexpr int NTOK = 8192, DM = 2048, SEQ = 4096, EW = 1024;
constexpr int PROJ_LD = 8320, BIN_N = 8240, KV_LD = 3072;
constexpr float DN_ALPHA = 1.681792830507429f;
constexpr float LN_EPS = 1e-5f;
constexpr float SCALE2 = 0.08838834764831845f * 1.4426950408889634f;

constexpr size_t al256(size_t x) { return (x + 255) & ~(size_t)255; }
constexpr size_t O_WAIN = 0;
constexpr size_t O_WGLU = O_WAIN + al256((size_t)2 * 2048 * 2048 * 2);
constexpr size_t O_WAOUT = O_WGLU + al256((size_t)2 * 1024 * 1024 * 2);
constexpr size_t O_WKV = O_WAOUT + al256((size_t)2 * 2048 * 1024 * 2);
constexpr size_t O_WC1 = O_WKV + al256((size_t)3072 * 2048 * 2);
constexpr size_t O_WC2 = O_WC1 + al256((size_t)2 * 128 * 4096 * 2);
constexpr size_t O_WBIN = O_WC2 + al256((size_t)2 * 128 * 128 * 2);
constexpr size_t O_WBOUT = O_WBIN + al256((size_t)2 * PROJ_LD * 2048 * 2);
constexpr size_t O_XB = O_WBOUT + al256((size_t)2 * 2048 * 2048 * 2);
constexpr size_t O_XF = O_XB + al256((size_t)NTOK * DM * 2);
constexpr size_t O_KV = O_XF + al256((size_t)NTOK * DM * 4);
constexpr size_t O_T1 = O_KV + al256((size_t)NTOK * KV_LD * 2);
constexpr size_t O_KCVC = O_T1 + al256((size_t)2 * 2 * 2048 * 128 * 4);
constexpr size_t O_C1B = O_KCVC + al256((size_t)2 * 2048 * 128 * 2);
constexpr size_t O_C1P = O_C1B + al256((size_t)2 * 128 * 4);
constexpr size_t O_BAR = O_C1P + al256((size_t)64 * 128 * 4);
constexpr size_t O_STATS = O_BAR + al256((size_t)4096 * 4);
constexpr size_t O_YB = O_STATS + al256((size_t)NTOK * 8);
constexpr size_t O_UNION = O_YB + al256((size_t)NTOK * DM * 2);
constexpr size_t O_UZ = O_UNION;
constexpr size_t O_G = O_UZ + al256((size_t)NTOK * 2048 * 2);
constexpr size_t O_V = O_G + al256((size_t)NTOK * 1024 * 2);
constexpr size_t O_S = O_V + al256((size_t)NTOK * 1024 * 2);
constexpr size_t O_HIN = O_S + al256((size_t)64 * 128 * 128 * 4);
constexpr size_t O_W1 = O_HIN + al256((size_t)64 * 128 * 128 * 2);
constexpr size_t O_W3T = O_W1 + al256((size_t)2 * 64 * 128 * 1024 * 2);
constexpr size_t O_KTAB = O_W3T + al256((size_t)2 * 64 * 1024 * 128 * 2);
constexpr size_t O_A64 = O_KTAB + al256((size_t)2 * 64 * 64 * 256 * 2);
constexpr size_t O_S5END = O_A64 + al256((size_t)2 * 64 * 64 * 8);
constexpr size_t O_PROJ = O_UNION;
constexpr size_t O_PROJEND = O_PROJ + al256((size_t)NTOK * PROJ_LD * 2);
constexpr size_t WS_TOTAL = (O_S5END > O_PROJEND ? O_S5END : O_PROJEND);

struct Params {
  const float* in[24];
  float* out;
  char* ws;
};

DI u16 f2bf(float f) { uint32_t u = __float_as_uint(f); u += 0x7fffu + ((u >> 16) & 1u); return (u16)(u >> 16); }
typedef float f32x2_t __attribute__((ext_vector_type(2)));
typedef __bf16 bf16x2_t __attribute__((ext_vector_type(2)));
DI uint32_t pack2(float a, float b) { f32x2_t v = {a, b}; bf16x2_t h = __builtin_convertvector(v, bf16x2_t); return __builtin_bit_cast(uint32_t, h); }
DI float bflo(uint32_t v) { return __uint_as_float(v << 16); }
DI float bfhi(uint32_t v) { return __uint_as_float(v & 0xffff0000u); }
DI float bf2f(u16 h) { return __uint_as_float(((uint32_t)h) << 16); }
DI uint4 ldg16(const void* p) { return *(const uint4*)p; }
DI uint4 ldg_o(const void* base, uint32_t byte_off) { return *(const uint4*)((const char*)base + byte_off); }
DI float sigm(float x) { return __builtin_amdgcn_rcpf(1.f + __expf(-x)); }
DI float silu(float x) { return x * sigm(x); }
DI float gelu_tanh(float x) { float u = 0.7978845608028654f * (x + 0.044715f * x * x * x); return x * sigm(2.f * u); }
DI void st_bf4(u16* p, f32x4 v) { uint2 o; o.x = pack2(v[0], v[1]); o.y = pack2(v[2], v[3]); *(uint2*)p = o; }
DI f32x4 ld_bf4(const u16* p) { uint2 o = *(const uint2*)p; f32x4 r; r[0] = bflo(o.x); r[1] = bfhi(o.x); r[2] = bflo(o.y); r[3] = bfhi(o.y); return r; }

DI int tid_l() { int t = threadIdx.x; asm volatile("" : "+v"(t)); return t; }


#define XB_TMO      128
#define XB_XCNT(j)  (256  + 64 * (j))
#define XB_XSUB(j)  (1280 + 64 * (j))
#define XB_XGEN(j)  (2304 + 64 * (j))
#define XB_TOP      3328
#define XB_TOPGEN   3392
#define XCD_BAR_WORDS 3456
#define XB_SPIN_CAP (1u << 22)
#define LAS __attribute__((address_space(3)))
DI unsigned xb_ld(unsigned* p) { return __hip_atomic_load(p, __ATOMIC_RELAXED, __HIP_MEMORY_SCOPE_AGENT); }
DI unsigned xb_add(unsigned* p, unsigned v) { return __hip_atomic_fetch_add(p, v, __ATOMIC_RELAXED, __HIP_MEMORY_SCOPE_AGENT); }
DI unsigned xb_xcc_id() { return (unsigned)__builtin_amdgcn_s_getreg((3 << 11) | 20) & 0xFu; }
#define XB_SPIN(cond, bar) do { unsigned _sp = 0; while (cond) { __builtin_amdgcn_s_sleep(1); \
    if ((++_sp & 255u) == 0u) { if (xb_ld(&(bar)[XB_TMO])) break; if (_sp > XB_SPIN_CAP) { atomicAdd(&(bar)[XB_TMO], 1u); break; } } } } while (0)
struct XcdBarrier { unsigned* bar; unsigned x; volatile LAS unsigned* st; };
DI XcdBarrier xcd_barrier_post(unsigned* bar, volatile LAS unsigned* st) {
  XcdBarrier b; b.bar = bar; b.x = xb_xcc_id(); b.st = st;
  if (threadIdx.x == 0) (void)xb_add(&bar[XB_XCNT(b.x)], 1u);
  return b;
}
DI void xcd_barrier_complete(unsigned* bar, unsigned x, unsigned& nloc, unsigned& nx) {
  const unsigned G = gridDim.x * gridDim.y * gridDim.z;
  unsigned sum, cnt, mine, sp = 0u;
  for (;;) {
    sum = 0u; cnt = 0u; mine = 0u;
#pragma unroll
    for (unsigned j = 0; j < 16; ++j) { const unsigned c = xb_ld(&bar[XB_XCNT(j)]); sum += c; cnt += (c > 0u) ? 1u : 0u; mine = (j == x) ? c : mine; }
    if (sum == G) break;
    __builtin_amdgcn_s_sleep(1);
    if ((++sp & 255u) == 0u) { if (xb_ld(&bar[XB_TMO])) break; if (sp > XB_SPIN_CAP) { atomicAdd(&bar[XB_TMO], 1u); break; } }
  }
  nloc = mine > 0u ? mine : 1u; nx = cnt > 0u ? cnt : 1u;
}
DI void xcd_barrier(const XcdBarrier& b) {
  asm volatile("s_waitcnt vmcnt(0)" ::: "memory");
  __syncthreads();
  if (threadIdx.x == 0) {
    unsigned* bar = b.bar;
    __builtin_amdgcn_s_waitcnt(0);
    unsigned nloc = b.st[0], nx = b.st[1];
    if (nloc == 0u) { xcd_barrier_complete(bar, b.x, nloc, nx); b.st[0] = nloc; b.st[1] = nx; }
    const unsigned old = xb_add(&bar[XB_XSUB(b.x)], 1u);
    const unsigned gen = old / nloc;
    if (old + 1u == (gen + 1u) * nloc) {
      __builtin_amdgcn_fence(__ATOMIC_RELEASE, "agent");
      asm volatile("s_waitcnt vmcnt(0)" ::: "memory");
      const unsigned og = xb_add(&bar[XB_TOP], 1u);
      const unsigned tg = og / nx;
      if (og + 1u == (tg + 1u) * nx) xb_add(&bar[XB_TOPGEN], 1u);
      else XB_SPIN(xb_ld(&bar[XB_TOPGEN]) == tg, bar);
      __builtin_amdgcn_fence(__ATOMIC_ACQUIRE, "agent");
      xb_add(&bar[XB_XGEN(b.x)], 1u);
      asm volatile("s_waitcnt vmcnt(0)" ::: "memory");
    } else {
      XB_SPIN(xb_ld(&bar[XB_XGEN(b.x)]) == gen, bar);
      __builtin_amdgcn_fence(__ATOMIC_ACQUIRE, "agent");
      asm volatile("s_waitcnt vmcnt(0)" ::: "memory");
    }
  }
  __syncthreads();
}

template <int DEPTH = 2, bool STAGED = true, class KMAP, class LA, class LW, class EPI>
DI void gemm_tile(u16* smem, int m0, int n0, int nks, KMAP kmap, LA loadA, LW loadW, EPI epi) {
  const int tid = tid_l(), lane = tid & 63, wave = tid >> 6;
  const int wm = wave >> 1, wn = wave & 1, l15 = lane & 15, quad = lane >> 4;
  u16* sX = smem;
  u16* sW = smem + 2 * 128 * 64;
  f32x4 acc[4][4];
#pragma unroll
  for (int i = 0; i < 4; ++i)
#pragma unroll
    for (int j = 0; j < 4; ++j) acc[i][j] = f32x4{0.f, 0.f, 0.f, 0.f};
  uint4 ra0[4], rw0[4], ra1[4], rw1[4];
  const int lrow = tid >> 3, lkc = (tid & 7) * 8;
  const int wpos = (((tid & 7) ^ ((tid >> 4) & 7)) * 8);
  const int rsw = (l15 >> 1) & 7;
  const int rp0 = ((quad ^ rsw) * 8), rp1 = (((4 + quad) ^ rsw) * 8);
#define G_LOAD(RA, RW, KS) { const int k0_ = __builtin_amdgcn_readfirstlane(kmap(KS)); _Pragma("unroll") for (int i = 0; i < 4; ++i) { RA[i] = loadA(m0 + lrow + i * 32, k0_, lkc); RW[i] = loadW(n0 + lrow + i * 32, k0_, lkc); } }
#define G_STORE(RA, RW, BUF) { u16* dx_ = sX + (BUF) * 128 * 64; u16* dw_ = sW + (BUF) * 128 * 64; _Pragma("unroll") for (int i = 0; i < 4; ++i) { \
    *(uint4*)(dx_ + (lrow + i * 32) * 64 + wpos) = RA[i]; *(uint4*)(dw_ + (lrow + i * 32) * 64 + wpos) = RW[i]; } }
#define G_COMPUTE(BUF, FENCE) { const u16* bx = sX + (BUF) * 128 * 64 + (wm * 64 + l15) * 64; const u16* bw = sW + (BUF) * 128 * 64 + (wn * 64 + l15) * 64; \
    bf16x8 xf[2][4], wf[2][4]; \
    _Pragma("unroll") for (int i = 0; i < 4; ++i) { \
      xf[0][i] = *(const bf16x8*)(bx + i * 16 * 64 + rp0); wf[0][i] = *(const bf16x8*)(bw + i * 16 * 64 + rp0); } \
    _Pragma("unroll") for (int i = 0; i < 4; ++i) { \
      xf[1][i] = *(const bf16x8*)(bx + i * 16 * 64 + rp1); wf[1][i] = *(const bf16x8*)(bw + i * 16 * 64 + rp1); } \
    if (FENCE) __builtin_amdgcn_sched_barrier(0); \
    _Pragma("unroll") for (int kk = 0; kk < 2; ++kk) { \
      _Pragma("unroll") for (int ni = 0; ni < 4; ++ni) _Pragma("unroll") for (int mi = 0; mi < 4; ++mi) \
          acc[ni][mi] = __builtin_amdgcn_mfma_f32_16x16x32_bf16(wf[kk][ni], xf[kk][mi], acc[ni][mi], 0, 0, 0); \
      if (FENCE) __builtin_amdgcn_sched_barrier(0); } }
#define G_PATTERN { __builtin_amdgcn_sched_group_barrier(0x100, 16, 0); \
    _Pragma("unroll") for (int q_ = 0; q_ < 8; ++q_) { __builtin_amdgcn_sched_group_barrier(0x008, 2, 0); __builtin_amdgcn_sched_group_barrier(0x020, 1, 0); } \
    _Pragma("unroll") for (int q_ = 0; q_ < 8; ++q_) { __builtin_amdgcn_sched_group_barrier(0x008, 2, 0); __builtin_amdgcn_sched_group_barrier(0x200, 1, 0); } }
  if (DEPTH == 2) {
    G_LOAD(ra0, rw0, 0);
    G_LOAD(ra1, rw1, 1);
    G_STORE(ra0, rw0, 0);
    __syncthreads();
    for (int ks = 0; ks < nks; ks += 2) {
      G_LOAD(ra0, rw0, (ks + 2 < nks ? ks + 2 : nks - 1));
      G_COMPUTE(0, 0);
      G_STORE(ra1, rw1, 1);
      G_PATTERN;
      __syncthreads();
      G_LOAD(ra1, rw1, (ks + 3 < nks ? ks + 3 : nks - 1));
      G_COMPUTE(1, 0);
      G_STORE(ra0, rw0, 0);
      G_PATTERN;
      __syncthreads();
    }
  } else {
    G_LOAD(ra0, rw0, 0);
    G_STORE(ra0, rw0, 0);
    __syncthreads();
    for (int ks = 0; ks < nks; ++ks) {
      const int buf = ks & 1;
      if (ks + 1 < nks) G_LOAD(ra0, rw0, ks + 1);
      G_COMPUTE(buf, 1);
      if (ks + 1 < nks) G_STORE(ra0, rw0, buf ^ 1);
      __syncthreads();
    }
  }
#undef G_LOAD
#undef G_STORE
#undef G_COMPUTE
#undef G_PATTERN
  if constexpr (!STAGED) {
#pragma unroll
    for (int ni = 0; ni < 4; ++ni)
#pragma unroll
      for (int mi = 0; mi < 4; ++mi)
        epi(m0 + wm * 64 + mi * 16 + l15, n0 + wn * 64 + ni * 16 + quad * 4, acc[ni][mi]);
  } else {
    float* wbuf = (float*)smem + wave * (16 * 68);
    const int rrow = lane >> 4, rcol = (lane & 15) * 4;
#pragma unroll
    for (int mi = 0; mi < 4; ++mi) {
#pragma unroll
      for (int ni = 0; ni < 4; ++ni) *(f32x4*)(wbuf + l15 * 68 + ni * 16 + quad * 4) = acc[ni][mi];
      __builtin_amdgcn_wave_barrier();
#pragma unroll
      for (int j = 0; j < 4; ++j) {
        const f32x4 a = *(const f32x4*)(wbuf + (j * 4 + rrow) * 68 + rcol);
        epi(m0 + wm * 64 + mi * 16 + j * 4 + rrow, n0 + wn * 64 + rcol, a);
      }
    }
    __syncthreads();
  }
}

template <bool HASPRE = false, class LA, class LW, class EPI, class PRE = int>
DI void gemm_tile_w(u16* smem, int m0, int n0, int nks, LA loadA, LW loadW, EPI epi, PRE pre = 0) {
  const int tid = tid_l(), lane = tid & 63, wave = tid >> 6;
  const int wm = wave >> 1, wn = wave & 1, l15 = lane & 15, quad = lane >> 4;
  u16* sX = smem;
  u16* sW = smem + 2 * 128 * 32;
  f32x4 acc[8][4];
#pragma unroll
  for (int i = 0; i < 8; ++i)
#pragma unroll
    for (int j = 0; j < 4; ++j) acc[i][j] = f32x4{0.f, 0.f, 0.f, 0.f};
  uint4 ra0[2], rw0[4], ra1[2], rw1[4];
  const int lrow = tid >> 2, lkc = (tid & 3) * 8;
  const int wpos = ((tid & 3) ^ ((0 - (tid >> 4)) & 3)) * 8;
  const int rpos = (quad ^ ((0 - (l15 >> 2)) & 3)) * 8;
#define W_LOAD(RA, RW, KS) { const int k0_ = __builtin_amdgcn_readfirstlane((KS) * 32); \
    _Pragma("unroll") for (int i = 0; i < 2; ++i) RA[i] = loadA(m0 + lrow + i * 64, k0_, lkc); \
    _Pragma("unroll") for (int i = 0; i < 4; ++i) RW[i] = loadW(n0 + lrow + i * 64, k0_, lkc); }
#define W_STORE(RA, RW, BUF) { u16* dx_ = sX + (BUF) * 128 * 32; u16* dw_ = sW + (BUF) * 256 * 32; \
    _Pragma("unroll") for (int i = 0; i < 2; ++i) *(uint4*)(dx_ + (lrow + i * 64) * 32 + wpos) = RA[i]; \
    _Pragma("unroll") for (int i = 0; i < 4; ++i) *(uint4*)(dw_ + (lrow + i * 64) * 32 + wpos) = RW[i]; }
#define W_COMPUTE(BUF) { const u16* bx = sX + (BUF) * 128 * 32 + (wm * 64 + l15) * 32 + rpos; const u16* bw = sW + (BUF) * 256 * 32 + (wn * 128 + l15) * 32 + rpos; \
    bf16x8 xf[4], wf[8]; \
    _Pragma("unroll") for (int i = 0; i < 4; ++i) xf[i] = *(const bf16x8*)(bx + i * 16 * 32); \
    _Pragma("unroll") for (int i = 0; i < 8; ++i) wf[i] = *(const bf16x8*)(bw + i * 16 * 32); \
    _Pragma("unroll") for (int ni = 0; ni < 8; ++ni) _Pragma("unroll") for (int mi = 0; mi < 4; ++mi) \
        acc[ni][mi] = __builtin_amdgcn_mfma_f32_16x16x32_bf16(wf[ni], xf[mi], acc[ni][mi], 0, 0, 0); }
#define W_PATTERN { __builtin_amdgcn_sched_group_barrier(0x100, 12, 0); \
    _Pragma("unroll") for (int q_ = 0; q_ < 6; ++q_) { __builtin_amdgcn_sched_group_barrier(0x008, 2, 0); __builtin_amdgcn_sched_group_barrier(0x020, 1, 0); } \
    _Pragma("unroll") for (int q_ = 0; q_ < 6; ++q_) { __builtin_amdgcn_sched_group_barrier(0x008, 3, 0); __builtin_amdgcn_sched_group_barrier(0x200, 1, 0); } \
    __builtin_amdgcn_sched_group_barrier(0x008, 2, 0); }
  W_LOAD(ra0, rw0, 0);
  W_LOAD(ra1, rw1, 1);
  W_STORE(ra0, rw0, 0);
  __syncthreads();
  for (int ks = 0; ks < nks; ks += 2) {
    W_LOAD(ra0, rw0, (ks + 2 < nks ? ks + 2 : nks - 1));
    W_COMPUTE(0);
    W_STORE(ra1, rw1, 1);
    W_PATTERN;
    __syncthreads();
    W_LOAD(ra1, rw1, (ks + 3 < nks ? ks + 3 : nks - 1));
    W_COMPUTE(1);
    W_STORE(ra0, rw0, 0);
    W_PATTERN;
    __syncthreads();
  }
#undef W_LOAD
#undef W_STORE
#undef W_COMPUTE
#undef W_PATTERN
  if constexpr (HASPRE) {
    float* wbuf = (float*)smem + wave * (16 * 132);
    const int rrow = lane >> 5, rcol = (lane & 31) * 4;
#pragma unroll
    for (int mi = 0; mi < 4; ++mi) {
#pragma unroll
      for (int ni = 0; ni < 8; ++ni) *(f32x4*)(wbuf + l15 * 132 + ni * 16 + quad * 4) = acc[ni][mi];
      __builtin_amdgcn_wave_barrier();
      f32x4 pv[8];
#pragma unroll
      for (int j = 0; j < 8; ++j) pv[j] = pre(m0 + wm * 64 + mi * 16 + j * 2 + rrow, n0 + wn * 128 + rcol);
#pragma unroll
      for (int j = 0; j < 8; ++j) {
        const f32x4 a = *(const f32x4*)(wbuf + (j * 2 + rrow) * 132 + rcol);
        epi(m0 + wm * 64 + mi * 16 + j * 2 + rrow, n0 + wn * 128 + rcol, a, pv[j]);
      }
    }
    __syncthreads();
  } else {
    float* wbuf = (float*)smem + wave * (16 * 132);
    const int rrow = lane >> 5, rcol = (lane & 31) * 4;
#pragma unroll
    for (int mi = 0; mi < 4; ++mi) {
#pragma unroll
      for (int ni = 0; ni < 8; ++ni) *(f32x4*)(wbuf + l15 * 132 + ni * 16 + quad * 4) = acc[ni][mi];
      __builtin_amdgcn_wave_barrier();
#pragma unroll
      for (int j = 0; j < 8; ++j) {
        const f32x4 a = *(const f32x4*)(wbuf + (j * 2 + rrow) * 132 + rcol);
        epi(m0 + wm * 64 + mi * 16 + j * 2 + rrow, n0 + wn * 128 + rcol, a);
      }
    }
    __syncthreads();
  }
}

DI void tconv(float* tl, const float* src, u16* dst, int K, int N, int Npad, int b0, int nb) {
  const int tid = tid_l();
  const int nkt = K >> 6, nnt = Npad >> 6, ntl = nkt * nnt;
  const int r = tid >> 4, c4 = (tid & 15) * 4;
  float4 v[4];
  int tile = (int)blockIdx.x - b0;
  auto ld = [&](int t) {
    const int kt = t % nkt, nt = t / nkt;
    const int k0 = kt * 64, n0 = nt * 64;
#pragma unroll
    for (int i = 0; i < 4; ++i) {
      v[i] = make_float4(0.f, 0.f, 0.f, 0.f);
      if (n0 + c4 < N) v[i] = *(const float4*)(src + (size_t)(k0 + r + i * 16) * N + n0 + c4);
    }
  };
  if (tile < ntl) ld(tile);
  for (; tile < ntl; tile += nb) {
    const int kt = tile % nkt, nt = tile / nkt;
    const int k0 = kt * 64, n0 = nt * 64;
#pragma unroll
    for (int i = 0; i < 4; ++i) {
      const int k = r + i * 16;
      tl[k * 65 + c4 + 0] = v[i].x; tl[k * 65 + c4 + 1] = v[i].y; tl[k * 65 + c4 + 2] = v[i].z; tl[k * 65 + c4 + 3] = v[i].w;
    }
    if (tile + nb < ntl) ld(tile + nb);
    __syncthreads();
#pragma unroll
    for (int i = 0; i < 2; ++i) {
      const int c = tid + i * 256;
      const int n = c >> 3, k8 = (c & 7) * 8;
      uint4 o;
      o.x = pack2(tl[(k8 + 0) * 65 + n], tl[(k8 + 1) * 65 + n]);
      o.y = pack2(tl[(k8 + 2) * 65 + n], tl[(k8 + 3) * 65 + n]);
      o.z = pack2(tl[(k8 + 4) * 65 + n], tl[(k8 + 5) * 65 + n]);
      o.w = pack2(tl[(k8 + 6) * 65 + n], tl[(k8 + 7) * 65 + n]);
      *(uint4*)(dst + (size_t)(n0 + n) * K + k0 + k8) = o;
    }
    __syncthreads();
  }
}

template <int MODE, class TILE, class BIAS, class EM, class MASK>
DI void attn_loop(u16* sK, u16* sV, uint32_t* imp, int ntiles, TILE tilefn, BIAS biasfn, EM emfn, MASK valid, const bf16x8 (&qf)[2][4],
                  f32x4 (&o)[2][8], float (&mrow)[2], float (&lrow)[2], const float (&linv)[2]) {
  const int tid = tid_l(), lane = tid & 63;
  const int l15 = lane & 15, quad = lane >> 4;
  const int lr = tid >> 4, lc = (tid & 15) * 8;
  uint4 rk[4];
#define K_LOAD(IT) { const u16 *kb_, *vb_; size_t rs_; int kp_; tilefn(IT, kb_, vb_, rs_, kp_); _Pragma("unroll") for (int i = 0; i < 4; ++i) rk[i] = ldg_o(kb_, (uint32_t)((lr + i * 16) * (int)rs_ + lc) * 2u); }
#define V_LOAD_G(IT) { const u16 *kb_, *vb_; size_t rs_; int kp_; tilefn(IT, kb_, vb_, rs_, kp_); _Pragma("unroll") for (int i = 0; i < 4; ++i) rk[i] = ldg_o(vb_, (uint32_t)((lr + i * 16) * (int)rs_ + lc) * 2u); }
#define K_STORE(BUF) { _Pragma("unroll") for (int i = 0; i < 4; ++i) *(uint4*)(sK + (BUF) * 64 * 136 + (lr + i * 16) * 136 + lc) = rk[i]; }
#define V_STORE(BUF) { _Pragma("unroll") for (int i = 0; i < 4; ++i) *(uint4*)(sV + (BUF) * 64 * 144 + (lr + i * 16) * 144 + lc) = rk[i]; }
  auto compute = [&](const int buf, const int it, auto midfn) {
    int kpos0;
    { const u16 *kb, *vb; size_t rs; tilefn(it, kb, vb, rs, kpos0); }
    f32x4 s[4][2];
#pragma unroll
    for (int kc = 0; kc < 4; ++kc) { s[kc][0] = f32x4{0.f, 0.f, 0.f, 0.f}; s[kc][1] = f32x4{0.f, 0.f, 0.f, 0.f}; }
    const u16* kbase = sK + buf * 64 * 136 + l15 * 136 + quad * 8;
    {
      bf16x8 kf[2][2];
      kf[0][0] = *(const bf16x8*)(kbase);
      kf[0][1] = *(const bf16x8*)(kbase + 32);
#pragma unroll
      for (int h = 0; h < 8; ++h) {
        const int kc = h >> 1, dh = h & 1;
        if (h < 7) {
          const int kc2 = (h + 1) >> 1, dh2 = (h + 1) & 1;
          kf[(h + 1) & 1][0] = *(const bf16x8*)(kbase + kc2 * 16 * 136 + (dh2 * 2) * 32);
          kf[(h + 1) & 1][1] = *(const bf16x8*)(kbase + kc2 * 16 * 136 + (dh2 * 2 + 1) * 32);
        }
#pragma unroll
        for (int e = 0; e < 2; ++e) {
          const int ds = dh * 2 + e;
          s[kc][0] = __builtin_amdgcn_mfma_f32_16x16x32_bf16(kf[h & 1][e], qf[0][ds], s[kc][0], 0, 0, 0);
          s[kc][1] = __builtin_amdgcn_mfma_f32_16x16x32_bf16(kf[h & 1][e], qf[1][ds], s[kc][1], 0, 0, 0);
        }
        __builtin_amdgcn_sched_barrier(0);
      }
    }
    midfn();
    float mx[2] = {-1e30f, -1e30f};
    if (MODE == 0) {
      const float bias0 = biasfn(it, 0), bias1 = biasfn(it, 1);
      const bool em = ATT_SAFE || emfn(it);
      if (em) {
#pragma unroll
        for (int kc = 0; kc < 4; ++kc)
#pragma unroll
          for (int qs = 0; qs < 2; ++qs)
#pragma unroll
            for (int r = 0; r < 4; ++r) {
              const int kpos = kpos0 + kc * 16 + quad * 4 + r;
              const float x = valid(kpos, qs) ? fmaf(s[kc][qs][r], SCALE2, qs ? bias1 : bias0) : -1e30f;
              s[kc][qs][r] = x;
              mx[qs] = fmaxf(mx[qs], x);
            }
      } else {
        float r0 = -3e38f, r1 = -3e38f;
#pragma unroll
        for (int kc = 0; kc < 4; ++kc)
#pragma unroll
          for (int r = 0; r < 4; ++r) { r0 = fmaxf(r0, s[kc][0][r]); r1 = fmaxf(r1, s[kc][1][r]); }
        mx[0] = fmaf(r0, SCALE2, bias0);
        mx[1] = fmaf(r1, SCALE2, bias1);
      }
      float al[2];
#pragma unroll
      for (int qs = 0; qs < 2; ++qs) {
        float m = mx[qs];
        m = fmaxf(m, __shfl_xor(m, 16));
        m = fmaxf(m, __shfl_xor(m, 32));
        const float mnew = fmaxf(mrow[qs], m);
        al[qs] = __builtin_amdgcn_exp2f(mrow[qs] - mnew);
        mrow[qs] = mnew;
      }
      if (__builtin_amdgcn_ballot_w64(al[0] < 1.f || al[1] < 1.f) != 0ull) {
#pragma unroll
        for (int qs = 0; qs < 2; ++qs) {
          lrow[qs] *= al[qs];
#pragma unroll
          for (int dt = 0; dt < 8; ++dt) o[qs][dt] *= al[qs];
        }
      }
      if (em) {
#pragma unroll
        for (int kc = 0; kc < 4; ++kc)
#pragma unroll
          for (int qs = 0; qs < 2; ++qs)
#pragma unroll
            for (int r = 0; r < 4; ++r) {
              float pv = __builtin_amdgcn_exp2f(s[kc][qs][r] - mrow[qs]);
              if (ATT_SAFE) pv = (s[kc][qs][r] > -1e29f) ? pv : 0.f;
              lrow[qs] += pv;
              s[kc][qs][r] = pv;
            }
      } else {
        const float c0 = bias0 - mrow[0], c1 = bias1 - mrow[1];
#pragma unroll
        for (int kc = 0; kc < 4; ++kc)
#pragma unroll
          for (int qs = 0; qs < 2; ++qs)
#pragma unroll
            for (int r = 0; r < 4; ++r) {
              const float pv = __builtin_amdgcn_exp2f(fmaf(s[kc][qs][r], SCALE2, qs ? c1 : c0));
              lrow[qs] += pv;
              s[kc][qs][r] = pv;
            }
      }
    } else {
#pragma unroll
      for (int kc = 0; kc < 4; ++kc)
#pragma unroll
        for (int qs = 0; qs < 2; ++qs)
#pragma unroll
          for (int r = 0; r < 4; ++r) {
            const int kpos = kpos0 + kc * 16 + quad * 4 + r;
            const float x = valid(kpos, qs) ? s[kc][qs][r] * SCALE2 : -1e30f;
            s[kc][qs][r] = x;
            mx[qs] = fmaxf(mx[qs], x);
          }
      if (MODE == 1) {
#pragma unroll
        for (int qs = 0; qs < 2; ++qs) {
          float m = mx[qs];
          m = fmaxf(m, __shfl_xor(m, 16));
          m = fmaxf(m, __shfl_xor(m, 32));
          const float mnew = fmaxf(mrow[qs], m);
          const float alpha = __builtin_amdgcn_exp2f(mrow[qs] - mnew);
          mrow[qs] = mnew;
          lrow[qs] *= alpha;
        }
      }
#pragma unroll
      for (int kc = 0; kc < 4; ++kc)
#pragma unroll
        for (int qs = 0; qs < 2; ++qs)
#pragma unroll
          for (int r = 0; r < 4; ++r) {
            const float x = s[kc][qs][r];
            float pv = (x > -1e29f) ? __builtin_amdgcn_exp2f(x - mrow[qs]) : 0.f;
            if (MODE == 2) pv *= linv[qs];
            else lrow[qs] += pv;
            s[kc][qs][r] = pv;
          }
    }
    if (MODE == 2) {
#pragma unroll
      for (int kc = 0; kc < 4; ++kc)
#pragma unroll
        for (int qs = 0; qs < 2; ++qs) {
          const int jb = (kpos0 >> 2) + kc * 4 + quad;
          const float a = s[kc][qs][0] + s[kc][qs][1] + s[kc][qs][2] + s[kc][qs][3];
          const float b3 = s[kc][qs][3];
          if (jb < 64) atomicAdd(&imp[(qs * 16 + l15) * 65 + jb], (uint32_t)(a * 67108864.f + 0.5f));
          if (jb + 1 < 64) atomicAdd(&imp[(qs * 16 + l15) * 65 + jb + 1], (uint32_t)(b3 * 67108864.f + 0.5f));
        }
    }
    if (MODE != 1) {
      bf16x8 pb[2][2];
#pragma unroll
      for (int j = 0; j < 2; ++j)
#pragma unroll
        for (int qs = 0; qs < 2; ++qs) {
          union { bf16x8 v; uint32_t u[4]; } cv;
          cv.u[0] = pack2(s[2 * j][qs][0], s[2 * j][qs][1]);
          cv.u[1] = pack2(s[2 * j][qs][2], s[2 * j][qs][3]);
          cv.u[2] = pack2(s[2 * j + 1][qs][0], s[2 * j + 1][qs][1]);
          cv.u[3] = pack2(s[2 * j + 1][qs][2], s[2 * j + 1][qs][3]);
          pb[j][qs] = cv.v;
        }
      const u16* vbase = sV + buf * 64 * 144 + (4 * quad + (l15 >> 2)) * 144 + (l15 & 3) * 4;
      bf16x8 vf[2][4];
#define V_LOAD(DST, G) { _Pragma("unroll") for (int d = 0; d < 4; ++d) { const u16* a0 = vbase + (32 * ((G) >> 1)) * 144 + (((G) & 1) * 4 + d) * 16; \
        s16x4 lo = __builtin_amdgcn_ds_read_tr16_b64_v4i16((__attribute__((address_space(3))) s16x4*)(a0)); \
        s16x4 hi = __builtin_amdgcn_ds_read_tr16_b64_v4i16((__attribute__((address_space(3))) s16x4*)(a0 + 16 * 144)); \
        bf16x8 t; t[0] = lo[0]; t[1] = lo[1]; t[2] = lo[2]; t[3] = lo[3]; t[4] = hi[0]; t[5] = hi[1]; t[6] = hi[2]; t[7] = hi[3]; DST[d] = t; } }
      V_LOAD(vf[0], 0);
#pragma unroll
      for (int g = 0; g < 4; ++g) {
        if (g < 3) V_LOAD(vf[(g + 1) & 1], g + 1);
#pragma unroll
        for (int d = 0; d < 4; ++d) {
          const int dt = (g & 1) * 4 + d;
          o[0][dt] = __builtin_amdgcn_mfma_f32_16x16x32_bf16(vf[g & 1][d], pb[g >> 1][0], o[0][dt], 0, 0, 0);
          o[1][dt] = __builtin_amdgcn_mfma_f32_16x16x32_bf16(vf[g & 1][d], pb[g >> 1][1], o[1][dt], 0, 0, 0);
        }
        __builtin_amdgcn_sched_barrier(0);
      }
#undef V_LOAD
    }
  };
  K_LOAD(0); K_STORE(0);
  V_LOAD_G(0); V_STORE(0);
  __syncthreads();
  for (int it = 0; it < ntiles; ++it) {
    const int buf = it & 1;
    const bool more = (it + 1 < ntiles);
    if (more) K_LOAD(it + 1);
    compute(buf, it, [&]() { if (more) { K_STORE(buf ^ 1); V_LOAD_G(it + 1); } });
    if (more) V_STORE(buf ^ 1);
    __syncthreads();
  }
#undef K_LOAD
#undef V_LOAD_G
#undef K_STORE
#undef V_STORE
}

__global__ void __launch_bounds__(256, 2) yoco_fwd(Params p) {
  cg::grid_group grid = cg::this_grid();
  __shared__ __attribute__((aligned(16))) u16 smem[40192];
  __shared__ uint4 xb_words;
  if (threadIdx.x == 0) xb_words = make_uint4(0u, 0u, 0u, 0u);
  __syncthreads();
  XcdBarrier xb = xcd_barrier_post((unsigned*)(p.ws + O_BAR), (volatile LAS unsigned*)&xb_words);
  char* ws = p.ws;
  u16* W_AIN = (u16*)(ws + O_WAIN);
  u16* W_GLU = (u16*)(ws + O_WGLU);
  u16* W_AOUT = (u16*)(ws + O_WAOUT);
  u16* W_KV = (u16*)(ws + O_WKV);
  u16* W_C1 = (u16*)(ws + O_WC1);
  u16* W_C2 = (u16*)(ws + O_WC2);
  u16* W_BIN = (u16*)(ws + O_WBIN);
  u16* W_BOUT = (u16*)(ws + O_WBOUT);
  u16* XB = (u16*)(ws + O_XB);
  float* XF = (float*)(ws + O_XF);
  u16* KV = (u16*)(ws + O_KV);
  float* T1P = (float*)(ws + O_T1);
  u16* KCVC = (u16*)(ws + O_KCVC);
  float* C1B = (float*)(ws + O_C1B);
  u16* YB = (u16*)(ws + O_YB);
  float2* STATS = (float2*)(ws + O_STATS);
  u16* UZ = (u16*)(ws + O_UZ);
  u16* GB = (u16*)(ws + O_G);
  u16* VB = (u16*)(ws + O_V);
  float* SB = (float*)(ws + O_S);
  u16* HIN = (u16*)(ws + O_HIN);
  u16* W1 = (u16*)(ws + O_W1);
  u16* W3T = (u16*)(ws + O_W3T);
  u16* KTAB = (u16*)(ws + O_KTAB);
  float2* A64 = (float2*)(ws + O_A64);
  u16* PROJ = (u16*)(ws + O_PROJ);

  float* tl = (float*)smem;
  auto do_jobs = [&](unsigned mask, int b0, int nb) {
      for (int job = 0; job < 15; ++job) {
        if (!((mask >> job) & 1u)) continue;

        const float* src; u16* dst; int K, N, Np;
        switch (job) {
          case 0: src = p.in[1]; dst = W_AIN; K = 2048; N = 2048; Np = 2048; break;
          case 1: src = p.in[1] + (size_t)2048 * 2048; dst = W_AIN + (size_t)2048 * 2048; K = 2048; N = 2048; Np = 2048; break;
          case 2: src = p.in[10]; dst = W_GLU; K = 1024; N = 1024; Np = 1024; break;
          case 3: src = p.in[10] + (size_t)1024 * 1024; dst = W_GLU + (size_t)1024 * 1024; K = 1024; N = 1024; Np = 1024; break;
          case 4: src = p.in[12]; dst = W_AOUT; K = 1024; N = 2048; Np = 2048; break;
          case 5: src = p.in[12] + (size_t)1024 * 2048; dst = W_AOUT + (size_t)2048 * 1024; K = 1024; N = 2048; Np = 2048; break;
          case 6: src = p.in[13]; dst = W_KV; K = 2048; N = 3072; Np = 3072; break;
          case 7: src = p.in[15]; dst = W_C1; K = 4096; N = 128; Np = 128; break;
          case 8: src = p.in[18]; dst = W_C1 + (size_t)128 * 4096; K = 4096; N = 128; Np = 128; break;
          case 9: src = p.in[16]; dst = W_C2; K = 128; N = 128; Np = 128; break;
          case 10: src = p.in[19]; dst = W_C2 + (size_t)128 * 128; K = 128; N = 128; Np = 128; break;
          case 11: src = p.in[20]; dst = W_BIN; K = 2048; N = BIN_N; Np = PROJ_LD; break;
          case 12: src = p.in[20] + (size_t)2048 * BIN_N; dst = W_BIN + (size_t)PROJ_LD * 2048; K = 2048; N = BIN_N; Np = PROJ_LD; break;
          case 13: src = p.in[21]; dst = W_BOUT; K = 2048; N = 2048; Np = 2048; break;
          default: src = p.in[21] + (size_t)2048 * 2048; dst = W_BOUT + (size_t)2048 * 2048; K = 2048; N = 2048; Np = 2048; break;
        }
        if ((int)blockIdx.x >= b0) tconv(tl, src, dst, K, N, Np, b0, nb);
      }
  };
  for (int rep0 = 0; rep0 < REPS_P0; ++rep0) {
    const int tid = tid_l(), lane = tid & 63, wave = tid >> 6; (void)lane; (void)wave;
    do_jobs((1u << 0) | (1u << 2) | (1u << 4) | (1u << 7) | (1u << 8) | (1u << 9) | (1u << 10), 0, (int)gridDim.x);
    {
      const float4* x4 = (const float4*)p.in[0];
      uint2* xb2 = (uint2*)XB;
      const size_t n4 = (size_t)NTOK * DM / 4;
      for (size_t i = (size_t)blockIdx.x * 256 + tid; i < n4; i += (size_t)gridDim.x * 256) {
        float4 v = x4[i];
        uint2 o; o.x = pack2(v.x, v.y); o.y = pack2(v.z, v.w);
        xb2[i] = o;
      }
    }
    {
      float* C1P = (float*)(ws + O_C1P);
      float* red = (float*)smem;
      for (int item = blockIdx.x; item < 64; item += gridDim.x) {
        const int kvs = item >> 5, part = item & 31;
        const float* pos = p.in[kvs ? 17 : 14];
        const float* w1 = p.in[kvs ? 18 : 15];
        const int j = tid & 127, half = tid >> 7;
        const int i0 = part * 128 + half * 64;
        float acc = 0.f;
#pragma unroll 16
        for (int i = 0; i < 64; ++i) acc += pos[i0 + i] * w1[(size_t)(i0 + i) * 128 + j];
        __syncthreads();
        red[tid] = acc;
        __syncthreads();
        if (tid < 128) C1P[(size_t)item * 128 + tid] = red[tid] + red[tid + 128];
        __syncthreads();
      }
    }
    {
      float2* sE = (float2*)smem;
      float2* sCo = sE + 64;
      float2* sM = sCo + 64;
      float2* sC = sM + 1024;
      for (int item = blockIdx.x; item < 2 * 64 * 65; item += gridDim.x) {
        const int j = item % 65, lg = item / 65;
        const float* lam_re = p.in[2] + (size_t)lg * 64;
        const float* lam_im = p.in[3] + (size_t)lg * 64;
        const float dt = __expf(p.in[4][lg]);
        const float* b_re = p.in[5] + (size_t)lg * 1024;
        const float* b_im = p.in[6] + (size_t)lg * 1024;
        const float* c_re = p.in[7] + (size_t)lg * 1024;
        const float* c_im = p.in[8] + (size_t)lg * 1024;
#pragma unroll
        for (int i = 0; i < 4; ++i) sC[tid + i * 256] = make_float2(c_re[tid + i * 256], c_im[tid + i * 256]);
        if (tid < 64) {
          const float lr = lam_re[tid], li = lam_im[tid];
          const float mag = expf(lr * dt);
          float sn, cs;
          sincosf(li * dt, &sn, &cs);
          const float ar = mag * cs, ai = mag * sn;
          const float inv = 1.f / (lr * lr + li * li);
          const float cr = ((ar - 1.f) * lr + ai * li) * inv;
          const float ci = (ai * lr - (ar - 1.f) * li) * inv;
          sCo[tid] = make_float2(cr, ci);
          const float fj = (float)j;
          const float mj = expf(lr * dt * fj);
          float sj, cj;
          sincosf(li * dt * fj, &sj, &cj);
          sE[tid] = make_float2(mj * cj, mj * sj);
          if (j == 64) A64[(size_t)lg * 64 + tid] = make_float2(mj * cj, mj * sj);
        }
        __syncthreads();
#pragma unroll
        for (int i = 0; i < 4; ++i) {
          const int idx = tid + i * 256;
          const int pp = idx >> 4, ci = idx & 15;
          const float br = b_re[idx], bi = b_im[idx];
          const float2 co = sCo[pp];
          const float bbr = co.x * br - co.y * bi, bbi = co.x * bi + co.y * br;
          const float2 e = sE[pp];
          const float mr = e.x * bbr - e.y * bbi, mi = e.x * bbi + e.y * bbr;
          sM[idx] = make_float2(mr, mi);
          if (j < 64) {
            const int s = 63 - j;
            u16* w1p = W1 + (size_t)lg * 128 * 1024;
            w1p[(size_t)pp * 1024 + s * 16 + ci] = f2bf(mr);
            w1p[(size_t)(64 + pp) * 1024 + s * 16 + ci] = f2bf(mi);
          }
        }
        __syncthreads();
        if (j < 64) {
          const int co = tid >> 4, ci = tid & 15;
          float acc = 0.f;
          for (int pp = 0; pp < 64; ++pp) {
            const float2 m = sM[pp * 16 + ci];
            const float2 c = sC[co * 64 + pp];
            acc += c.x * m.x - c.y * m.y;
          }
          KTAB[(((size_t)lg * 64 + j) * 16 + co) * 16 + ci] = f2bf(acc);
        }
        if (j >= 1) {
          const int t = j - 1;
          u16* w3p = W3T + (size_t)lg * 1024 * 128;
#pragma unroll
          for (int i = 0; i < 4; ++i) {
            const int idx = tid + i * 256;
            const int co = idx >> 6, pp = idx & 63;
            const float cr = sC[idx].x, ci = sC[idx].y;
            const float2 e = sE[pp];
            const float re = cr * e.x - ci * e.y, im = cr * e.y + ci * e.x;
            w3p[(size_t)(t * 16 + co) * 128 + pp] = f2bf(re);
            w3p[(size_t)(t * 16 + co) * 128 + 64 + pp] = f2bf(-im);
          }
        }
        __syncthreads();
      }
    }
  }
  grid.sync();

  auto kmap64 = [](int ks) { return ks * 64; };

  for (int l = 0; l < 2; ++l) {
    const float* xres = (l == 0) ? p.in[0] : XF;
    {
      const int tid = tid_l(), lane = tid & 63, wave = tid >> 6; (void)lane; (void)wave;
      if (l == 0 && blockIdx.x == 0) {
        const float* C1P = (const float*)(ws + O_C1P);
        float a = 0.f;
        for (int part = 0; part < 32; ++part) a += C1P[((size_t)(tid >> 7) * 32 + part) * 128 + (tid & 127)];
        C1B[tid] = a;
      }
      const u16* Wt = W_AIN + (size_t)l * 2048 * 2048;
      for (int tile = blockIdx.x; tile < 64 * 8; tile += gridDim.x) {
        const int mt = tile & 63, nt = tile >> 6;
        gemm_tile_w(smem, mt * 128, nt * 256, 64,
                  [=](int m, int k0, int kc) { return ldg_o(XB + k0, (uint32_t)(m * 2048 + kc) * 2u); },
                  [=](int n, int k0, int kc) { return ldg_o(Wt + k0, (uint32_t)(n * 2048 + kc) * 2u); },
                  [=](int m, int n, f32x4 v) { st_bf4(UZ + (size_t)m * 2048 + n, v); });
      }
    }
    xcd_barrier(xb);
    {
      float* sS = (float*)smem;
      if (l == 0) do_jobs((1u << 1) | (1u << 3) | (1u << 5) | (1u << 6) | (1u << 11), 64, (int)gridDim.x - 64);
      else do_jobs((1u << 12) | (1u << 13) | (1u << 14), 64, (int)gridDim.x - 64);
      for (int g = blockIdx.x; g < 64; g += gridDim.x) {
        const u16* w1p = W1 + ((size_t)l * 64 + g) * 128 * 1024;
        gemm_tile<1, false>(smem, 0, 0, 16, kmap64,
                  [=](int m, int k0, int kc) { return ldg_o(UZ + (size_t)(k0 >> 4) * 2048 + g * 16, (uint32_t)((m * 64 + (kc >> 4)) * 2048 + (kc & 15)) * 2u); },
                  [=](int n, int k0, int kc) { return ldg_o(w1p + k0, (uint32_t)(n * 1024 + kc) * 2u); },
                  [=](int m, int n, f32x4 v) { *(f32x4*)(sS + m * 132 + n) = v; });
        __syncthreads();
        const int tid = tid_l();
        if (tid < 128) {
          const int b = tid >> 6, pp = tid & 63;
          const float2 a = A64[((size_t)l * 64 + g) * 64 + pp];
          float hr = 0.f, hi = 0.f;
          const float* sp = sS + (b * 64) * 132;
          u16* hp = HIN + ((size_t)g * 128 + b * 64) * 128;
#pragma unroll 4
          for (int c = 0; c < 64; ++c) {
            hp[c * 128 + pp] = f2bf(hr);
            hp[c * 128 + 64 + pp] = f2bf(hi);
            const float sr = sp[c * 132 + pp], si = sp[c * 132 + 64 + pp];
            const float nr = a.x * hr - a.y * hi + sr;
            const float ni = a.x * hi + a.y * hr + si;
            hr = nr; hi = ni;
          }
        }
        __syncthreads();
      }
    }
    xcd_barrier(xb);
    {
      const float* dsk = p.in[9] + (size_t)l * 1024;
      for (int tile = blockIdx.x; tile < 64 * 8; tile += gridDim.x) {
        const int g = tile >> 3, nt = 7 - (tile & 7);
        const int nks1 = 2 * nt + 2;
        const u16* ktab = KTAB + ((size_t)l * 64 + g) * 64 * 256;
        const u16* w3p = W3T + ((size_t)l * 64 + g) * 1024 * 128;
        const u16* hp = HIN + (size_t)g * 128 * 128;
        gemm_tile(smem, 0, nt * 128, nks1 + 2,
                  [=](int ks) { return ks < nks1 ? ks * 64 : 1024 + (ks - nks1) * 64; },
                  [=](int m, int k0, int kc) {
                    if (k0 < 1024) return ldg_o(UZ + (size_t)(k0 >> 4) * 2048 + g * 16, (uint32_t)((m * 64 + (kc >> 4)) * 2048 + (kc & 15)) * 2u);
                    return ldg_o(hp + (k0 - 1024), (uint32_t)(m * 128 + kc) * 2u);
                  },
                  [=](int n, int k0, int kc) {
                    if (k0 < 1024) {
                      const int lag = (n >> 4) - (kc >> 4) - (k0 >> 4);
                      if (lag < 0) return make_uint4(0u, 0u, 0u, 0u);
                      return ldg_o(ktab, (uint32_t)((lag * 16 + (n & 15)) * 16 + (kc & 15)) * 2u);
                    }
                    return ldg_o(w3p + (k0 - 1024), (uint32_t)(n * 128 + kc) * 2u);
                  },
                  [=](int m, int n, f32x4 v) {
                    const int t = n >> 4, co = n & 15;
                    const size_t tok = (size_t)m * 64 + t;
                    const int ch = g * 16 + co;
                    const f32x4 u = ld_bf4(UZ + tok * 2048 + ch);
                    const f32x4 d = *(const f32x4*)(dsk + ch);
                    f32x4 r;
#pragma unroll
                    for (int i = 0; i < 4; ++i) r[i] = gelu_tanh(v[i] + d[i] * u[i]);
                    st_bf4(GB + tok * 1024 + ch, r);
                  });
      }
    }
    xcd_barrier(xb);
    {
      const u16* Wt = W_GLU + (size_t)l * 1024 * 1024;
      const float* bg = p.in[11] + (size_t)l * 1024;
      for (int tile = blockIdx.x; tile < 64 * 8; tile += gridDim.x) {
        const int mt = tile & 63, nt = tile >> 6;
        gemm_tile(smem, mt * 128, nt * 128, 16, kmap64,
                  [=](int m, int k0, int kc) { return ldg_o(GB + k0, (uint32_t)(m * 1024 + kc) * 2u); },
                  [=](int n, int k0, int kc) { return ldg_o(Wt + k0, (uint32_t)(n * 1024 + kc) * 2u); },
                  [=](int m, int n, f32x4 v) {
                    const f32x4 gg = ld_bf4(GB + (size_t)m * 1024 + n);
                    const f32x4 zz = ld_bf4(UZ + (size_t)m * 2048 + 1024 + n);
                    const f32x4 bb = *(const f32x4*)(bg + n);
                    f32x4 r;
#pragma unroll
                    for (int i = 0; i < 4; ++i) r[i] = gg[i] * sigm(v[i] + bb[i]) * silu(zz[i]);
                    st_bf4(VB + (size_t)m * 1024 + n, r);
                  });
      }
    }
    xcd_barrier(xb);
    {
      const u16* Wt = W_AOUT + (size_t)l * 2048 * 1024;
      for (int tile = blockIdx.x; tile < 64 * 8; tile += gridDim.x) {
        const int mt = tile & 63, nt = tile >> 6;
        const float2* stp = STATS;
        const float* pgam = p.in[22] + (size_t)(l > 0 ? l - 1 : 0) * 2048;
        const float* pbet = p.in[23] + (size_t)(l > 0 ? l - 1 : 0) * 2048;
        gemm_tile_w<true>(smem, mt * 128, nt * 256, 32,
                  [=](int m, int k0, int kc) { return ldg_o(VB + k0, (uint32_t)(m * 1024 + kc) * 2u); },
                  [=](int n, int k0, int kc) { return ldg_o(Wt + k0, (uint32_t)(n * 1024 + kc) * 2u); },
                  [=](int m, int n, f32x4 v, f32x4 xr) {
                    if (l > 0) {
                      const float2 st = stp[m];
                      const f32x4 gg = *(const f32x4*)(pgam + n);
                      const f32x4 bb = *(const f32x4*)(pbet + n);
#pragma unroll
                      for (int i = 0; i < 4; ++i) xr[i] = (xr[i] - st.x) * st.y * gg[i] + bb[i];
                    }
                    f32x4 r;
#pragma unroll
                    for (int i = 0; i < 4; ++i) r[i] = DN_ALPHA * xr[i] + v[i];
                    *(f32x4*)((char*)XF + (uint32_t)(m * 2048 + n) * 4u) = r;
                  },
                  [=](int m, int n) { return *(const f32x4*)((const char*)xres + (uint32_t)(m * 2048 + n) * 4u); });
      }
    }
    xcd_barrier(xb);
    {
      const int tid = tid_l(), lane = tid & 63, wave = tid >> 6; (void)lane; (void)wave;
      const float* lg_ = p.in[22] + (size_t)l * 2048;
      const float* lb_ = p.in[23] + (size_t)l * 2048;
      for (int row = blockIdx.x * 4 + wave; row < NTOK; row += gridDim.x * 4) {
        float* xr = XF + (size_t)row * 2048;
        f32x4 v[8];
        float sum = 0.f;
#pragma unroll
        for (int i = 0; i < 8; ++i) { v[i] = *(const f32x4*)(xr + i * 256 + lane * 4); sum += v[i][0] + v[i][1] + v[i][2] + v[i][3]; }
#pragma unroll
        for (int o = 32; o >= 1; o >>= 1) sum += __shfl_xor(sum, o);
        const float mu = sum * (1.f / 2048.f);
        float sq = 0.f;
#pragma unroll
        for (int i = 0; i < 8; ++i)
#pragma unroll
          for (int e = 0; e < 4; ++e) { const float d = v[i][e] - mu; sq += d * d; }
#pragma unroll
        for (int o = 32; o >= 1; o >>= 1) sq += __shfl_xor(sq, o);
        const float rstd = rsqrtf(sq * (1.f / 2048.f) + LN_EPS);
#pragma unroll
        for (int i = 0; i < 8; ++i) {
          const int c = i * 256 + lane * 4;
          const f32x4 gg = *(const f32x4*)(lg_ + c);
          const f32x4 bb = *(const f32x4*)(lb_ + c);
          f32x4 r;
#pragma unroll
          for (int e = 0; e < 4; ++e) r[e] = (v[i][e] - mu) * rstd * gg[e] + bb[e];
          st_bf4(XB + (size_t)row * 2048 + c, r);
        }
        if (lane == 0) STATS[row] = make_float2(mu, rstd);
      }
    }
    xcd_barrier(xb);
  }

  {
    for (int tile = blockIdx.x; tile < 64 * 24; tile += gridDim.x) {
      const int mt = tile & 63, nt = tile >> 6;
      gemm_tile(smem, mt * 128, nt * 128, 32, kmap64,
                [=](int m, int k0, int kc) { return ldg_o(XB + k0, (uint32_t)(m * 2048 + kc) * 2u); },
                [=](int n, int k0, int kc) { return ldg_o(W_KV + k0, (uint32_t)(n * 2048 + kc) * 2u); },
                [=](int m, int n, f32x4 v) { st_bf4(KV + (size_t)m * KV_LD + n, v); });
    }
  }
  xcd_barrier(xb);
  for (int lb = 0; lb < 2; ++lb) {
    const int layer = 2 + lb;
    {
      const u16* Wt = W_BIN + (size_t)lb * PROJ_LD * 2048;
      if (lb == 0 && blockIdx.x >= 64 && blockIdx.x < 128) {
        const int ct = blockIdx.x - 64;
        const int half = ct >> 5, kvs = (ct >> 4) & 1, mt = ct & 15;
        const u16* Wc = W_C1 + (size_t)kvs * 128 * 4096;
        float* t1 = T1P + ((size_t)(half * 2 + kvs)) * 2048 * 128;
        gemm_tile<1>(smem, mt * 128, 0, 32, [=](int ks) { return half * 2048 + ks * 64; },
                  [=](int m, int k0, int kc) {
                    const int b = m >> 10, n = (m >> 2) & 255, g = m & 3;
                    int tok = n * 16 + (k0 >> 7);
                    tok = tok > 4095 ? 4095 : tok;
                    return ldg_o(KV + kvs * 512 + (k0 & 127), (uint32_t)((b * 4096 + tok) * KV_LD + g * 128 + kc) * 2u);
                  },
                  [=](int n, int k0, int kc) { return ldg_o(Wc + k0, (uint32_t)(n * 4096 + kc) * 2u); },
                  [=](int m, int n, f32x4 v) { *(f32x4*)(t1 + (size_t)m * 128 + n) = v; });
      }
      for (int rep = 0; rep < REPS_BIN; ++rep)
      for (int tile = blockIdx.x; tile < 64 * 32; tile += gridDim.x) {
        const int mt = tile & 63, nt = tile >> 6;
        gemm_tile_w(smem, mt * 128, nt * 256, 64,
                  [=](int m, int k0, int kc) { return ldg_o(XB + k0, (uint32_t)(m * 2048 + kc) * 2u); },
                  [=](int n, int k0, int kc) { return ldg_o(Wt + k0, (uint32_t)(n * 2048 + kc) * 2u); },
                  [=](int m, int n, f32x4 v) { st_bf4(PROJ + (size_t)m * PROJ_LD + n, v); });
      }
      for (int tile = blockIdx.x; tile < 64; tile += gridDim.x) {
        const int mt = tile & 63, nt = 64;
        gemm_tile(smem, mt * 128, nt * 128, 32, kmap64,
                  [=](int m, int k0, int kc) { return ldg_o(XB + k0, (uint32_t)(m * 2048 + kc) * 2u); },
                  [=](int n, int k0, int kc) { return ldg_o(Wt + k0, (uint32_t)(n * 2048 + kc) * 2u); },
                  [=](int m, int n, f32x4 v) { st_bf4(PROJ + (size_t)m * PROJ_LD + n, v); });
      }
    }
    xcd_barrier(xb);
    if (lb == 0) {
      for (int tile = blockIdx.x; tile < 32; tile += gridDim.x) {
        const int kvs = tile >> 4, mt = tile & 15;
        const u16* Wt = W_C2 + (size_t)kvs * 128 * 128;
        const float* t1a = T1P + ((size_t)kvs) * 2048 * 128;
        const float* t1b = T1P + ((size_t)(2 + kvs)) * 2048 * 128;
        const float* cb = C1B + kvs * 128;
        u16* kc_ = KCVC + (size_t)kvs * 2048 * 128;
        gemm_tile<1>(smem, mt * 128, 0, 2, kmap64,
                  [=](int m, int k0, int kc) {
                    const int k = k0 + kc;
                    const f32x4 a0 = *(const f32x4*)(t1a + (size_t)m * 128 + k), a1 = *(const f32x4*)(t1a + (size_t)m * 128 + k + 4);
                    const f32x4 b0 = *(const f32x4*)(t1b + (size_t)m * 128 + k), b1 = *(const f32x4*)(t1b + (size_t)m * 128 + k + 4);
                    const f32x4 c0 = *(const f32x4*)(cb + k), c1 = *(const f32x4*)(cb + k + 4);
                    uint4 r;
                    r.x = pack2(gelu_tanh(a0[0] + b0[0] + c0[0]), gelu_tanh(a0[1] + b0[1] + c0[1]));
                    r.y = pack2(gelu_tanh(a0[2] + b0[2] + c0[2]), gelu_tanh(a0[3] + b0[3] + c0[3]));
                    r.z = pack2(gelu_tanh(a1[0] + b1[0] + c1[0]), gelu_tanh(a1[1] + b1[1] + c1[1]));
                    r.w = pack2(gelu_tanh(a1[2] + b1[2] + c1[2]), gelu_tanh(a1[3] + b1[3] + c1[3]));
                    return r;
                  },
                  [=](int n, int k0, int kc) { return ldg_o(Wt + k0, (uint32_t)(n * 128 + kc) * 2u); },
                  [=](int m, int n, f32x4 v) {
                    if (((m >> 2) & 255) == 255) v = f32x4{0.f, 0.f, 0.f, 0.f};
                    st_bf4(kc_ + (size_t)m * 128 + n, v);
                  });
      }
      xcd_barrier(xb);
    }
#ifndef NO_ATTN
    {
      u16* sK = smem;
      u16* sV = smem + 2 * 64 * 136;
      uint32_t* imp = (uint32_t*)(smem + 2 * 64 * 136 + 2 * 64 * 144);
      unsigned long long* selm = (unsigned long long*)(imp + 32 * 65);
      const int tid = tid_l(), lane = tid & 63, wave = tid >> 6;
      const int l15 = lane & 15, quad = lane >> 4;
      const u16* KC = KCVC;
      const u16* VC = KCVC + (size_t)2048 * 128;
      for (int rep = 0; rep < REPS_ATTN; ++rep)
      for (int item = blockIdx.x; item < 1024; item += gridDim.x) {
        const int qt = (item < 512) ? (127 - (item >> 3)) : ((item - 512) >> 3);
        const int bg = item & 7, b = bg >> 2, g = bg & 3;
        const int t0 = qt * 32, h = g * 4 + wave;
        const size_t tokbase = (size_t)b * SEQ;
        const int cur = t0 >> 6;
        if (DESYNC_COND) __builtin_amdgcn_s_sleep(60);
        for (int i = tid; i < 32 * 65; i += 256) imp[i] = 0u;
        bf16x8 qf[2][4];
#pragma unroll
        for (int qs = 0; qs < 2; ++qs)
#pragma unroll
          for (int ds = 0; ds < 4; ++ds) {
            uint4 v = ldg16(PROJ + (tokbase + t0 + qs * 16 + l15) * PROJ_LD + h * 128 + ds * 32 + quad * 8);
            union { uint4 u; bf16x8 v; } cv; cv.u = v; qf[qs][ds] = cv.v;
          }
        const int tq0 = t0 + l15, tq1 = t0 + 16 + l15;
        f32x4 o[2][8];
        float mrow[2], lrow[2], linv[2];
        auto zero_o = [&]() {
#pragma unroll
          for (int qs = 0; qs < 2; ++qs)
#pragma unroll
            for (int dt = 0; dt < 8; ++dt) o[qs][dt] = f32x4{0.f, 0.f, 0.f, 0.f};
        };
        auto finish_l = [&]() {
#pragma unroll
          for (int qs = 0; qs < 2; ++qs) {
            float lsum = lrow[qs];
            lsum += __shfl_xor(lsum, 16);
            lsum += __shfl_xor(lsum, 32);
            linv[qs] = 1.f / fmaxf(lsum, 1e-30f);
          }
        };
        auto emit = [&](int br, bool first, bool scale_l) {
          float* wbuf = (float*)smem + wave * (16 * 132);
          const int rrow = lane >> 5, rcol = (lane & 31) * 4;
          const int tb = (int)tokbase + t0;
          const uint32_t zoff0 = (uint32_t)((tb + rrow) * PROJ_LD + 2048 + br * 2048 + h * 128 + rcol) * 2u;
          const uint32_t yoff0 = (uint32_t)((tb + rrow) * 2048 + h * 128 + rcol) * 2u;
#pragma unroll
          for (int qs = 0; qs < 2; ++qs) {
            const float gate = sigm(bf2f(*(const u16*)((const char*)PROJ + (uint32_t)((tb + qs * 16 + l15) * PROJ_LD + 8192 + br * 16 + h) * 2u)));
            const float sc = scale_l ? gate * linv[qs] : gate;
#pragma unroll
            for (int dt = 0; dt < 8; ++dt) *(f32x4*)(wbuf + l15 * 132 + dt * 16 + quad * 4) = o[qs][dt] * sc;
            __builtin_amdgcn_wave_barrier();
#pragma unroll 4
            for (int j = 0; j < 8; ++j) {
              const uint32_t zo = zoff0 + (uint32_t)((qs * 16 + j * 2) * PROJ_LD) * 2u;
              const uint32_t yo = yoff0 + (uint32_t)((qs * 16 + j * 2) * 2048) * 2u;
              const f32x4 a = *(const f32x4*)(wbuf + (j * 2 + rrow) * 132 + rcol);
              const f32x4 zz = ld_bf4((const u16*)((const char*)PROJ + zo));
              u16* yp = (u16*)((char*)YB + yo);
              f32x4 r;
#pragma unroll
              for (int e = 0; e < 4; ++e) r[e] = a[e] * silu(zz[e]);
              if (!first) {
                const f32x4 old = ld_bf4(yp);
#pragma unroll
                for (int e = 0; e < 4; ++e) r[e] += old[e];
              }
              st_bf4(yp, r);
            }
          }
          __syncthreads();
        };
#ifndef NO_CMP
        {
          int nmax = t0 >> 4; if (nmax > 254) nmax = 254;
          const int ntl = (nmax >> 6) + 1;
          auto tilefn = [&](int i, const u16*& kb, const u16*& vb, size_t& rs, int& kp) {
            const size_t off = (((size_t)b * 256 + i * 64) * 4 + g) * 128;
            kb = KC + off; vb = VC + off; rs = 512; kp = i * 64;
          };
          auto valid = [&](int kpos, int qs) { return kpos * 16 + 31 <= (qs ? tq1 : tq0); };
          mrow[0] = mrow[1] = -1e30f; lrow[0] = lrow[1] = 0.f; linv[0] = linv[1] = 1.f;
          auto nobias = [](int, int) { return 0.f; };
          auto allem = [](int) { return true; };
          attn_loop<1>(sK, sV, imp, ntl, tilefn, nobias, allem, valid, qf, o, mrow, lrow, linv);
          finish_l();
          zero_o();
          attn_loop<2>(sK, sV, imp, ntl, tilefn, nobias, allem, valid, qf, o, mrow, lrow, linv);
          emit(0, true, false);
        }
#endif
        {
#pragma unroll 1
          for (int tt = 0; tt < 8; ++tt) {
            const int tok = wave * 8 + tt;
            unsigned long long mask;
            if (cur < 16) {
              mask = (2ull << cur) - 1ull;
            } else {
              const uint32_t v = imp[tok * 65 + lane];
              const bool cand = (lane >= 1) && (lane <= cur - 2);
              int rank = 0;
#pragma unroll 1
              for (int j2 = 0; j2 < 64; ++j2) {
                const uint32_t v2 = (uint32_t)__builtin_amdgcn_readlane((int)v, j2);
                const bool c2 = (j2 >= 1) && (j2 <= cur - 2);
                rank += (c2 && (v2 > v || (v2 == v && j2 < lane))) ? 1 : 0;
              }
              const bool sel = (lane == 0) || (lane == cur) || (lane == cur - 1) || (cand && rank < 13);
              mask = __ballot(sel);
            }
            if (lane == 0) selm[tok] = mask;
          }
          __syncthreads();
        }
        const unsigned long long sm0 = selm[l15], sm1 = selm[16 + l15];
#ifndef NO_SEL
        {
          auto tilefn = [&](int i, const u16*& kb, const u16*& vb, size_t& rs, int& kp) {
            const size_t off = (tokbase + (size_t)i * 64) * KV_LD + 1024 + g * 128;
            kb = KV + off; vb = KV + off + 512; rs = KV_LD; kp = i * 64;
          };
          auto valid = [&](int kpos, int qs) { return kpos <= (qs ? tq1 : tq0); };
          auto biasfn = [&](int i, int qs) { return (((qs ? sm1 : sm0) >> i) & 1ull) ? 0.f : -1e30f; };
          auto emfn = [&](int i) { return i == cur; };
          mrow[0] = mrow[1] = -1e30f; lrow[0] = lrow[1] = 0.f;
          zero_o();
          attn_loop<0>(sK, sV, imp, cur + 1, tilefn, biasfn, emfn, valid, qf, o, mrow, lrow, linv);
          finish_l();
          emit(1, false, true);
        }
#endif
#ifndef NO_WIN
        {
          int jt0 = (t0 - 511) >> 6; if (jt0 < 0) jt0 = 0;
          auto tilefn = [&](int i, const u16*& kb, const u16*& vb, size_t& rs, int& kp) {
            const size_t off = (tokbase + (size_t)(jt0 + i) * 64) * KV_LD + 2048 + g * 128;
            kb = KV + off; vb = KV + off + 512; rs = KV_LD; kp = (jt0 + i) * 64;
          };
          auto valid = [&](int kpos, int qs) {
            const int t = qs ? tq1 : tq0;
            return (kpos <= t) && (kpos > t - 512);
          };
          auto biasfn = [](int, int) { return 0.f; };
          auto emfn = [&](int i) { const int kp = (jt0 + i) * 64; return !((kp + 63 <= t0) && (kp > t0 + 31 - 512)); };
          mrow[0] = mrow[1] = -1e30f; lrow[0] = lrow[1] = 0.f;
          zero_o();
          attn_loop<0>(sK, sV, imp, cur - jt0 + 1, tilefn, biasfn, emfn, valid, qf, o, mrow, lrow, linv);
          finish_l();
          emit(2, false, true);
        }
#endif
        __syncthreads();
      }
    }
#endif
    xcd_barrier(xb);
    {
      const u16* Wt = W_BOUT + (size_t)lb * 2048 * 2048;
      for (int tile = blockIdx.x; tile < 64 * 8; tile += gridDim.x) {
        const int mt = tile & 63, nt = tile >> 6;
        const float2* stp = STATS;
        const float* pgam = p.in[22] + (size_t)(layer - 1) * 2048;
        const float* pbet = p.in[23] + (size_t)(layer - 1) * 2048;
        gemm_tile_w<true>(smem, mt * 128, nt * 256, 64,
                  [=](int m, int k0, int kc) { return ldg_o(YB + k0, (uint32_t)(m * 2048 + kc) * 2u); },
                  [=](int n, int k0, int kc) { return ldg_o(Wt + k0, (uint32_t)(n * 2048 + kc) * 2u); },
                  [=](int m, int n, f32x4 v, f32x4 xr) {
                    const float2 st = stp[m];
                    const f32x4 gg = *(const f32x4*)(pgam + n);
                    const f32x4 bb = *(const f32x4*)(pbet + n);
                    f32x4 r;
#pragma unroll
                    for (int i = 0; i < 4; ++i) r[i] = DN_ALPHA * ((xr[i] - st.x) * st.y * gg[i] + bb[i]) + v[i];
                    *(f32x4*)((char*)XF + (uint32_t)(m * 2048 + n) * 4u) = r;
                  },
                  [=](int m, int n) { return *(const f32x4*)((const char*)XF + (uint32_t)(m * 2048 + n) * 4u); });
      }
    }
    xcd_barrier(xb);
    {
      const int tid = tid_l(), lane = tid & 63, wave = tid >> 6; (void)lane; (void)wave;
      const float* lg_ = p.in[22] + (size_t)layer * 2048;
      const float* lb_ = p.in[23] + (size_t)layer * 2048;
      const bool last = (lb == 1);
      for (int row = blockIdx.x * 4 + wave; row < NTOK; row += gridDim.x * 4) {
        float* xr = XF + (size_t)row * 2048;
        float* orow = last ? (p.out + (size_t)row * 2048) : xr;
        f32x4 v[8];
        float sum = 0.f;
#pragma unroll
        for (int i = 0; i < 8; ++i) { v[i] = *(const f32x4*)(xr + i * 256 + lane * 4); sum += v[i][0] + v[i][1] + v[i][2] + v[i][3]; }
#pragma unroll
        for (int o = 32; o >= 1; o >>= 1) sum += __shfl_xor(sum, o);
        const float mu = sum * (1.f / 2048.f);
        float sq = 0.f;
#pragma unroll
        for (int i = 0; i < 8; ++i)
#pragma unroll
          for (int e = 0; e < 4; ++e) { const float d = v[i][e] - mu; sq += d * d; }
#pragma unroll
        for (int o = 32; o >= 1; o >>= 1) sq += __shfl_xor(sq, o);
        const float rstd = rsqrtf(sq * (1.f / 2048.f) + LN_EPS);
#pragma unroll
        for (int i = 0; i < 8; ++i) {
          const int c = i * 256 + lane * 4;
          const f32x4 gg = *(const f32x4*)(lg_ + c);
          const f32x4 bb = *(const f32x4*)(lb_ + c);
          f32x4 r;
#pragma unroll
          for (int e = 0; e < 4; ++e) r[e] = (v[i][e] - mu) * rstd * gg[e] + bb[e];
          if (last) *(f32x4*)(orow + c) = r;
          else st_bf4(XB + (size_t)row * 2048 + c, r);
        }
        if (!last && lane == 0) STATS[row] = make_float2(mu, rstd);
      }
    }
    if (lb == 0) xcd_barrier(xb);
  }
}

extern "C" void kernel_launch(void* const* d_in, const int* in_sizes, int n_in, void* d_out, int out_size, void* d_ws,
                              size_t ws_size, hipStream_t stream) {
  static int grid_blocks = 0;
  if (!grid_blocks) {
    int dev = 0, cus = 0, per_cu = 0;
    hipGetDevice(&dev);
    hipDeviceGetAttribute(&cus, hipDeviceAttributeMultiprocessorCount, dev);
    hipOccupancyMaxActiveBlocksPerMultiprocessor(&per_cu, yoco_fwd, 256, 0);
    if (per_cu > 2) per_cu = 2;
    if (per_cu < 1) per_cu = 1;
    grid_blocks = cus * per_cu;
  }
  Params p{};
  for (int i = 0; i < 24; ++i) p.in[i] = (const float*)d_in[i];
  p.out = (float*)d_out;
  p.ws = (char*)d_ws;
  if (ws_size < WS_TOTAL) fprintf(stderr, "workspace too small: %zu < %zu\n", ws_size, (size_t)WS_TOTAL);
  (void)hipMemsetAsync((char*)d_ws + O_BAR, 0, XCD_BAR_WORDS * 4, stream);
  void* args[] = {&p};
  hipError_t e = hipLaunchCooperativeKernel((void*)yoco_fwd, dim3(grid_blocks), dim3(256), args, 0, stream);
  if (e != hipSuccess) fprintf(stderr, "cooperative launch failed: %s (grid %d)\n", hipGetErrorString(e), grid_blocks);
}
```

```cpp
#include <hip/hip_runtime.h>
#include <hip/hip_cooperative_groups.h>
#include <stdint.h>
#include <stdio.h>
namespace cg = cooperative_groups;

typedef __attribute__((ext_vector_type(8))) short bf16x8;
typedef __attribute__((ext_vector_type(4))) short s16x4;
typedef __attribute__((ext_vector_type(4))) float f32x4;
typedef unsigned short u16;
#define DI __device__ __forceinline__

#define DESYNC_COND (blockIdx.x >= 256)
#ifndef ATT_SAFE
#define ATT_SAFE 0
#endif
#ifndef REPS_ATTN
#define REPS_ATTN 1
#endif
#ifndef REPS_BIN
#define REPS_BIN 1
#endif
#ifndef REPS_SSM
#define REPS_SSM 1
#endif
#ifndef REPS_P0
#define REPS_P0 1
#endif
constexpr int NTOK = 8192, DM = 2048, SEQ = 4096, EW = 1024;
constexpr int PROJ_LD = 8320, BIN_N = 8240, KV_LD = 3072;
constexpr float DN_ALPHA = 1.681792830507429f;
constexpr float LN_EPS = 1e-5f;
constexpr float SCALE2 = 0.08838834764831845f * 1.4426950408889634f;

constexpr size_t al256(size_t x) { return (x + 255) & ~(size_t)255; }
constexpr size_t O_WAIN = 0;
constexpr size_t O_WGLU = O_WAIN + al256((size_t)2 * 2048 * 2048 * 2);
constexpr size_t O_WAOUT = O_WGLU + al256((size_t)2 * 1024 * 1024 * 2);
constexpr size_t O_WKV = O_WAOUT + al256((size_t)2 * 2048 * 1024 * 2);
constexpr size_t O_WC1 = O_WKV + al256((size_t)3072 * 2048 * 2);
constexpr size_t O_WC2 = O_WC1 + al256((size_t)2 * 128 * 4096 * 2);
constexpr size_t O_WBIN = O_WC2 + al256((size_t)2 * 128 * 128 * 2);
constexpr size_t O_WBOUT = O_WBIN + al256((size_t)2 * PROJ_LD * 2048 * 2);
constexpr size_t O_XB = O_WBOUT + al256((size_t)2 * 2048 * 2048 * 2);
constexpr size_t O_XF = O_XB + al256((size_t)NTOK * DM * 2);
constexpr size_t O_KV = O_XF + al256((size_t)NTOK * DM * 4);
constexpr size_t O_T1 = O_KV + al256((size_t)NTOK * KV_LD * 2);
constexpr size_t O_KCVC = O_T1 + al256((size_t)2 * 2 * 2048 * 128 * 4);
constexpr size_t O_C1B = O_KCVC + al256((size_t)2 * 2048 * 128 * 2);
constexpr size_t O_C1P = O_C1B + al256((size_t)2 * 128 * 4);
constexpr size_t O_BAR = O_C1P + al256((size_t)64 * 128 * 4);
constexpr size_t O_STATS = O_BAR + al256((size_t)4096 * 4);
constexpr size_t O_YB = O_STATS + al256((size_t)NTOK * 8);
constexpr size_t O_UNION = O_YB + al256((size_t)NTOK * DM * 2);
constexpr size_t O_UZ = O_UNION;
constexpr size_t O_G = O_UZ + al256((size_t)NTOK * 2048 * 2);
constexpr size_t O_V = O_G + al256((size_t)NTOK * 1024 * 2);
constexpr size_t O_S = O_V + al256((size_t)NTOK * 1024 * 2);
constexpr size_t O_HIN = O_S + al256((size_t)64 * 128 * 128 * 4);
constexpr size_t O_W1 = O_HIN + al256((size_t)64 * 128 * 128 * 2);
constexpr size_t O_W3T = O_W1 + al256((size_t)2 * 64 * 128 * 1024 * 2);
constexpr size_t O_KTAB = O_W3T + al256((size_t)2 * 64 * 1024 * 128 * 2);
constexpr size_t O_A64 = O_KTAB + al256((size_t)2 * 64 * 64 * 256 * 2);
constexpr size_t O_S5END = O_A64 + al256((size_t)2 * 64 * 64 * 8);
constexpr size_t O_PROJ = O_UNION;
constexpr size_t O_PROJEND = O_PROJ + al256((size_t)NTOK * PROJ_LD * 2);
constexpr size_t WS_TOTAL = (O_S5END > O_PROJEND ? O_S5END : O_PROJEND);

struct Params {
  const float* in[24];
  float* out;
  char* ws;
};

DI u16 f2bf(float f) { uint32_t u = __float_as_uint(f); u += 0x7fffu + ((u >> 16) & 1u); return (u16)(u >> 16); }
typedef float f32x2_t __attribute__((ext_vector_type(2)));
typedef __bf16 bf16x2_t __attribute__((ext_vector_type(2)));
DI uint32_t pack2(float a, float b) { f32x2_t v = {a, b}; bf16x2_t h = __builtin_convertvector(v, bf16x2_t); return __builtin_bit_cast(uint32_t, h); }
DI float bflo(uint32_t v) { return __uint_as_float(v << 16); }
DI float bfhi(uint32_t v) { return __uint_as_float(v & 0xffff0000u); }
DI float bf2f(u16 h) { return __uint_as_float(((uint32_t)h) << 16); }
DI uint4 ldg16(const void* p) { return *(const uint4*)p; }
DI uint4 ldg_o(const void* base, uint32_t byte_off) { return *(const uint4*)((const char*)base + byte_off); }
DI float sigm(float x) { return __builtin_amdgcn_rcpf(1.f + __expf(-x)); }
DI float silu(float x) { return x * sigm(x); }
DI float gelu_tanh(float x) { float u = 0.7978845608028654f * (x + 0.044715f * x * x * x); return x * sigm(2.f * u); }
DI void st_bf4(u16* p, f32x4 v) { uint2 o; o.x = pack2(v[0], v[1]); o.y = pack2(v[2], v[3]); *(uint2*)p = o; }
DI f32x4 ld_bf4(const u16* p) { uint2 o = *(const uint2*)p; f32x4 r; r[0] = bflo(o.x); r[1] = bfhi(o.x); r[2] = bflo(o.y); r[3] = bfhi(o.y); return r; }

DI int tid_l() { int t = threadIdx.x; asm volatile("" : "+v"(t)); return t; }


#define XB_TMO      128
#define XB_XCNT(j)  (256  + 64 * (j))
#define XB_XSUB(j)  (1280 + 64 * (j))
#define XB_XGEN(j)  (2304 + 64 * (j))
#define XB_TOP      3328
#define XB_TOPGEN   3392
#define XCD_BAR_WORDS 3456
#define XB_SPIN_CAP (1u << 22)
#define LAS __attribute__((address_space(3)))
DI unsigned xb_ld(unsigned* p) { return __hip_atomic_load(p, __ATOMIC_RELAXED, __HIP_MEMORY_SCOPE_AGENT); }
DI unsigned xb_add(unsigned* p, unsigned v) { return __hip_atomic_fetch_add(p, v, __ATOMIC_RELAXED, __HIP_MEMORY_SCOPE_AGENT); }
DI unsigned xb_xcc_id() { return (unsigned)__builtin_amdgcn_s_getreg((3 << 11) | 20) & 0xFu; }
#define XB_SPIN(cond, bar) do { unsigned _sp = 0; while (cond) { __builtin_amdgcn_s_sleep(1); \
    if ((++_sp & 255u) == 0u) { if (xb_ld(&(bar)[XB_TMO])) break; if (_sp > XB_SPIN_CAP) { atomicAdd(&(bar)[XB_TMO], 1u); break; } } } } while (0)
struct XcdBarrier { unsigned* bar; unsigned x; volatile LAS unsigned* st; };
DI XcdBarrier xcd_barrier_post(unsigned* bar, volatile LAS unsigned* st) {
  XcdBarrier b; b.bar = bar; b.x = xb_xcc_id(); b.st = st;
  if (threadIdx.x == 0) (void)xb_add(&bar[XB_XCNT(b.x)], 1u);
  return b;
}
DI void xcd_barrier_complete(unsigned* bar, unsigned x, unsigned& nloc, unsigned& nx) {
  const unsigned G = gridDim.x * gridDim.y * gridDim.z;
  unsigned sum, cnt, mine, sp = 0u;
  for (;;) {
    sum = 0u; cnt = 0u; mine = 0u;
#pragma unroll
    for (unsigned j = 0; j < 16; ++j) { const unsigned c = xb_ld(&bar[XB_XCNT(j)]); sum += c; cnt += (c > 0u) ? 1u : 0u; mine = (j == x) ? c : mine; }
    if (sum == G) break;
    __builtin_amdgcn_s_sleep(1);
    if ((++sp & 255u) == 0u) { if (xb_ld(&bar[XB_TMO])) break; if (sp > XB_SPIN_CAP) { atomicAdd(&bar[XB_TMO], 1u); break; } }
  }
  nloc = mine > 0u ? mine : 1u; nx = cnt > 0u ? cnt : 1u;
}
DI void xcd_barrier(const XcdBarrier& b) {
  asm volatile("s_waitcnt vmcnt(0)" ::: "memory");
  __syncthreads();
  if (threadIdx.x == 0) {
    unsigned* bar = b.bar;
    __builtin_amdgcn_s_waitcnt(0);
    unsigned nloc = b.st[0], nx = b.st[1];
    if (nloc == 0u) { xcd_barrier_complete(bar, b.x, nloc, nx); b.st[0] = nloc; b.st[1] = nx; }
    const unsigned old = xb_add(&bar[XB_XSUB(b.x)], 1u);
    const unsigned gen = old / nloc;
    if (old + 1u == (gen + 1u) * nloc) {
      __builtin_amdgcn_fence(__ATOMIC_RELEASE, "agent");
      asm volatile("s_waitcnt vmcnt(0)" ::: "memory");
      const unsigned og = xb_add(&bar[XB_TOP], 1u);
      const unsigned tg = og / nx;
      if (og + 1u == (tg + 1u) * nx) xb_add(&bar[XB_TOPGEN], 1u);
      else XB_SPIN(xb_ld(&bar[XB_TOPGEN]) == tg, bar);
      __builtin_amdgcn_fence(__ATOMIC_ACQUIRE, "agent");
      xb_add(&bar[XB_XGEN(b.x)], 1u);
      asm volatile("s_waitcnt vmcnt(0)" ::: "memory");
    } else {
      XB_SPIN(xb_ld(&bar[XB_XGEN(b.x)]) == gen, bar);
      __builtin_amdgcn_fence(__ATOMIC_ACQUIRE, "agent");
      asm volatile("s_waitcnt vmcnt(0)" ::: "memory");
    }
  }
  __syncthreads();
}

template <int DEPTH = 2, bool STAGED = true, class KMAP, class LA, class LW, class EPI>
DI void gemm_tile(u16* smem, int m0, int n0, int nks, KMAP kmap, LA loadA, LW loadW, EPI epi) {
  const int tid = tid_l(), lane = tid & 63, wave = tid >> 6;
  const int wm = wave >> 1, wn = wave & 1, l15 = lane & 15, quad = lane >> 4;
  u16* sX = smem;
  u16* sW = smem + 2 * 128 * 64;
  f32x4 acc[4][4];
#pragma unroll
  for (int i = 0; i < 4; ++i)
#pragma unroll
    for (int j = 0; j < 4; ++j) acc[i][j] = f32x4{0.f, 0.f, 0.f, 0.f};
  uint4 ra0[4], rw0[4], ra1[4], rw1[4];
  const int lrow = tid >> 3, lkc = (tid & 7) * 8;
  const int wpos = (((tid & 7) ^ ((tid >> 4) & 7)) * 8);
  const int rsw = (l15 >> 1) & 7;
  const int rp0 = ((quad ^ rsw) * 8), rp1 = (((4 + quad) ^ rsw) * 8);
#define G_LOAD(RA, RW, KS) { const int k0_ = __builtin_amdgcn_readfirstlane(kmap(KS)); _Pragma("unroll") for (int i = 0; i < 4; ++i) { RA[i] = loadA(m0 + lrow + i * 32, k0_, lkc); RW[i] = loadW(n0 + lrow + i * 32, k0_, lkc); } }
#define G_STORE(RA, RW, BUF) { u16* dx_ = sX + (BUF) * 128 * 64; u16* dw_ = sW + (BUF) * 128 * 64; _Pragma("unroll") for (int i = 0; i < 4; ++i) { \
    *(uint4*)(dx_ + (lrow + i * 32) * 64 + wpos) = RA[i]; *(uint4*)(dw_ + (lrow + i * 32) * 64 + wpos) = RW[i]; } }
#define G_COMPUTE(BUF, FENCE) { const u16* bx = sX + (BUF) * 128 * 64 + (wm * 64 + l15) * 64; const u16* bw = sW + (BUF) * 128 * 64 + (wn * 64 + l15) * 64; \
    bf16x8 xf[2][4], wf[2][4]; \
    _Pragma("unroll") for (int i = 0; i < 4; ++i) { \
      xf[0][i] = *(const bf16x8*)(bx + i * 16 * 64 + rp0); wf[0][i] = *(const bf16x8*)(bw + i * 16 * 64 + rp0); } \
    _Pragma("unroll") for (int i = 0; i < 4; ++i) { \
      xf[1][i] = *(const bf16x8*)(bx + i * 16 * 64 + rp1); wf[1][i] = *(const bf16x8*)(bw + i * 16 * 64 + rp1); } \
    if (FENCE) __builtin_amdgcn_sched_barrier(0); \
    _Pragma("unroll") for (int kk = 0; kk < 2; ++kk) { \
      _Pragma("unroll") for (int ni = 0; ni < 4; ++ni) _Pragma("unroll") for (int mi = 0; mi < 4; ++mi) \
          acc[ni][mi] = __builtin_amdgcn_mfma_f32_16x16x32_bf16(wf[kk][ni], xf[kk][mi], acc[ni][mi], 0, 0, 0); \
      if (FENCE) __builtin_amdgcn_sched_barrier(0); } }
#define G_PATTERN { __builtin_amdgcn_sched_group_barrier(0x100, 16, 0); \
    _Pragma("unroll") for (int q_ = 0; q_ < 8; ++q_) { __builtin_amdgcn_sched_group_barrier(0x008, 2, 0); __builtin_amdgcn_sched_group_barrier(0x020, 1, 0); } \
    _Pragma("unroll") for (int q_ = 0; q_ < 8; ++q_) { __builtin_amdgcn_sched_group_barrier(0x008, 2, 0); __builtin_amdgcn_sched_group_barrier(0x200, 1, 0); } }
  if (DEPTH == 2) {
    G_LOAD(ra0, rw0, 0);
    G_LOAD(ra1, rw1, 1);
    G_STORE(ra0, rw0, 0);
    __syncthreads();
    for (int ks = 0; ks < nks; ks += 2) {
      G_LOAD(ra0, rw0, (ks + 2 < nks ? ks + 2 : nks - 1));
      G_COMPUTE(0, 0);
      G_STORE(ra1, rw1, 1);
      G_PATTERN;
      __syncthreads();
      G_LOAD(ra1, rw1, (ks + 3 < nks ? ks + 3 : nks - 1));
      G_COMPUTE(1, 0);
      G_STORE(ra0, rw0, 0);
      G_PATTERN;
      __syncthreads();
    }
  } else {
    G_LOAD(ra0, rw0, 0);
    G_STORE(ra0, rw0, 0);
    __syncthreads();
    for (int ks = 0; ks < nks; ++ks) {
      const int buf = ks & 1;
      if (ks + 1 < nks) G_LOAD(ra0, rw0, ks + 1);
      G_COMPUTE(buf, 1);
      if (ks + 1 < nks) G_STORE(ra0, rw0, buf ^ 1);
      __syncthreads();
    }
  }
#undef G_LOAD
#undef G_STORE
#undef G_COMPUTE
#undef G_PATTERN
  if constexpr (!STAGED) {
#pragma unroll
    for (int ni = 0; ni < 4; ++ni)
#pragma unroll
      for (int mi = 0; mi < 4; ++mi)
        epi(m0 + wm * 64 + mi * 16 + l15, n0 + wn * 64 + ni * 16 + quad * 4, acc[ni][mi]);
  } else {
    float* wbuf = (float*)smem + wave * (16 * 68);
    const int rrow = lane >> 4, rcol = (lane & 15) * 4;
#pragma unroll
    for (int mi = 0; mi < 4; ++mi) {
#pragma unroll
      for (int ni = 0; ni < 4; ++ni) *(f32x4*)(wbuf + l15 * 68 + ni * 16 + quad * 4) = acc[ni][mi];
      __builtin_amdgcn_wave_barrier();
#pragma unroll
      for (int j = 0; j < 4; ++j) {
        const f32x4 a = *(const f32x4*)(wbuf + (j * 4 + rrow) * 68 + rcol);
        epi(m0 + wm * 64 + mi * 16 + j * 4 + rrow, n0 + wn * 64 + rcol, a);
      }
    }
    __syncthreads();
  }
}

template <bool HASPRE = false, class LA, class LW, class EPI, class PRE = int>
DI void gemm_tile_w(u16* smem, int m0, int n0, int nks, LA loadA, LW loadW, EPI epi, PRE pre = 0) {
  const int tid = tid_l(), lane = tid & 63, wave = tid >> 6;
  const int wm = wave >> 1, wn = wave & 1, l15 = lane & 15, quad = lane >> 4;
  u16* sX = smem;
  u16* sW = smem + 2 * 128 * 32;
  f32x4 acc[8][4];
#pragma unroll
  for (int i = 0; i < 8; ++i)
#pragma unroll
    for (int j = 0; j < 4; ++j) acc[i][j] = f32x4{0.f, 0.f, 0.f, 0.f};
  uint4 ra0[2], rw0[4], ra1[2], rw1[4];
  const int lrow = tid >> 2, lkc = (tid & 3) * 8;
  const int wpos = ((tid & 3) ^ ((0 - (tid >> 4)) & 3)) * 8;
  const int rpos = (quad ^ ((0 - (l15 >> 2)) & 3)) * 8;
#define W_LOAD(RA, RW, KS) { const int k0_ = __builtin_amdgcn_readfirstlane((KS) * 32); \
    _Pragma("unroll") for (int i = 0; i < 2; ++i) RA[i] = loadA(m0 + lrow + i * 64, k0_, lkc); \
    _Pragma("unroll") for (int i = 0; i < 4; ++i) RW[i] = loadW(n0 + lrow + i * 64, k0_, lkc); }
#define W_STORE(RA, RW, BUF) { u16* dx_ = sX + (BUF) * 128 * 32; u16* dw_ = sW + (BUF) * 256 * 32; \
    _Pragma("unroll") for (int i = 0; i < 2; ++i) *(uint4*)(dx_ + (lrow + i * 64) * 32 + wpos) = RA[i]; \
    _Pragma("unroll") for (int i = 0; i < 4; ++i) *(uint4*)(dw_ + (lrow + i * 64) * 32 + wpos) = RW[i]; }
#define W_COMPUTE(BUF) { const u16* bx = sX + (BUF) * 128 * 32 + (wm * 64 + l15) * 32 + rpos; const u16* bw = sW + (BUF) * 256 * 32 + (wn * 128 + l15) * 32 + rpos; \
    bf16x8 xf[4], wf[8]; \
    _Pragma("unroll") for (int i = 0; i < 4; ++i) xf[i] = *(const bf16x8*)(bx + i * 16 * 32); \
    _Pragma("unroll") for (int i = 0; i < 8; ++i) wf[i] = *(const bf16x8*)(bw + i * 16 * 32); \
    _Pragma("unroll") for (int ni = 0; ni < 8; ++ni) _Pragma("unroll") for (int mi = 0; mi < 4; ++mi) \
        acc[ni][mi] = __builtin_amdgcn_mfma_f32_16x16x32_bf16(wf[ni], xf[mi], acc[ni][mi], 0, 0, 0); }
#define W_PATTERN { __builtin_amdgcn_sched_group_barrier(0x100, 12, 0); \
    _Pragma("unroll") for (int q_ = 0; q_ < 6; ++q_) { __builtin_amdgcn_sched_group_barrier(0x008, 2, 0); __builtin_amdgcn_sched_group_barrier(0x020, 1, 0); } \
    _Pragma("unroll") for (int q_ = 0; q_ < 6; ++q_) { __builtin_amdgcn_sched_group_barrier(0x008, 3, 0); __builtin_amdgcn_sched_group_barrier(0x200, 1, 0); } \
    __builtin_amdgcn_sched_group_barrier(0x008, 2, 0); }
  W_LOAD(ra0, rw0, 0);
  W_LOAD(ra1, rw1, 1);
  W_STORE(ra0, rw0, 0);
  __syncthreads();
  for (int ks = 0; ks < nks; ks += 2) {
    W_LOAD(ra0, rw0, (ks + 2 < nks ? ks + 2 : nks - 1));
    W_COMPUTE(0);
    W_STORE(ra1, rw1, 1);
    W_PATTERN;
    __syncthreads();
    W_LOAD(ra1, rw1, (ks + 3 < nks ? ks + 3 : nks - 1));
    W_COMPUTE(1);
    W_STORE(ra0, rw0, 0);
    W_PATTERN;
    __syncthreads();
  }
#undef W_LOAD
#undef W_STORE
#undef W_COMPUTE
#undef W_PATTERN
  if constexpr (HASPRE) {
    float* wbuf = (float*)smem + wave * (16 * 132);
    const int rrow = lane >> 5, rcol = (lane & 31) * 4;
#pragma unroll
    for (int mi = 0; mi < 4; ++mi) {
#pragma unroll
      for (int ni = 0; ni < 8; ++ni) *(f32x4*)(wbuf + l15 * 132 + ni * 16 + quad * 4) = acc[ni][mi];
      __builtin_amdgcn_wave_barrier();
      f32x4 pv[8];
#pragma unroll
      for (int j = 0; j < 8; ++j) pv[j] = pre(m0 + wm * 64 + mi * 16 + j * 2 + rrow, n0 + wn * 128 + rcol);
#pragma unroll
      for (int j = 0; j < 8; ++j) {
        const f32x4 a = *(const f32x4*)(wbuf + (j * 2 + rrow) * 132 + rcol);
        epi(m0 + wm * 64 + mi * 16 + j * 2 + rrow, n0 + wn * 128 + rcol, a, pv[j]);
      }
    }
    __syncthreads();
  } else {
    float* wbuf = (float*)smem + wave * (16 * 132);
    const int rrow = lane >> 5, rcol = (lane & 31) * 4;
#pragma unroll
    for (int mi = 0; mi < 4; ++mi) {
#pragma unroll
      for (int ni = 0; ni < 8; ++ni) *(f32x4*)(wbuf + l15 * 132 + ni * 16 + quad * 4) = acc[ni][mi];
      __builtin_amdgcn_wave_barrier();
#pragma unroll
      for (int j = 0; j < 8; ++j) {
        const f32x4 a = *(const f32x4*)(wbuf + (j * 2 + rrow) * 132 + rcol);
        epi(m0 + wm * 64 + mi * 16 + j * 2 + rrow, n0 + wn * 128 + rcol, a);
      }
    }
    __syncthreads();
  }
}

DI void tconv(float* tl, const float* src, u16* dst, int K, int N, int Npad, int b0, int nb) {
  const int tid = tid_l();
  const int nkt = K >> 6, nnt = Npad >> 6, ntl = nkt * nnt;
  const int r = tid >> 4, c4 = (tid & 15) * 4;
  float4 v[4];
  int tile = (int)blockIdx.x - b0;
  auto ld = [&](int t) {
    const int kt = t % nkt, nt = t / nkt;
    const int k0 = kt * 64, n0 = nt * 64;
#pragma unroll
    for (int i = 0; i < 4; ++i) {
      v[i] = make_float4(0.f, 0.f, 0.f, 0.f);
      if (n0 + c4 < N) v[i] = *(const float4*)(src + (size_t)(k0 + r + i * 16) * N + n0 + c4);
    }
  };
  if (tile < ntl) ld(tile);
  for (; tile < ntl; tile += nb) {
    const int kt = tile % nkt, nt = tile / nkt;
    const int k0 = kt * 64, n0 = nt * 64;
#pragma unroll
    for (int i = 0; i < 4; ++i) {
      const int k = r + i * 16;
      tl[k * 65 + c4 + 0] = v[i].x; tl[k * 65 + c4 + 1] = v[i].y; tl[k * 65 + c4 + 2] = v[i].z; tl[k * 65 + c4 + 3] = v[i].w;
    }
    if (tile + nb < ntl) ld(tile + nb);
    __syncthreads();
#pragma unroll
    for (int i = 0; i < 2; ++i) {
      const int c = tid + i * 256;
      const int n = c >> 3, k8 = (c & 7) * 8;
      uint4 o;
      o.x = pack2(tl[(k8 + 0) * 65 + n], tl[(k8 + 1) * 65 + n]);
      o.y = pack2(tl[(k8 + 2) * 65 + n], tl[(k8 + 3) * 65 + n]);
      o.z = pack2(tl[(k8 + 4) * 65 + n], tl[(k8 + 5) * 65 + n]);
      o.w = pack2(tl[(k8 + 6) * 65 + n], tl[(k8 + 7) * 65 + n]);
      *(uint4*)(dst + (size_t)(n0 + n) * K + k0 + k8) = o;
    }
    __syncthreads();
  }
}

template <int MODE, class TILE, class BIAS, class EM, class MASK>
DI void attn_loop(u16* sK, u16* sV, uint32_t* imp, int ntiles, TILE tilefn, BIAS biasfn, EM emfn, MASK valid, const bf16x8 (&qf)[2][4],
                  f32x4 (&o)[2][8], float (&mrow)[2], float (&lrow)[2], const float (&linv)[2]) {
  const int tid = tid_l(), lane = tid & 63;
  const int l15 = lane & 15, quad = lane >> 4;
  const int lr = tid >> 4, lc = (tid & 15) * 8;
  uint4 rk[4];
#define K_LOAD(IT) { const u16 *kb_, *vb_; size_t rs_; int kp_; tilefn(IT, kb_, vb_, rs_, kp_); _Pragma("unroll") for (int i = 0; i < 4; ++i) rk[i] = ldg_o(kb_, (uint32_t)((lr + i * 16) * (int)rs_ + lc) * 2u); }
#define V_LOAD_G(IT) { const u16 *kb_, *vb_; size_t rs_; int kp_; tilefn(IT, kb_, vb_, rs_, kp_); _Pragma("unroll") for (int i = 0; i < 4; ++i) rk[i] = ldg_o(vb_, (uint32_t)((lr + i * 16) * (int)rs_ + lc) * 2u); }
#define K_STORE(BUF) { _Pragma("unroll") for (int i = 0; i < 4; ++i) *(uint4*)(sK + (BUF) * 64 * 136 + (lr + i * 16) * 136 + lc) = rk[i]; }
#define V_STORE(BUF) { _Pragma("unroll") for (int i = 0; i < 4; ++i) *(uint4*)(sV + (BUF) * 64 * 144 + (lr + i * 16) * 144 + lc) = rk[i]; }
  auto compute = [&](const int buf, const int it, auto midfn) {
    int kpos0;
    { const u16 *kb, *vb; size_t rs; tilefn(it, kb, vb, rs, kpos0); }
    f32x4 s[4][2];
#pragma unroll
    for (int kc = 0; kc < 4; ++kc) { s[kc][0] = f32x4{0.f, 0.f, 0.f, 0.f}; s[kc][1] = f32x4{0.f, 0.f, 0.f, 0.f}; }
    const u16* kbase = sK + buf * 64 * 136 + l15 * 136 + quad * 8;
    {
      bf16x8 kf[2][2];
      kf[0][0] = *(const bf16x8*)(kbase);
      kf[0][1] = *(const bf16x8*)(kbase + 32);
#pragma unroll
      for (int h = 0; h < 8; ++h) {
        const int kc = h >> 1, dh = h & 1;
        if (h < 7) {
          const int kc2 = (h + 1) >> 1, dh2 = (h + 1) & 1;
          kf[(h + 1) & 1][0] = *(const bf16x8*)(kbase + kc2 * 16 * 136 + (dh2 * 2) * 32);
          kf[(h + 1) & 1][1] = *(const bf16x8*)(kbase + kc2 * 16 * 136 + (dh2 * 2 + 1) * 32);
        }
#pragma unroll
        for (int e = 0; e < 2; ++e) {
          const int ds = dh * 2 + e;
          s[kc][0] = __builtin_amdgcn_mfma_f32_16x16x32_bf16(kf[h & 1][e], qf[0][ds], s[kc][0], 0, 0, 0);
          s[kc][1] = __builtin_amdgcn_mfma_f32_16x16x32_bf16(kf[h & 1][e], qf[1][ds], s[kc][1], 0, 0, 0);
        }
        __builtin_amdgcn_sched_barrier(0);
      }
    }
    midfn();
    float mx[2] = {-1e30f, -1e30f};
    if (MODE == 0) {
      const float bias0 = biasfn(it, 0), bias1 = biasfn(it, 1);
      const bool em = ATT_SAFE || emfn(it);
      if (em) {
#pragma unroll
        for (int kc = 0; kc < 4; ++kc)
#pragma unroll
          for (int qs = 0; qs < 2; ++qs)
#pragma unroll
            for (int r = 0; r < 4; ++r) {
              const int kpos = kpos0 + kc * 16 + quad * 4 + r;
              const float x = valid(kpos, qs) ? fmaf(s[kc][qs][r], SCALE2, qs ? bias1 : bias0) : -1e30f;
              s[kc][qs][r] = x;
              mx[qs] = fmaxf(mx[qs], x);
            }
      } else {
        float r0 = -3e38f, r1 = -3e38f;
#pragma unroll
        for (int kc = 0; kc < 4; ++kc)
#pragma unroll
          for (int r = 0; r < 4; ++r) { r0 = fmaxf(r0, s[kc][0][r]); r1 = fmaxf(r1, s[kc][1][r]); }
        mx[0] = fmaf(r0, SCALE2, bias0);
        mx[1] = fmaf(r1, SCALE2, bias1);
      }
      float al[2];
#pragma unroll
      for (int qs = 0; qs < 2; ++qs) {
        float m = mx[qs];
        m = fmaxf(m, __shfl_xor(m, 16));
        m = fmaxf(m, __shfl_xor(m, 32));
        const float mnew = fmaxf(mrow[qs], m);
        al[qs] = __builtin_amdgcn_exp2f(mrow[qs] - mnew);
        mrow[qs] = mnew;
      }
      if (__builtin_amdgcn_ballot_w64(al[0] < 1.f || al[1] < 1.f) != 0ull) {
#pragma unroll
        for (int qs = 0; qs < 2; ++qs) {
          lrow[qs] *= al[qs];
#pragma unroll
          for (int dt = 0; dt < 8; ++dt) o[qs][dt] *= al[qs];
        }
      }
      if (em) {
#pragma unroll
        for (int kc = 0; kc < 4; ++kc)
#pragma unroll
          for (int qs = 0; qs < 2; ++qs)
#pragma unroll
            for (int r = 0; r < 4; ++r) {
              float pv = __builtin_amdgcn_exp2f(s[kc][qs][r] - mrow[qs]);
              if (ATT_SAFE) pv = (s[kc][qs][r] > -1e29f) ? pv : 0.f;
              lrow[qs] += pv;
              s[kc][qs][r] = pv;
            }
      } else {
        const float c0 = bias0 - mrow[0], c1 = bias1 - mrow[1];
#pragma unroll
        for (int kc = 0; kc < 4; ++kc)
#pragma unroll
          for (int qs = 0; qs < 2; ++qs)
#pragma unroll
            for (int r = 0; r < 4; ++r) {
              const float pv = __builtin_amdgcn_exp2f(fmaf(s[kc][qs][r], SCALE2, qs ? c1 : c0));
              lrow[qs] += pv;
              s[kc][qs][r] = pv;
            }
      }
    } else {
#pragma unroll
      for (int kc = 0; kc < 4; ++kc)
#pragma unroll
        for (int qs = 0; qs < 2; ++qs)
#pragma unroll
          for (int r = 0; r < 4; ++r) {
            const int kpos = kpos0 + kc * 16 + quad * 4 + r;
            const float x = valid(kpos, qs) ? s[kc][qs][r] * SCALE2 : -1e30f;
            s[kc][qs][r] = x;
            mx[qs] = fmaxf(mx[qs], x);
          }
      if (MODE == 1) {
#pragma unroll
        for (int qs = 0; qs < 2; ++qs) {
          float m = mx[qs];
          m = fmaxf(m, __shfl_xor(m, 16));
          m = fmaxf(m, __shfl_xor(m, 32));
          const float mnew = fmaxf(mrow[qs], m);
          const float alpha = __builtin_amdgcn_exp2f(mrow[qs] - mnew);
          mrow[qs] = mnew;
          lrow[qs] *= alpha;
        }
      }
#pragma unroll
      for (int kc = 0; kc < 4; ++kc)
#pragma unroll
        for (int qs = 0; qs < 2; ++qs)
#pragma unroll
          for (int r = 0; r < 4; ++r) {
            const float x = s[kc][qs][r];
            float pv = (x > -1e29f) ? __builtin_amdgcn_exp2f(x - mrow[qs]) : 0.f;
            if (MODE == 2) pv *= linv[qs];
            else lrow[qs] += pv;
            s[kc][qs][r] = pv;
          }
    }
    if (MODE == 2) {
#pragma unroll
      for (int kc = 0; kc < 4; ++kc)
#pragma unroll
        for (int qs = 0; qs < 2; ++qs) {
          const int jb = (kpos0 >> 2) + kc * 4 + quad;
          const float a = s[kc][qs][0] + s[kc][qs][1] + s[kc][qs][2] + s[kc][qs][3];
          const float b3 = s[kc][qs][3];
          if (jb < 64) atomicAdd(&imp[(qs * 16 + l15) * 65 + jb], (uint32_t)(a * 67108864.f + 0.5f));
          if (jb + 1 < 64) atomicAdd(&imp[(qs * 16 + l15) * 65 + jb + 1], (uint32_t)(b3 * 67108864.f + 0.5f));
        }
    }
    if (MODE != 1) {
      bf16x8 pb[2][2];
#pragma unroll
      for (int j = 0; j < 2; ++j)
#pragma unroll
        for (int qs = 0; qs < 2; ++qs) {
          union { bf16x8 v; uint32_t u[4]; } cv;
          cv.u[0] = pack2(s[2 * j][qs][0], s[2 * j][qs][1]);
          cv.u[1] = pack2(s[2 * j][qs][2], s[2 * j][qs][3]);
          cv.u[2] = pack2(s[2 * j + 1][qs][0], s[2 * j + 1][qs][1]);
          cv.u[3] = pack2(s[2 * j + 1][qs][2], s[2 * j + 1][qs][3]);
          pb[j][qs] = cv.v;
        }
      const u16* vbase = sV + buf * 64 * 144 + (4 * quad + (l15 >> 2)) * 144 + (l15 & 3) * 4;
      bf16x8 vf[2][4];
#define V_LOAD(DST, G) { _Pragma("unroll") for (int d = 0; d < 4; ++d) { const u16* a0 = vbase + (32 * ((G) >> 1)) * 144 + (((G) & 1) * 4 + d) * 16; \
        s16x4 lo = __builtin_amdgcn_ds_read_tr16_b64_v4i16((__attribute__((address_space(3))) s16x4*)(a0)); \
        s16x4 hi = __builtin_amdgcn_ds_read_tr16_b64_v4i16((__attribute__((address_space(3))) s16x4*)(a0 + 16 * 144)); \
        bf16x8 t; t[0] = lo[0]; t[1] = lo[1]; t[2] = lo[2]; t[3] = lo[3]; t[4] = hi[0]; t[5] = hi[1]; t[6] = hi[2]; t[7] = hi[3]; DST[d] = t; } }
      V_LOAD(vf[0], 0);
#pragma unroll
      for (int g = 0; g < 4; ++g) {
        if (g < 3) V_LOAD(vf[(g + 1) & 1], g + 1);
#pragma unroll
        for (int d = 0; d < 4; ++d) {
          const int dt = (g & 1) * 4 + d;
          o[0][dt] = __builtin_amdgcn_mfma_f32_16x16x32_bf16(vf[g & 1][d], pb[g >> 1][0], o[0][dt], 0, 0, 0);
          o[1][dt] = __builtin_amdgcn_mfma_f32_16x16x32_bf16(vf[g & 1][d], pb[g >> 1][1], o[1][dt], 0, 0, 0);
        }
        __builtin_amdgcn_sched_barrier(0);
      }
#undef V_LOAD
    }
  };
  K_LOAD(0); K_STORE(0);
  V_LOAD_G(0); V_STORE(0);
  __syncthreads();
  for (int it = 0; it < ntiles; ++it) {
    const int buf = it & 1;
    const bool more = (it + 1 < ntiles);
    if (more) K_LOAD(it + 1);
    compute(buf, it, [&]() { if (more) { K_STORE(buf ^ 1); V_LOAD_G(it + 1); } });
    if (more) V_STORE(buf ^ 1);
    __syncthreads();
  }
#undef K_LOAD
#undef V_LOAD_G
#undef K_STORE
#undef V_STORE
}

__global__ void __launch_bounds__(256, 2) yoco_fwd(Params p) {
  cg::grid_group grid = cg::this_grid();
  __shared__ __attribute__((aligned(16))) u16 smem[40192];
  __shared__ uint4 xb_words;
  if (threadIdx.x == 0) xb_words = make_uint4(0u, 0u, 0u, 0u);
  __syncthreads();
  XcdBarrier xb = xcd_barrier_post((unsigned*)(p.ws + O_BAR), (volatile LAS unsigned*)&xb_words);
  char* ws = p.ws;
  u16* W_AIN = (u16*)(ws + O_WAIN);
  u16* W_GLU = (u16*)(ws + O_WGLU);
  u16* W_AOUT = (u16*)(ws + O_WAOUT);
  u16* W_KV = (u16*)(ws + O_WKV);
  u16* W_C1 = (u16*)(ws + O_WC1);
  u16* W_C2 = (u16*)(ws + O_WC2);
  u16* W_BIN = (u16*)(ws + O_WBIN);
  u16* W_BOUT = (u16*)(ws + O_WBOUT);
  u16* XB = (u16*)(ws + O_XB);
  float* XF = (float*)(ws + O_XF);
  u16* KV = (u16*)(ws + O_KV);
  float* T1P = (float*)(ws + O_T1);
  u16* KCVC = (u16*)(ws + O_KCVC);
  float* C1B = (float*)(ws + O_C1B);
  u16* YB = (u16*)(ws + O_YB);
  float2* STATS = (float2*)(ws + O_STATS);
  u16* UZ = (u16*)(ws + O_UZ);
  u16* GB = (u16*)(ws + O_G);
  u16* VB = (u16*)(ws + O_V);
  float* SB = (float*)(ws + O_S);
  u16* HIN = (u16*)(ws + O_HIN);
  u16* W1 = (u16*)(ws + O_W1);
  u16* W3T = (u16*)(ws + O_W3T);
  u16* KTAB = (u16*)(ws + O_KTAB);
  float2* A64 = (float2*)(ws + O_A64);
  u16* PROJ = (u16*)(ws + O_PROJ);

  float* tl = (float*)smem;
  auto do_jobs = [&](unsigned mask, int b0, int nb) {
      for (int job = 0; job < 15; ++job) {
        if (!((mask >> job) & 1u)) continue;

        const float* src; u16* dst; int K, N, Np;
        switch (job) {
          case 0: src = p.in[1]; dst = W_AIN; K = 2048; N = 2048; Np = 2048; break;
          case 1: src = p.in[1] + (size_t)2048 * 2048; dst = W_AIN + (size_t)2048 * 2048; K = 2048; N = 2048; Np = 2048; break;
          case 2: src = p.in[10]; dst = W_GLU; K = 1024; N = 1024; Np = 1024; break;
          case 3: src = p.in[10] + (size_t)1024 * 1024; dst = W_GLU + (size_t)1024 * 1024; K = 1024; N = 1024; Np = 1024; break;
          case 4: src = p.in[12]; dst = W_AOUT; K = 1024; N = 2048; Np = 2048; break;
          case 5: src = p.in[12] + (size_t)1024 * 2048; dst = W_AOUT + (size_t)2048 * 1024; K = 1024; N = 2048; Np = 2048; break;
          case 6: src = p.in[13]; dst = W_KV; K = 2048; N = 3072; Np = 3072; break;
          case 7: src = p.in[15]; dst = W_C1; K = 4096; N = 128; Np = 128; break;
          case 8: src = p.in[18]; dst = W_C1 + (size_t)128 * 4096; K = 4096; N = 128; Np = 128; break;
          case 9: src = p.in[16]; dst = W_C2; K = 128; N = 128; Np = 128; break;
          case 10: src = p.in[19]; dst = W_C2 + (size_t)128 * 128; K = 128; N = 128; Np = 128; break;
          case 11: src = p.in[20]; dst = W_BIN; K = 2048; N = BIN_N; Np = PROJ_LD; break;
          case 12: src = p.in[20] + (size_t)2048 * BIN_N; dst = W_BIN + (size_t)PROJ_LD * 2048; K = 2048; N = BIN_N; Np = PROJ_LD; break;
          case 13: src = p.in[21]; dst = W_BOUT; K = 2048; N = 2048; Np = 2048; break;
          default: src = p.in[21] + (size_t)2048 * 2048; dst = W_BOUT + (size_t)2048 * 2048; K = 2048; N = 2048; Np = 2048; break;
        }
        if ((int)blockIdx.x >= b0) tconv(tl, src, dst, K, N, Np, b0, nb);
      }
  };
  for (int rep0 = 0; rep0 < REPS_P0; ++rep0) {
    const int tid = tid_l(), lane = tid & 63, wave = tid >> 6; (void)lane; (void)wave;
    do_jobs((1u << 0) | (1u << 2) | (1u << 4) | (1u << 7) | (1u << 8) | (1u << 9) | (1u << 10), 0, (int)gridDim.x);
    {
      const float4* x4 = (const float4*)p.in[0];
      uint2* xb2 = (uint2*)XB;
      const size_t n4 = (size_t)NTOK * DM / 4;
      for (size_t i = (size_t)blockIdx.x * 256 + tid; i < n4; i += (size_t)gridDim.x * 256) {
        float4 v = x4[i];
        uint2 o; o.x = pack2(v.x, v.y); o.y = pack2(v.z, v.w);
        xb2[i] = o;
      }
    }
    {
      float* C1P = (float*)(ws + O_C1P);
      float* red = (float*)smem;
      for (int item = blockIdx.x; item < 64; item += gridDim.x) {
        const int kvs = item >> 5, part = item & 31;
        const float* pos = p.in[kvs ? 17 : 14];
        const float* w1 = p.in[kvs ? 18 : 15];
        const int j = tid & 127, half = tid >> 7;
        const int i0 = part * 128 + half * 64;
        float acc = 0.f;
#pragma unroll 16
        for (int i = 0; i < 64; ++i) acc += pos[i0 + i] * w1[(size_t)(i0 + i) * 128 + j];
        __syncthreads();
        red[tid] = acc;
        __syncthreads();
        if (tid < 128) C1P[(size_t)item * 128 + tid] = red[tid] + red[tid + 128];
        __syncthreads();
      }
    }
    {
      float2* sE = (float2*)smem;
      float2* sCo = sE + 64;
      float2* sM = sCo + 64;
      float2* sC = sM + 1024;
      for (int item = blockIdx.x; item < 2 * 64 * 65; item += gridDim.x) {
        const int j = item % 65, lg = item / 65;
        const float* lam_re = p.in[2] + (size_t)lg * 64;
        const float* lam_im = p.in[3] + (size_t)lg * 64;
        const float dt = __expf(p.in[4][lg]);
        const float* b_re = p.in[5] + (size_t)lg * 1024;
        const float* b_im = p.in[6] + (size_t)lg * 1024;
        const float* c_re = p.in[7] + (size_t)lg * 1024;
        const float* c_im = p.in[8] + (size_t)lg * 1024;
#pragma unroll
        for (int i = 0; i < 4; ++i) sC[tid + i * 256] = make_float2(c_re[tid + i * 256], c_im[tid + i * 256]);
        if (tid < 64) {
          const float lr = lam_re[tid], li = lam_im[tid];
          const float mag = expf(lr * dt);
          float sn, cs;
          sincosf(li * dt, &sn, &cs);
          const float ar = mag * cs, ai = mag * sn;
          const float inv = 1.f / (lr * lr + li * li);
          const float cr = ((ar - 1.f) * lr + ai * li) * inv;
          const float ci = (ai * lr - (ar - 1.f) * li) * inv;
          sCo[tid] = make_float2(cr, ci);
          const float fj = (float)j;
          const float mj = expf(lr * dt * fj);
          float sj, cj;
          sincosf(li * dt * fj, &sj, &cj);
          sE[tid] = make_float2(mj * cj, mj * sj);
          if (j == 64) A64[(size_t)lg * 64 + tid] = make_float2(mj * cj, mj * sj);
        }
        __syncthreads();
#pragma unroll
        for (int i = 0; i < 4; ++i) {
          const int idx = tid + i * 256;
          const int pp = idx >> 4, ci = idx & 15;
          const float br = b_re[idx], bi = b_im[idx];
          const float2 co = sCo[pp];
          const float bbr = co.x * br - co.y * bi, bbi = co.x * bi + co.y * br;
          const float2 e = sE[pp];
          const float mr = e.x * bbr - e.y * bbi, mi = e.x * bbi + e.y * bbr;
          sM[idx] = make_float2(mr, mi);
          if (j < 64) {
            const int s = 63 - j;
            u16* w1p = W1 + (size_t)lg * 128 * 1024;
            w1p[(size_t)pp * 1024 + s * 16 + ci] = f2bf(mr);
            w1p[(size_t)(64 + pp) * 1024 + s * 16 + ci] = f2bf(mi);
          }
        }
        __syncthreads();
        if (j < 64) {
          const int co = tid >> 4, ci = tid & 15;
          float acc = 0.f;
          for (int pp = 0; pp < 64; ++pp) {
            const float2 m = sM[pp * 16 + ci];
            const float2 c = sC[co * 64 + pp];
            acc += c.x * m.x - c.y * m.y;
          }
          KTAB[(((size_t)lg * 64 + j) * 16 + co) * 16 + ci] = f2bf(acc);
        }
        if (j >= 1) {
          const int t = j - 1;
          u16* w3p = W3T + (size_t)lg * 1024 * 128;
#pragma unroll
          for (int i = 0; i < 4; ++i) {
            const int idx = tid + i * 256;
            const int co = idx >> 6, pp = idx & 63;
            const float cr = sC[idx].x, ci = sC[idx].y;
            const float2 e = sE[pp];
            const float re = cr * e.x - ci * e.y, im = cr * e.y + ci * e.x;
            w3p[(size_t)(t * 16 + co) * 128 + pp] = f2bf(re);
            w3p[(size_t)(t * 16 + co) * 128 + 64 + pp] = f2bf(-im);
          }
        }
        __syncthreads();
      }
    }
  }
  grid.sync();

  auto kmap64 = [](int ks) { return ks * 64; };

  for (int l = 0; l < 2; ++l) {
    const float* xres = (l == 0) ? p.in[0] : XF;
    {
      const int tid = tid_l(), lane = tid & 63, wave = tid >> 6; (void)lane; (void)wave;
      if (l == 0 && blockIdx.x == 0) {
        const float* C1P = (const float*)(ws + O_C1P);
        float a = 0.f;
        for (int part = 0; part < 32; ++part) a += C1P[((size_t)(tid >> 7) * 32 + part) * 128 + (tid & 127)];
        C1B[tid] = a;
      }
      const u16* Wt = W_AIN + (size_t)l * 2048 * 2048;
      for (int tile = blockIdx.x; tile < 64 * 8; tile += gridDim.x) {
        const int mt = tile & 63, nt = tile >> 6;
        gemm_tile_w(smem, mt * 128, nt * 256, 64,
                  [=](int m, int k0, int kc) { return ldg_o(XB + k0, (uint32_t)(m * 2048 + kc) * 2u); },
                  [=](int n, int k0, int kc) { return ldg_o(Wt + k0, (uint32_t)(n * 2048 + kc) * 2u); },
                  [=](int m, int n, f32x4 v) { st_bf4(UZ + (size_t)m * 2048 + n, v); });
      }
    }
    xcd_barrier(xb);
    {
      float* sS = (float*)smem;
      if (l == 0) do_jobs((1u << 1) | (1u << 3) | (1u << 5) | (1u << 6) | (1u << 11), 64, (int)gridDim.x - 64);
      else do_jobs((1u << 12) | (1u << 13) | (1u << 14), 64, (int)gridDim.x - 64);
      for (int g = blockIdx.x; g < 64; g += gridDim.x) {
        const u16* w1p = W1 + ((size_t)l * 64 + g) * 128 * 1024;
        gemm_tile<1, false>(smem, 0, 0, 16, kmap64,
                  [=](int m, int k0, int kc) { return ldg_o(UZ + (size_t)(k0 >> 4) * 2048 + g * 16, (uint32_t)((m * 64 + (kc >> 4)) * 2048 + (kc & 15)) * 2u); },
                  [=](int n, int k0, int kc) { return ldg_o(w1p + k0, (uint32_t)(n * 1024 + kc) * 2u); },
                  [=](int m, int n, f32x4 v) { *(f32x4*)(sS + m * 132 + n) = v; });
        __syncthreads();
        const int tid = tid_l();
        if (tid < 128) {
          const int b = tid >> 6, pp = tid & 63;
          const float2 a = A64[((size_t)l * 64 + g) * 64 + pp];
          float hr = 0.f, hi = 0.f;
          const float* sp = sS + (b * 64) * 132;
          u16* hp = HIN + ((size_t)g * 128 + b * 64) * 128;
#pragma unroll 4
          for (int c = 0; c < 64; ++c) {
            hp[c * 128 + pp] = f2bf(hr);
            hp[c * 128 + 64 + pp] = f2bf(hi);
            const float sr = sp[c * 132 + pp], si = sp[c * 132 + 64 + pp];
            const float nr = a.x * hr - a.y * hi + sr;
            const float ni = a.x * hi + a.y * hr + si;
            hr = nr; hi = ni;
          }
        }
        __syncthreads();
      }
    }
    xcd_barrier(xb);
    {
      const float* dsk = p.in[9] + (size_t)l * 1024;
      for (int tile = blockIdx.x; tile < 64 * 8; tile += gridDim.x) {
        const int g = tile >> 3, nt = 7 - (tile & 7);
        const int nks1 = 2 * nt + 2;
        const u16* ktab = KTAB + ((size_t)l * 64 + g) * 64 * 256;
        const u16* w3p = W3T + ((size_t)l * 64 + g) * 1024 * 128;
        const u16* hp = HIN + (size_t)g * 128 * 128;
        gemm_tile(smem, 0, nt * 128, nks1 + 2,
                  [=](int ks) { return ks < nks1 ? ks * 64 : 1024 + (ks - nks1) * 64; },
                  [=](int m, int k0, int kc) {
                    if (k0 < 1024) return ldg_o(UZ + (size_t)(k0 >> 4) * 2048 + g * 16, (uint32_t)((m * 64 + (kc >> 4)) * 2048 + (kc & 15)) * 2u);
                    return ldg_o(hp + (k0 - 1024), (uint32_t)(m * 128 + kc) * 2u);
                  },
                  [=](int n, int k0, int kc) {
                    if (k0 < 1024) {
                      const int lag = (n >> 4) - (kc >> 4) - (k0 >> 4);
                      if (lag < 0) return make_uint4(0u, 0u, 0u, 0u);
                      return ldg_o(ktab, (uint32_t)((lag * 16 + (n & 15)) * 16 + (kc & 15)) * 2u);
                    }
                    return ldg_o(w3p + (k0 - 1024), (uint32_t)(n * 128 + kc) * 2u);
                  },
                  [=](int m, int n, f32x4 v) {
                    const int t = n >> 4, co = n & 15;
                    const size_t tok = (size_t)m * 64 + t;
                    const int ch = g * 16 + co;
                    const f32x4 u = ld_bf4(UZ + tok * 2048 + ch);
                    const f32x4 d = *(const f32x4*)(dsk + ch);
                    f32x4 r;
#pragma unroll
                    for (int i = 0; i < 4; ++i) r[i] = gelu_tanh(v[i] + d[i] * u[i]);
                    st_bf4(GB + tok * 1024 + ch, r);
                  });
      }
    }
    xcd_barrier(xb);
    {
      const u16* Wt = W_GLU + (size_t)l * 1024 * 1024;
      const float* bg = p.in[11] + (size_t)l * 1024;
      for (int tile = blockIdx.x; tile < 64 * 8; tile += gridDim.x) {
        const int mt = tile & 63, nt = tile >> 6;
        gemm_tile(smem, mt * 128, nt * 128, 16, kmap64,
                  [=](int m, int k0, int kc) { return ldg_o(GB + k0, (uint32_t)(m * 1024 + kc) * 2u); },
                  [=](int n, int k0, int kc) { return ldg_o(Wt + k0, (uint32_t)(n * 1024 + kc) * 2u); },
                  [=](int m, int n, f32x4 v) {
                    const f32x4 gg = ld_bf4(GB + (size_t)m * 1024 + n);
                    const f32x4 zz = ld_bf4(UZ + (size_t)m * 2048 + 1024 + n);
                    const f32x4 bb = *(const f32x4*)(bg + n);
                    f32x4 r;
#pragma unroll
                    for (int i = 0; i < 4; ++i) r[i] = gg[i] * sigm(v[i] + bb[i]) * silu(zz[i]);
                    st_bf4(VB + (size_t)m * 1024 + n, r);
                  });
      }
    }
    xcd_barrier(xb);
    {
      const u16* Wt = W_AOUT + (size_t)l * 2048 * 1024;
      for (int tile = blockIdx.x; tile < 64 * 8; tile += gridDim.x) {
        const int mt = tile & 63, nt = tile >> 6;
        const float2* stp = STATS;
        const float* pgam = p.in[22] + (size_t)(l > 0 ? l - 1 : 0) * 2048;
        const float* pbet = p.in[23] + (size_t)(l > 0 ? l - 1 : 0) * 2048;
        gemm_tile_w<true>(smem, mt * 128, nt * 256, 32,
                  [=](int m, int k0, int kc) { return ldg_o(VB + k0, (uint32_t)(m * 1024 + kc) * 2u); },
                  [=](int n, int k0, int kc) { return ldg_o(Wt + k0, (uint32_t)(n * 1024 + kc) * 2u); },
                  [=](int m, int n, f32x4 v, f32x4 xr) {
                    if (l > 0) {
                      const float2 st = stp[m];
                      const f32x4 gg = *(const f32x4*)(pgam + n);
                      const f32x4 bb = *(const f32x4*)(pbet + n);
#pragma unroll
                      for (int i = 0; i < 4; ++i) xr[i] = (xr[i] - st.x) * st.y * gg[i] + bb[i];
                    }
                    f32x4 r;
#pragma unroll
                    for (int i = 0; i < 4; ++i) r[i] = DN_ALPHA * xr[i] + v[i];
                    *(f32x4*)((char*)XF + (uint32_t)(m * 2048 + n) * 4u) = r;
                  },
                  [=](int m, int n) { return *(const f32x4*)((const char*)xres + (uint32_t)(m * 2048 + n) * 4u); });
      }
    }
    xcd_barrier(xb);
    {
      const int tid = tid_l(), lane = tid & 63, wave = tid >> 6; (void)lane; (void)wave;
      const float* lg_ = p.in[22] + (size_t)l * 2048;
      const float* lb_ = p.in[23] + (size_t)l * 2048;
      for (int row = blockIdx.x * 4 + wave; row < NTOK; row += gridDim.x * 4) {
        float* xr = XF + (size_t)row * 2048;
        f32x4 v[8];
        float sum = 0.f;
#pragma unroll
        for (int i = 0; i < 8; ++i) { v[i] = *(const f32x4*)(xr + i * 256 + lane * 4); sum += v[i][0] + v[i][1] + v[i][2] + v[i][3]; }
#pragma unroll
        for (int o = 32; o >= 1; o >>= 1) sum += __shfl_xor(sum, o);
        const float mu = sum * (1.f / 2048.f);
        float sq = 0.f;
#pragma unroll
        for (int i = 0; i < 8; ++i)
#pragma unroll
          for (int e = 0; e < 4; ++e) { const float d = v[i][e] - mu; sq += d * d; }
#pragma unroll
        for (int o = 32; o >= 1; o >>= 1) sq += __shfl_xor(sq, o);
        const float rstd = rsqrtf(sq * (1.f / 2048.f) + LN_EPS);
#pragma unroll
        for (int i = 0; i < 8; ++i) {
          const int c = i * 256 + lane * 4;
          const f32x4 gg = *(const f32x4*)(lg_ + c);
          const f32x4 bb = *(const f32x4*)(lb_ + c);
          f32x4 r;
#pragma unroll
          for (int e = 0; e < 4; ++e) r[e] = (v[i][e] - mu) * rstd * gg[e] + bb[e];
          st_bf4(XB + (size_t)row * 2048 + c, r);
        }
        if (lane == 0) STATS[row] = make_float2(mu, rstd);
      }
    }
    xcd_barrier(xb);
  }

  {
    for (int tile = blockIdx.x; tile < 64 * 24; tile += gridDim.x) {
      const int mt = tile & 63, nt = tile >> 6;
      gemm_tile(smem, mt * 128, nt * 128, 32, kmap64,
                [=](int m, int k0, int kc) { return ldg_o(XB + k0, (uint32_t)(m * 2048 + kc) * 2u); },
                [=](int n, int k0, int kc) { return ldg_o(W_KV + k0, (uint32_t)(n * 2048 + kc) * 2u); },
                [=](int m, int n, f32x4 v) { st_bf4(KV + (size_t)m * KV_LD + n, v); });
    }
  }
  xcd_barrier(xb);
  for (int lb = 0; lb < 2; ++lb) {
    const int layer = 2 + lb;
    {
      const u16* Wt = W_BIN + (size_t)lb * PROJ_LD * 2048;
      if (lb == 0 && blockIdx.x >= 64 && blockIdx.x < 128) {
        const int ct = blockIdx.x - 64;
        const int half = ct >> 5, kvs = (ct >> 4) & 1, mt = ct & 15;
        const u16* Wc = W_C1 + (size_t)kvs * 128 * 4096;
        float* t1 = T1P + ((size_t)(half * 2 + kvs)) * 2048 * 128;
        gemm_tile<1>(smem, mt * 128, 0, 32, [=](int ks) { return half * 2048 + ks * 64; },
                  [=](int m, int k0, int kc) {
                    const int b = m >> 10, n = (m >> 2) & 255, g = m & 3;
                    int tok = n * 16 + (k0 >> 7);
                    tok = tok > 4095 ? 4095 : tok;
                    return ldg_o(KV + kvs * 512 + (k0 & 127), (uint32_t)((b * 4096 + tok) * KV_LD + g * 128 + kc) * 2u);
                  },
                  [=](int n, int k0, int kc) { return ldg_o(Wc + k0, (uint32_t)(n * 4096 + kc) * 2u); },
                  [=](int m, int n, f32x4 v) { *(f32x4*)(t1 + (size_t)m * 128 + n) = v; });
      }
      for (int rep = 0; rep < REPS_BIN; ++rep)
      for (int tile = blockIdx.x; tile < 64 * 32; tile += gridDim.x) {
        const int mt = tile & 63, nt = tile >> 6;
        gemm_tile_w(smem, mt * 128, nt * 256, 64,
                  [=](int m, int k0, int kc) { return ldg_o(XB + k0, (uint32_t)(m * 2048 + kc) * 2u); },
                  [=](int n, int k0, int kc) { return ldg_o(Wt + k0, (uint32_t)(n * 2048 + kc) * 2u); },
                  [=](int m, int n, f32x4 v) { st_bf4(PROJ + (size_t)m * PROJ_LD + n, v); });
      }
      for (int tile = blockIdx.x; tile < 64; tile += gridDim.x) {
        const int mt = tile & 63, nt = 64;
        gemm_tile(smem, mt * 128, nt * 128, 32, kmap64,
                  [=](int m, int k0, int kc) { return ldg_o(XB + k0, (uint32_t)(m * 2048 + kc) * 2u); },
                  [=](int n, int k0, int kc) { return ldg_o(Wt + k0, (uint32_t)(n * 2048 + kc) * 2u); },
                  [=](int m, int n, f32x4 v) { st_bf4(PROJ + (size_t)m * PROJ_LD + n, v); });
      }
    }
    xcd_barrier(xb);
    if (lb == 0) {
      for (int tile = blockIdx.x; tile < 32; tile += gridDim.x) {
        const int kvs = tile >> 4, mt = tile & 15;
        const u16* Wt = W_C2 + (size_t)kvs * 128 * 128;
        const float* t1a = T1P + ((size_t)kvs) * 2048 * 128;
        const float* t1b = T1P + ((size_t)(2 + kvs)) * 2048 * 128;
        const float* cb = C1B + kvs * 128;
        u16* kc_ = KCVC + (size_t)kvs * 2048 * 128;
        gemm_tile<1>(smem, mt * 128, 0, 2, kmap64,
                  [=](int m, int k0, int kc) {
                    const int k = k0 + kc;
                    const f32x4 a0 = *(const f32x4*)(t1a + (size_t)m * 128 + k), a1 = *(const f32x4*)(t1a + (size_t)m * 128 + k + 4);
                    const f32x4 b0 = *(const f32x4*)(t1b + (size_t)m * 128 + k), b1 = *(const f32x4*)(t1b + (size_t)m * 128 + k + 4);
                    const f32x4 c0 = *(const f32x4*)(cb + k), c1 = *(const f32x4*)(cb + k + 4);
                    uint4 r;
                    r.x = pack2(gelu_tanh(a0[0] + b0[0] + c0[0]), gelu_tanh(a0[1] + b0[1] + c0[1]));
                    r.y = pack2(gelu_tanh(a0[2] + b0[2] + c0[2]), gelu_tanh(a0[3] + b0[3] + c0[3]));
                    r.z = pack2(gelu_tanh(a1[0] + b1[0] + c1[0]), gelu_tanh(a1[1] + b1[1] + c1[1]));
                    r.w = pack2(gelu_tanh(a1[2] + b1[2] + c1[2]), gelu_tanh(a1[3] + b1[3] + c1[3]));
                    return r;
                  },
                  [=](int n, int k0, int kc) { return ldg_o(Wt + k0, (uint32_t)(n * 128 + kc) * 2u); },
                  [=](int m, int n, f32x4 v) {
                    if (((m >> 2) & 255) == 255) v = f32x4{0.f, 0.f, 0.f, 0.f};
                    st_bf4(kc_ + (size_t)m * 128 + n, v);
                  });
      }
      xcd_barrier(xb);
    }
#ifndef NO_ATTN
    {
      u16* sK = smem;
      u16* sV = smem + 2 * 64 * 136;
      uint32_t* imp = (uint32_t*)(smem + 2 * 64 * 136 + 2 * 64 * 144);
      unsigned long long* selm = (unsigned long long*)(imp + 32 * 65);
      const int tid = tid_l(), lane = tid & 63, wave = tid >> 6;
      const int l15 = lane & 15, quad = lane >> 4;
      const u16* KC = KCVC;
      const u16* VC = KCVC + (size_t)2048 * 128;
      for (int rep = 0; rep < REPS_ATTN; ++rep)
      for (int item = blockIdx.x; item < 1024; item += gridDim.x) {
        const int qt = (item < 512) ? (127 - (item >> 3)) : ((item - 512) >> 3);
        const int bg = item & 7, b = bg >> 2, g = bg & 3;
        const int t0 = qt * 32, h = g * 4 + wave;
        const size_t tokbase = (size_t)b * SEQ;
        const int cur = t0 >> 6;
        if (DESYNC_COND) __builtin_amdgcn_s_sleep(60);
        for (int i = tid; i < 32 * 65; i += 256) imp[i] = 0u;
        bf16x8 qf[2][4];
#pragma unroll
        for (int qs = 0; qs < 2; ++qs)
#pragma unroll
          for (int ds = 0; ds < 4; ++ds) {
            uint4 v = ldg16(PROJ + (tokbase + t0 + qs * 16 + l15) * PROJ_LD + h * 128 + ds * 32 + quad * 8);
            union { uint4 u; bf16x8 v; } cv; cv.u = v; qf[qs][ds] = cv.v;
          }
        const int tq0 = t0 + l15, tq1 = t0 + 16 + l15;
        f32x4 o[2][8];
        float mrow[2], lrow[2], linv[2];
        auto zero_o = [&]() {
#pragma unroll
          for (int qs = 0; qs < 2; ++qs)
#pragma unroll
            for (int dt = 0; dt < 8; ++dt) o[qs][dt] = f32x4{0.f, 0.f, 0.f, 0.f};
        };
        auto finish_l = [&]() {
#pragma unroll
          for (int qs = 0; qs < 2; ++qs) {
            float lsum = lrow[qs];
            lsum += __shfl_xor(lsum, 16);
            lsum += __shfl_xor(lsum, 32);
            linv[qs] = 1.f / fmaxf(lsum, 1e-30f);
          }
        };
        auto emit = [&](int br, bool first, bool scale_l) {
          float* wbuf = (float*)smem + wave * (16 * 132);
          const int rrow = lane >> 5, rcol = (lane & 31) * 4;
          const int tb = (int)tokbase + t0;
          const uint32_t zoff0 = (uint32_t)((tb + rrow) * PROJ_LD + 2048 + br * 2048 + h * 128 + rcol) * 2u;
          const uint32_t yoff0 = (uint32_t)((tb + rrow) * 2048 + h * 128 + rcol) * 2u;
#pragma unroll
          for (int qs = 0; qs < 2; ++qs) {
            const float gate = sigm(bf2f(*(const u16*)((const char*)PROJ + (uint32_t)((tb + qs * 16 + l15) * PROJ_LD + 8192 + br * 16 + h) * 2u)));
            const float sc = scale_l ? gate * linv[qs] : gate;
#pragma unroll
            for (int dt = 0; dt < 8; ++dt) *(f32x4*)(wbuf + l15 * 132 + dt * 16 + quad * 4) = o[qs][dt] * sc;
            __builtin_amdgcn_wave_barrier();
#pragma unroll 4
            for (int j = 0; j < 8; ++j) {
              const uint32_t zo = zoff0 + (uint32_t)((qs * 16 + j * 2) * PROJ_LD) * 2u;
              const uint32_t yo = yoff0 + (uint32_t)((qs * 16 + j * 2) * 2048) * 2u;
              const f32x4 a = *(const f32x4*)(wbuf + (j * 2 + rrow) * 132 + rcol);
              const f32x4 zz = ld_bf4((const u16*)((const char*)PROJ + zo));
              u16* yp = (u16*)((char*)YB + yo);
              f32x4 r;
#pragma unroll
              for (int e = 0; e < 4; ++e) r[e] = a[e] * silu(zz[e]);
              if (!first) {
                const f32x4 old = ld_bf4(yp);
#pragma unroll
                for (int e = 0; e < 4; ++e) r[e] += old[e];
              }
              st_bf4(yp, r);
            }
          }
          __syncthreads();
        };
#ifndef NO_CMP
        {
          int nmax = t0 >> 4; if (nmax > 254) nmax = 254;
          const int ntl = (nmax >> 6) + 1;
          auto tilefn = [&](int i, const u16*& kb, const u16*& vb, size_t& rs, int& kp) {
            const size_t off = (((size_t)b * 256 + i * 64) * 4 + g) * 128;
            kb = KC + off; vb = VC + off; rs = 512; kp = i * 64;
          };
          auto valid = [&](int kpos, int qs) { return kpos * 16 + 31 <= (qs ? tq1 : tq0); };
          mrow[0] = mrow[1] = -1e30f; lrow[0] = lrow[1] = 0.f; linv[0] = linv[1] = 1.f;
          auto nobias = [](int, int) { return 0.f; };
          auto allem = [](int) { return true; };
          attn_loop<1>(sK, sV, imp, ntl, tilefn, nobias, allem, valid, qf, o, mrow, lrow, linv);
          finish_l();
          zero_o();
          attn_loop<2>(sK, sV, imp, ntl, tilefn, nobias, allem, valid, qf, o, mrow, lrow, linv);
          emit(0, true, false);
        }
#endif
        {
#pragma unroll 1
          for (int tt = 0; tt < 8; ++tt) {
            const int tok = wave * 8 + tt;
            unsigned long long mask;
            if (cur < 16) {
              mask = (2ull << cur) - 1ull;
            } else {
              const uint32_t v = imp[tok * 65 + lane];
              const bool cand = (lane >= 1) && (lane <= cur - 2);
              const unsigned long long cm = __ballot(cand);
              uint32_t T = 0u;
#pragma unroll 1
              for (int bit = 30; bit >= 0; --bit) {
                const uint32_t tr = T | (1u << bit);
                const unsigned long long m = __ballot(v >= tr) & cm;
                if (__popcll(m) >= 13) T = tr;
              }
              const unsigned long long gt = __ballot(v > T) & cm;
              unsigned long long eq = __ballot(v == T) & cm;
              int need = 13 - (int)__popcll(gt);
              unsigned long long pick = 0ull;
              while (need > 0 && eq != 0ull) {
                const unsigned long long low = eq & (0ull - eq);
                pick |= low; eq ^= low; --need;
              }
              mask = gt | pick | 1ull | (1ull << cur) | (1ull << (cur - 1));
            }
            if (lane == 0) selm[tok] = mask;
          }
          __syncthreads();
        }
        const unsigned long long sm0 = selm[l15], sm1 = selm[16 + l15];
#ifndef NO_SEL
        {
          auto tilefn = [&](int i, const u16*& kb, const u16*& vb, size_t& rs, int& kp) {
            const size_t off = (tokbase + (size_t)i * 64) * KV_LD + 1024 + g * 128;
            kb = KV + off; vb = KV + off + 512; rs = KV_LD; kp = i * 64;
          };
          auto valid = [&](int kpos, int qs) { return kpos <= (qs ? tq1 : tq0); };
          auto biasfn = [&](int i, int qs) { return (((qs ? sm1 : sm0) >> i) & 1ull) ? 0.f : -1e30f; };
          auto emfn = [&](int i) { return i == cur; };
          mrow[0] = mrow[1] = -1e30f; lrow[0] = lrow[1] = 0.f;
          zero_o();
          attn_loop<0>(sK, sV, imp, cur + 1, tilefn, biasfn, emfn, valid, qf, o, mrow, lrow, linv);
          finish_l();
          emit(1, false, true);
        }
#endif
#ifndef NO_WIN
        {
          int jt0 = (t0 - 511) >> 6; if (jt0 < 0) jt0 = 0;
          auto tilefn = [&](int i, const u16*& kb, const u16*& vb, size_t& rs, int& kp) {
            const size_t off = (tokbase + (size_t)(jt0 + i) * 64) * KV_LD + 2048 + g * 128;
            kb = KV + off; vb = KV + off + 512; rs = KV_LD; kp = (jt0 + i) * 64;
          };
          auto valid = [&](int kpos, int qs) {
            const int t = qs ? tq1 : tq0;
            return (kpos <= t) && (kpos > t - 512);
          };
          auto biasfn = [](int, int) { return 0.f; };
          auto emfn = [&](int i) { const int kp = (jt0 + i) * 64; return !((kp + 63 <= t0) && (kp > t0 + 31 - 512)); };
          mrow[0] = mrow[1] = -1e30f; lrow[0] = lrow[1] = 0.f;
          zero_o();
          attn_loop<0>(sK, sV, imp, cur - jt0 + 1, tilefn, biasfn, emfn, valid, qf, o, mrow, lrow, linv);
          finish_l();
          emit(2, false, true);
        }
#endif
        __syncthreads();
      }
    }
#endif
    xcd_barrier(xb);
    {
      const u16* Wt = W_BOUT + (size_t)lb * 2048 * 2048;
      for (int tile = blockIdx.x; tile < 64 * 8; tile += gridDim.x) {
        const int mt = tile & 63, nt = tile >> 6;
        const float2* stp = STATS;
        const float* pgam = p.in[22] + (size_t)(layer - 1) * 2048;
        const float* pbet = p.in[23] + (size_t)(layer - 1) * 2048;
        gemm_tile_w<true>(smem, mt * 128, nt * 256, 64,
                  [=](int m, int k0, int kc) { return ldg_o(YB + k0, (uint32_t)(m * 2048 + kc) * 2u); },
                  [=](int n, int k0, int kc) { return ldg_o(Wt + k0, (uint32_t)(n * 2048 + kc) * 2u); },
                  [=](int m, int n, f32x4 v, f32x4 xr) {
                    const float2 st = stp[m];
                    const f32x4 gg = *(const f32x4*)(pgam + n);
                    const f32x4 bb = *(const f32x4*)(pbet + n);
                    f32x4 r;
#pragma unroll
                    for (int i = 0; i < 4; ++i) r[i] = DN_ALPHA * ((xr[i] - st.x) * st.y * gg[i] + bb[i]) + v[i];
                    *(f32x4*)((char*)XF + (uint32_t)(m * 2048 + n) * 4u) = r;
                  },
                  [=](int m, int n) { return *(const f32x4*)((const char*)XF + (uint32_t)(m * 2048 + n) * 4u); });
      }
    }
    xcd_barrier(xb);
    {
      const int tid = tid_l(), lane = tid & 63, wave = tid >> 6; (void)lane; (void)wave;
      const float* lg_ = p.in[22] + (size_t)layer * 2048;
      const float* lb_ = p.in[23] + (size_t)layer * 2048;
      const bool last = (lb == 1);
      for (int row = blockIdx.x * 4 + wave; row < NTOK; row += gridDim.x * 4) {
        float* xr = XF + (size_t)row * 2048;
        float* orow = last ? (p.out + (size_t)row * 2048) : xr;
        f32x4 v[8];
        float sum = 0.f;
#pragma unroll
        for (int i = 0; i < 8; ++i) { v[i] = *(const f32x4*)(xr + i * 256 + lane * 4); sum += v[i][0] + v[i][1] + v[i][2] + v[i][3]; }
#pragma unroll
        for (int o = 32; o >= 1; o >>= 1) sum += __shfl_xor(sum, o);
        const float mu = sum * (1.f / 2048.f);
        float sq = 0.f;
#pragma unroll
        for (int i = 0; i < 8; ++i)
#pragma unroll
          for (int e = 0; e < 4; ++e) { const float d = v[i][e] - mu; sq += d * d; }
#pragma unroll
        for (int o = 32; o >= 1; o >>= 1) sq += __shfl_xor(sq, o);
        const float rstd = rsqrtf(sq * (1.f / 2048.f) + LN_EPS);
#pragma unroll
        for (int i = 0; i < 8; ++i) {
          const int c = i * 256 + lane * 4;
          const f32x4 gg = *(const f32x4*)(lg_ + c);
          const f32x4 bb = *(const f32x4*)(lb_ + c);
          f32x4 r;
#pragma unroll
          for (int e = 0; e < 4; ++e) r[e] = (v[i][e] - mu) * rstd * gg[e] + bb[e];
          if (last) *(f32x4*)(orow + c) = r;
          else st_bf4(XB + (size_t)row * 2048 + c, r);
        }
        if (!last && lane == 0) STATS[row] = make_float2(mu, rstd);
      }
    }
    if (lb == 0) xcd_barrier(xb);
  }
}

extern "C" void kernel_launch(void* const* d_in, const int* in_sizes, int n_in, void* d_out, int out_size, void* d_ws,
                              size_t ws_size, hipStream_t stream) {
  static int grid_blocks = 0;
  if (!grid_blocks) {
    int dev = 0, cus = 0, per_cu = 0;
    hipGetDevice(&dev);
    hipDeviceGetAttribute(&cus, hipDeviceAttributeMultiprocessorCount, dev);
    hipOccupancyMaxActiveBlocksPerMultiprocessor(&per_cu, yoco_fwd, 256, 0);
    if (per_cu > 2) per_cu = 2;
    if (per_cu < 1) per_cu = 1;
    grid_blocks = cus * per_cu;
  }
  Params p{};
  for (int i = 0; i < 24; ++i) p.in[i] = (const float*)d_in[i];
  p.out = (float*)d_out;
  p.ws = (char*)d_ws;
  if (ws_size < WS_TOTAL) fprintf(stderr, "workspace too small: %zu < %zu\n", ws_size, (size_t)WS_TOTAL);
  (void)hipMemsetAsync((char*)d_ws + O_BAR, 0, XCD_BAR_WORDS * 4, stream);
  void* args[] = {&p};
  hipError_t e = hipLaunchCooperativeKernel((void*)yoco_fwd, dim3(grid_blocks), dim3(256), args, 0, stream);
  if (e != hipSuccess) fprintf(stderr, "cooperative launch failed: %s (grid %d)\n", hipGetErrorString(e), grid_blocks);
}
```

```cpp
#include <hip/hip_runtime.h>
#include <hip/hip_cooperative_groups.h>
#include <stdint.h>
#include <stdio.h>
namespace cg = cooperative_groups;

typedef __attribute__((ext_vector_type(8))) short bf16x8;
typedef __attribute__((ext_vector_type(4))) short s16x4;
typedef __attribute__((ext_vector_type(4))) float f32x4;
typedef unsigned short u16;
#define DI __device__ __forceinline__

#define DESYNC_COND (blockIdx.x >= 256)
#ifndef ATT_SAFE
#define ATT_SAFE 0
#endif
#ifndef REPS_ATTN
#define REPS_ATTN 1
#endif
#ifndef REPS_BIN
#define REPS_BIN 1
#endif
#ifndef REPS_SSM
#define REPS_SSM 1
#endif
#ifndef REPS_P0
#define REPS_P0 1
#endif
constexpr int NTOK = 8192, DM = 2048, SEQ = 4096, EW = 1024;
constexpr int PROJ_LD = 8320, BIN_N = 8240, KV_LD = 3072;
constexpr float DN_ALPHA = 1.681792830507429f;
constexpr float LN_EPS = 1e-5f;
constexpr float SCALE2 = 0.08838834764831845f * 1.4426950408889634f;

constexpr size_t al256(size_t x) { return (x + 255) & ~(size_t)255; }
constexpr size_t O_WAIN = 0;
constexpr size_t O_WGLU = O_WAIN + al256((size_t)2 * 2048 * 2048 * 2);
constexpr size_t O_WAOUT = O_WGLU + al256((size_t)2 * 1024 * 1024 * 2);
constexpr size_t O_WKV = O_WAOUT + al256((size_t)2 * 2048 * 1024 * 2);
constexpr size_t O_WC1 = O_WKV + al256((size_t)3072 * 2048 * 2);
constexpr size_t O_WC2 = O_WC1 + al256((size_t)2 * 128 * 4096 * 2);
constexpr size_t O_WBIN = O_WC2 + al256((size_t)2 * 128 * 128 * 2);
constexpr size_t O_WBOUT = O_WBIN + al256((size_t)2 * PROJ_LD * 2048 * 2);
constexpr size_t O_XB = O_WBOUT + al256((size_t)2 * 2048 * 2048 * 2);
constexpr size_t O_XF = O_XB + al256((size_t)NTOK * DM * 2);
constexpr size_t O_KV = O_XF + al256((size_t)NTOK * DM * 4);
constexpr size_t O_T1 = O_KV + al256((size_t)NTOK * KV_LD * 2);
constexpr size_t O_KCVC = O_T1 + al256((size_t)2 * 2 * 2048 * 128 * 4);
constexpr size_t O_C1B = O_KCVC + al256((size_t)2 * 2048 * 128 * 2);
constexpr size_t O_C1P = O_C1B + al256((size_t)2 * 128 * 4);
constexpr size_t O_BAR = O_C1P + al256((size_t)64 * 128 * 4);
constexpr size_t O_STATS = O_BAR + al256((size_t)4096 * 4);
constexpr size_t O_YB = O_STATS + al256((size_t)NTOK * 8);
constexpr size_t O_UNION = O_YB + al256((size_t)NTOK * DM * 2);
constexpr size_t O_UZ = O_UNION;
constexpr size_t O_G = O_UZ + al256((size_t)NTOK * 2048 * 2);
constexpr size_t O_V = O_G + al256((size_t)NTOK * 1024 * 2);
constexpr size_t O_S = O_V + al256((size_t)NTOK * 1024 * 2);
constexpr size_t O_HIN = O_S + al256((size_t)64 * 128 * 128 * 4);
constexpr size_t O_W1 = O_HIN + al256((size_t)64 * 128 * 128 * 2);
constexpr size_t O_W3T = O_W1 + al256((size_t)2 * 64 * 128 * 1024 * 2);
constexpr size_t O_KTAB = O_W3T + al256((size_t)2 * 64 * 1024 * 128 * 2);
constexpr size_t O_A64 = O_KTAB + al256((size_t)2 * 64 * 64 * 256 * 2);
constexpr size_t O_S5END = O_A64 + al256((size_t)2 * 64 * 64 * 8);
constexpr size_t O_PROJ = O_UNION;
constexpr size_t O_PROJEND = O_PROJ + al256((size_t)NTOK * PROJ_LD * 2);
constexpr size_t WS_TOTAL = (O_S5END > O_PROJEND ? O_S5END : O_PROJEND);

struct Params {
  const float* in[24];
  float* out;
  char* ws;
};

DI u16 f2bf(float f) { uint32_t u = __float_as_uint(f); u += 0x7fffu + ((u >> 16) & 1u); return (u16)(u >> 16); }
typedef float f32x2_t __attribute__((ext_vector_type(2)));
typedef __bf16 bf16x2_t __attribute__((ext_vector_type(2)));
DI uint32_t pack2(float a, float b) { f32x2_t v = {a, b}; bf16x2_t h = __builtin_convertvector(v, bf16x2_t); return __builtin_bit_cast(uint32_t, h); }
DI float bflo(uint32_t v) { return __uint_as_float(v << 16); }
DI float bfhi(uint32_t v) { return __uint_as_float(v & 0xffff0000u); }
DI float bf2f(u16 h) { return __uint_as_float(((uint32_t)h) << 16); }
DI uint4 ldg16(const void* p) { return *(const uint4*)p; }
DI uint4 ldg_o(const void* base, uint32_t byte_off) { return *(const uint4*)((const char*)base + byte_off); }
DI float sigm(float x) { return __builtin_amdgcn_rcpf(1.f + __expf(-x)); }
DI float silu(float x) { return x * sigm(x); }
DI float gelu_tanh(float x) { float u = 0.7978845608028654f * (x + 0.044715f * x * x * x); return x * sigm(2.f * u); }
DI void st_bf4(u16* p, f32x4 v) { uint2 o; o.x = pack2(v[0], v[1]); o.y = pack2(v[2], v[3]); *(uint2*)p = o; }
DI f32x4 ld_bf4(const u16* p) { uint2 o = *(const uint2*)p; f32x4 r; r[0] = bflo(o.x); r[1] = bfhi(o.x); r[2] = bflo(o.y); r[3] = bfhi(o.y); return r; }

DI int tid_l() { int t = threadIdx.x; asm volatile("" : "+v"(t)); return t; }


#define XB_TMO      128
#define XB_XCNT(j)  (256  + 64 * (j))
#define XB_XSUB(j)  (1280 + 64 * (j))
#define XB_XGEN(j)  (2304 + 64 * (j))
#define XB_TOP      3328
#define XB_TOPGEN   3392
#define XCD_BAR_WORDS 3456
#define XB_SPIN_CAP (1u << 22)
#define LAS __attribute__((address_space(3)))
DI unsigned xb_ld(unsigned* p) { return __hip_atomic_load(p, __ATOMIC_RELAXED, __HIP_MEMORY_SCOPE_AGENT); }
DI unsigned xb_add(unsigned* p, unsigned v) { return __hip_atomic_fetch_add(p, v, __ATOMIC_RELAXED, __HIP_MEMORY_SCOPE_AGENT); }
DI unsigned xb_xcc_id() { return (unsigned)__builtin_amdgcn_s_getreg((3 << 11) | 20) & 0xFu; }
#define XB_SPIN(cond, bar) do { unsigned _sp = 0; while (cond) { __builtin_amdgcn_s_sleep(1); \
    if ((++_sp & 255u) == 0u) { if (xb_ld(&(bar)[XB_TMO])) break; if (_sp > XB_SPIN_CAP) { atomicAdd(&(bar)[XB_TMO], 1u); break; } } } } while (0)
struct XcdBarrier { unsigned* bar; unsigned x; volatile LAS unsigned* st; };
DI XcdBarrier xcd_barrier_post(unsigned* bar, volatile LAS unsigned* st) {
  XcdBarrier b; b.bar = bar; b.x = xb_xcc_id(); b.st = st;
  if (threadIdx.x == 0) (void)xb_add(&bar[XB_XCNT(b.x)], 1u);
  return b;
}
DI void xcd_barrier_complete(unsigned* bar, unsigned x, unsigned& nloc, unsigned& nx) {
  const unsigned G = gridDim.x * gridDim.y * gridDim.z;
  unsigned sum, cnt, mine, sp = 0u;
  for (;;) {
    sum = 0u; cnt = 0u; mine = 0u;
#pragma unroll
    for (unsigned j = 0; j < 16; ++j) { const unsigned c = xb_ld(&bar[XB_XCNT(j)]); sum += c; cnt += (c > 0u) ? 1u : 0u; mine = (j == x) ? c : mine; }
    if (sum == G) break;
    __builtin_amdgcn_s_sleep(1);
    if ((++sp & 255u) == 0u) { if (xb_ld(&bar[XB_TMO])) break; if (sp > XB_SPIN_CAP) { atomicAdd(&bar[XB_TMO], 1u); break; } }
  }
  nloc = mine > 0u ? mine : 1u; nx = cnt > 0u ? cnt : 1u;
}
DI void xcd_barrier(const XcdBarrier& b) {
  asm volatile("s_waitcnt vmcnt(0)" ::: "memory");
  __syncthreads();
  if (threadIdx.x == 0) {
    unsigned* bar = b.bar;
    __builtin_amdgcn_s_waitcnt(0);
    unsigned nloc = b.st[0], nx = b.st[1];
    if (nloc == 0u) { xcd_barrier_complete(bar, b.x, nloc, nx); b.st[0] = nloc; b.st[1] = nx; }
    const unsigned old = xb_add(&bar[XB_XSUB(b.x)], 1u);
    const unsigned gen = old / nloc;
    if (old + 1u == (gen + 1u) * nloc) {
      __builtin_amdgcn_fence(__ATOMIC_RELEASE, "agent");
      asm volatile("s_waitcnt vmcnt(0)" ::: "memory");
      const unsigned og = xb_add(&bar[XB_TOP], 1u);
      const unsigned tg = og / nx;
      if (og + 1u == (tg + 1u) * nx) xb_add(&bar[XB_TOPGEN], 1u);
      else XB_SPIN(xb_ld(&bar[XB_TOPGEN]) == tg, bar);
      __builtin_amdgcn_fence(__ATOMIC_ACQUIRE, "agent");
      xb_add(&bar[XB_XGEN(b.x)], 1u);
      asm volatile("s_waitcnt vmcnt(0)" ::: "memory");
    } else {
      XB_SPIN(xb_ld(&bar[XB_XGEN(b.x)]) == gen, bar);
      __builtin_amdgcn_fence(__ATOMIC_ACQUIRE, "agent");
      asm volatile("s_waitcnt vmcnt(0)" ::: "memory");
    }
  }
  __syncthreads();
}

template <int DEPTH = 2, bool STAGED = true, class KMAP, class LA, class LW, class EPI>
DI void gemm_tile(u16* smem, int m0, int n0, int nks, KMAP kmap, LA loadA, LW loadW, EPI epi) {
  const int tid = tid_l(), lane = tid & 63, wave = tid >> 6;
  const int wm = wave >> 1, wn = wave & 1, l15 = lane & 15, quad = lane >> 4;
  u16* sX = smem;
  u16* sW = smem + 2 * 128 * 64;
  f32x4 acc[4][4];
#pragma unroll
  for (int i = 0; i < 4; ++i)
#pragma unroll
    for (int j = 0; j < 4; ++j) acc[i][j] = f32x4{0.f, 0.f, 0.f, 0.f};
  uint4 ra0[4], rw0[4], ra1[4], rw1[4];
  const int lrow = tid >> 3, lkc = (tid & 7) * 8;
  const int wpos = (((tid & 7) ^ ((tid >> 4) & 7)) * 8);
  const int rsw = (l15 >> 1) & 7;
  const int rp0 = ((quad ^ rsw) * 8), rp1 = (((4 + quad) ^ rsw) * 8);
#define G_LOAD(RA, RW, KS) { const int k0_ = __builtin_amdgcn_readfirstlane(kmap(KS)); _Pragma("unroll") for (int i = 0; i < 4; ++i) { RA[i] = loadA(m0 + lrow + i * 32, k0_, lkc); RW[i] = loadW(n0 + lrow + i * 32, k0_, lkc); } }
#define G_STORE(RA, RW, BUF) { u16* dx_ = sX + (BUF) * 128 * 64; u16* dw_ = sW + (BUF) * 128 * 64; _Pragma("unroll") for (int i = 0; i < 4; ++i) { \
    *(uint4*)(dx_ + (lrow + i * 32) * 64 + wpos) = RA[i]; *(uint4*)(dw_ + (lrow + i * 32) * 64 + wpos) = RW[i]; } }
#define G_COMPUTE(BUF, FENCE) { const u16* bx = sX + (BUF) * 128 * 64 + (wm * 64 + l15) * 64; const u16* bw = sW + (BUF) * 128 * 64 + (wn * 64 + l15) * 64; \
    bf16x8 xf[2][4], wf[2][4]; \
    _Pragma("unroll") for (int i = 0; i < 4; ++i) { \
      xf[0][i] = *(const bf16x8*)(bx + i * 16 * 64 + rp0); wf[0][i] = *(const bf16x8*)(bw + i * 16 * 64 + rp0); } \
    _Pragma("unroll") for (int i = 0; i < 4; ++i) { \
      xf[1][i] = *(const bf16x8*)(bx + i * 16 * 64 + rp1); wf[1][i] = *(const bf16x8*)(bw + i * 16 * 64 + rp1); } \
    if (FENCE) __builtin_amdgcn_sched_barrier(0); \
    _Pragma("unroll") for (int kk = 0; kk < 2; ++kk) { \
      _Pragma("unroll") for (int ni = 0; ni < 4; ++ni) _Pragma("unroll") for (int mi = 0; mi < 4; ++mi) \
          acc[ni][mi] = __builtin_amdgcn_mfma_f32_16x16x32_bf16(wf[kk][ni], xf[kk][mi], acc[ni][mi], 0, 0, 0); \
      if (FENCE) __builtin_amdgcn_sched_barrier(0); } }
#define G_PATTERN { __builtin_amdgcn_sched_group_barrier(0x100, 16, 0); \
    _Pragma("unroll") for (int q_ = 0; q_ < 8; ++q_) { __builtin_amdgcn_sched_group_barrier(0x008, 2, 0); __builtin_amdgcn_sched_group_barrier(0x020, 1, 0); } \
    _Pragma("unroll") for (int q_ = 0; q_ < 8; ++q_) { __builtin_amdgcn_sched_group_barrier(0x008, 2, 0); __builtin_amdgcn_sched_group_barrier(0x200, 1, 0); } }
  if (DEPTH == 2) {
    G_LOAD(ra0, rw0, 0);
    G_LOAD(ra1, rw1, 1);
    G_STORE(ra0, rw0, 0);
    __syncthreads();
    for (int ks = 0; ks < nks; ks += 2) {
      G_LOAD(ra0, rw0, (ks + 2 < nks ? ks + 2 : nks - 1));
      G_COMPUTE(0, 0);
      G_STORE(ra1, rw1, 1);
      G_PATTERN;
      __syncthreads();
      G_LOAD(ra1, rw1, (ks + 3 < nks ? ks + 3 : nks - 1));
      G_COMPUTE(1, 0);
      G_STORE(ra0, rw0, 0);
      G_PATTERN;
      __syncthreads();
    }
  } else {
    G_LOAD(ra0, rw0, 0);
    G_STORE(ra0, rw0, 0);
    __syncthreads();
    for (int ks = 0; ks < nks; ++ks) {
      const int buf = ks & 1;
      if (ks + 1 < nks) G_LOAD(ra0, rw0, ks + 1);
      G_COMPUTE(buf, 1);
      if (ks + 1 < nks) G_STORE(ra0, rw0, buf ^ 1);
      __syncthreads();
    }
  }
#undef G_LOAD
#undef G_STORE
#undef G_COMPUTE
#undef G_PATTERN
  if constexpr (!STAGED) {
#pragma unroll
    for (int ni = 0; ni < 4; ++ni)
#pragma unroll
      for (int mi = 0; mi < 4; ++mi)
        epi(m0 + wm * 64 + mi * 16 + l15, n0 + wn * 64 + ni * 16 + quad * 4, acc[ni][mi]);
  } else {
    float* wbuf = (float*)smem + wave * (16 * 68);
    const int rrow = lane >> 4, rcol = (lane & 15) * 4;
#pragma unroll
    for (int mi = 0; mi < 4; ++mi) {
#pragma unroll
      for (int ni = 0; ni < 4; ++ni) *(f32x4*)(wbuf + l15 * 68 + ni * 16 + quad * 4) = acc[ni][mi];
      __builtin_amdgcn_wave_barrier();
#pragma unroll
      for (int j = 0; j < 4; ++j) {
        const f32x4 a = *(const f32x4*)(wbuf + (j * 4 + rrow) * 68 + rcol);
        epi(m0 + wm * 64 + mi * 16 + j * 4 + rrow, n0 + wn * 64 + rcol, a);
      }
    }
    __syncthreads();
  }
}

template <bool HASPRE = false, class LA, class LW, class EPI, class PRE = int>
DI void gemm_tile_w(u16* smem, int m0, int n0, int nks, LA loadA, LW loadW, EPI epi, PRE pre = 0) {
  const int tid = tid_l(), lane = tid & 63, wave = tid >> 6;
  const int wm = wave >> 1, wn = wave & 1, l15 = lane & 15, quad = lane >> 4;
  u16* sX = smem;
  u16* sW = smem + 2 * 128 * 32;
  f32x4 acc[8][4];
#pragma unroll
  for (int i = 0; i < 8; ++i)
#pragma unroll
    for (int j = 0; j < 4; ++j) acc[i][j] = f32x4{0.f, 0.f, 0.f, 0.f};
  uint4 ra0[2], rw0[4], ra1[2], rw1[4];
  const int lrow = tid >> 2, lkc = (tid & 3) * 8;
  const int wpos = ((tid & 3) ^ ((0 - (tid >> 4)) & 3)) * 8;
  const int rpos = (quad ^ ((0 - (l15 >> 2)) & 3)) * 8;
#define W_LOAD(RA, RW, KS) { const int k0_ = __builtin_amdgcn_readfirstlane((KS) * 32); \
    _Pragma("unroll") for (int i = 0; i < 2; ++i) RA[i] = loadA(m0 + lrow + i * 64, k0_, lkc); \
    _Pragma("unroll") for (int i = 0; i < 4; ++i) RW[i] = loadW(n0 + lrow + i * 64, k0_, lkc); }
#define W_STORE(RA, RW, BUF) { u16* dx_ = sX + (BUF) * 128 * 32; u16* dw_ = sW + (BUF) * 256 * 32; \
    _Pragma("unroll") for (int i = 0; i < 2; ++i) *(uint4*)(dx_ + (lrow + i * 64) * 32 + wpos) = RA[i]; \
    _Pragma("unroll") for (int i = 0; i < 4; ++i) *(uint4*)(dw_ + (lrow + i * 64) * 32 + wpos) = RW[i]; }
#define W_COMPUTE(BUF) { const u16* bx = sX + (BUF) * 128 * 32 + (wm * 64 + l15) * 32 + rpos; const u16* bw = sW + (BUF) * 256 * 32 + (wn * 128 + l15) * 32 + rpos; \
    bf16x8 xf[4], wf[8]; \
    _Pragma("unroll") for (int i = 0; i < 4; ++i) xf[i] = *(const bf16x8*)(bx + i * 16 * 32); \
    _Pragma("unroll") for (int i = 0; i < 8; ++i) wf[i] = *(const bf16x8*)(bw + i * 16 * 32); \
    _Pragma("unroll") for (int ni = 0; ni < 8; ++ni) _Pragma("unroll") for (int mi = 0; mi < 4; ++mi) \
        acc[ni][mi] = __builtin_amdgcn_mfma_f32_16x16x32_bf16(wf[ni], xf[mi], acc[ni][mi], 0, 0, 0); }
#define W_PATTERN { __builtin_amdgcn_sched_group_barrier(0x100, 12, 0); \
    _Pragma("unroll") for (int q_ = 0; q_ < 6; ++q_) { __builtin_amdgcn_sched_group_barrier(0x008, 2, 0); __builtin_amdgcn_sched_group_barrier(0x020, 1, 0); } \
    _Pragma("unroll") for (int q_ = 0; q_ < 6; ++q_) { __builtin_amdgcn_sched_group_barrier(0x008, 3, 0); __builtin_amdgcn_sched_group_barrier(0x200, 1, 0); } \
    __builtin_amdgcn_sched_group_barrier(0x008, 2, 0); }
  W_LOAD(ra0, rw0, 0);
  W_LOAD(ra1, rw1, 1);
  W_STORE(ra0, rw0, 0);
  __syncthreads();
  for (int ks = 0; ks < nks; ks += 2) {
    W_LOAD(ra0, rw0, (ks + 2 < nks ? ks + 2 : nks - 1));
    W_COMPUTE(0);
    W_STORE(ra1, rw1, 1);
    W_PATTERN;
    __syncthreads();
    W_LOAD(ra1, rw1, (ks + 3 < nks ? ks + 3 : nks - 1));
    W_COMPUTE(1);
    W_STORE(ra0, rw0, 0);
    W_PATTERN;
    __syncthreads();
  }
#undef W_LOAD
#undef W_STORE
#undef W_COMPUTE
#undef W_PATTERN
  if constexpr (HASPRE) {
    float* wbuf = (float*)smem + wave * (16 * 132);
    const int rrow = lane >> 5, rcol = (lane & 31) * 4;
#pragma unroll
    for (int mi = 0; mi < 4; ++mi) {
#pragma unroll
      for (int ni = 0; ni < 8; ++ni) *(f32x4*)(wbuf + l15 * 132 + ni * 16 + quad * 4) = acc[ni][mi];
      __builtin_amdgcn_wave_barrier();
      f32x4 pv[8];
#pragma unroll
      for (int j = 0; j < 8; ++j) pv[j] = pre(m0 + wm * 64 + mi * 16 + j * 2 + rrow, n0 + wn * 128 + rcol);
#pragma unroll
      for (int j = 0; j < 8; ++j) {
        const f32x4 a = *(const f32x4*)(wbuf + (j * 2 + rrow) * 132 + rcol);
        epi(m0 + wm * 64 + mi * 16 + j * 2 + rrow, n0 + wn * 128 + rcol, a, pv[j]);
      }
    }
    __syncthreads();
  } else {
    float* wbuf = (float*)smem + wave * (16 * 132);
    const int rrow = lane >> 5, rcol = (lane & 31) * 4;
#pragma unroll
    for (int mi = 0; mi < 4; ++mi) {
#pragma unroll
      for (int ni = 0; ni < 8; ++ni) *(f32x4*)(wbuf + l15 * 132 + ni * 16 + quad * 4) = acc[ni][mi];
      __builtin_amdgcn_wave_barrier();
#pragma unroll
      for (int j = 0; j < 8; ++j) {
        const f32x4 a = *(const f32x4*)(wbuf + (j * 2 + rrow) * 132 + rcol);
        epi(m0 + wm * 64 + mi * 16 + j * 2 + rrow, n0 + wn * 128 + rcol, a);
      }
    }
    __syncthreads();
  }
}

DI void tconv(float* tl, const float* src, u16* dst, int K, int N, int Npad, int b0, int nb) {
  const int tid = tid_l();
  const int nkt = K >> 6, nnt = Npad >> 6, ntl = nkt * nnt;
  const int r = tid >> 4, c4 = (tid & 15) * 4;
  float4 v[4];
  int tile = (int)blockIdx.x - b0;
  auto ld = [&](int t) {
    const int kt = t % nkt, nt = t / nkt;
    const int k0 = kt * 64, n0 = nt * 64;
#pragma unroll
    for (int i = 0; i < 4; ++i) {
      v[i] = make_float4(0.f, 0.f, 0.f, 0.f);
      if (n0 + c4 < N) v[i] = *(const float4*)(src + (size_t)(k0 + r + i * 16) * N + n0 + c4);
    }
  };
  if (tile < ntl) ld(tile);
  for (; tile < ntl; tile += nb) {
    const int kt = tile % nkt, nt = tile / nkt;
    const int k0 = kt * 64, n0 = nt * 64;
#pragma unroll
    for (int i = 0; i < 4; ++i) {
      const int k = r + i * 16;
      tl[k * 65 + c4 + 0] = v[i].x; tl[k * 65 + c4 + 1] = v[i].y; tl[k * 65 + c4 + 2] = v[i].z; tl[k * 65 + c4 + 3] = v[i].w;
    }
    if (tile + nb < ntl) ld(tile + nb);
    __syncthreads();
#pragma unroll
    for (int i = 0; i < 2; ++i) {
      const int c = tid + i * 256;
      const int n = c >> 3, k8 = (c & 7) * 8;
      uint4 o;
      o.x = pack2(tl[(k8 + 0) * 65 + n], tl[(k8 + 1) * 65 + n]);
      o.y = pack2(tl[(k8 + 2) * 65 + n], tl[(k8 + 3) * 65 + n]);
      o.z = pack2(tl[(k8 + 4) * 65 + n], tl[(k8 + 5) * 65 + n]);
      o.w = pack2(tl[(k8 + 6) * 65 + n], tl[(k8 + 7) * 65 + n]);
      *(uint4*)(dst + (size_t)(n0 + n) * K + k0 + k8) = o;
    }
    __syncthreads();
  }
}

template <int MODE, class TILE, class BIAS, class EM, class MASK>
DI void attn_loop(u16* sK, u16* sV, uint32_t* imp, int ntiles, TILE tilefn, BIAS biasfn, EM emfn, MASK valid, const bf16x8 (&qf)[2][4],
                  f32x4 (&o)[2][8], float (&mrow)[2], float (&lrow)[2], const float (&linv)[2]) {
  const int tid = tid_l(), lane = tid & 63;
  const int l15 = lane & 15, quad = lane >> 4;
  const int lr = tid >> 4, lc = (tid & 15) * 8;
  uint4 rk[4];
#define K_LOAD(IT) { const u16 *kb_, *vb_; size_t rs_; int kp_; tilefn(IT, kb_, vb_, rs_, kp_); _Pragma("unroll") for (int i = 0; i < 4; ++i) rk[i] = ldg_o(kb_, (uint32_t)((lr + i * 16) * (int)rs_ + lc) * 2u); }
#define V_LOAD_G(IT) { const u16 *kb_, *vb_; size_t rs_; int kp_; tilefn(IT, kb_, vb_, rs_, kp_); _Pragma("unroll") for (int i = 0; i < 4; ++i) rk[i] = ldg_o(vb_, (uint32_t)((lr + i * 16) * (int)rs_ + lc) * 2u); }
#define K_STORE(BUF) { _Pragma("unroll") for (int i = 0; i < 4; ++i) *(uint4*)(sK + (BUF) * 64 * 136 + (lr + i * 16) * 136 + lc) = rk[i]; }
#define V_STORE(BUF) { _Pragma("unroll") for (int i = 0; i < 4; ++i) *(uint4*)(sV + (BUF) * 64 * 144 + (lr + i * 16) * 144 + lc) = rk[i]; }
  auto compute = [&](const int buf, const int it, auto midfn) {
    int kpos0;
    { const u16 *kb, *vb; size_t rs; tilefn(it, kb, vb, rs, kpos0); }
    f32x4 s[4][2];
#pragma unroll
    for (int kc = 0; kc < 4; ++kc) { s[kc][0] = f32x4{0.f, 0.f, 0.f, 0.f}; s[kc][1] = f32x4{0.f, 0.f, 0.f, 0.f}; }
    const u16* kbase = sK + buf * 64 * 136 + l15 * 136 + quad * 8;
    {
      bf16x8 kf[2][2];
      kf[0][0] = *(const bf16x8*)(kbase);
      kf[0][1] = *(const bf16x8*)(kbase + 32);
#pragma unroll
      for (int h = 0; h < 8; ++h) {
        const int kc = h >> 1, dh = h & 1;
        if (h < 7) {
          const int kc2 = (h + 1) >> 1, dh2 = (h + 1) & 1;
          kf[(h + 1) & 1][0] = *(const bf16x8*)(kbase + kc2 * 16 * 136 + (dh2 * 2) * 32);
          kf[(h + 1) & 1][1] = *(const bf16x8*)(kbase + kc2 * 16 * 136 + (dh2 * 2 + 1) * 32);
        }
#pragma unroll
        for (int e = 0; e < 2; ++e) {
          const int ds = dh * 2 + e;
          s[kc][0] = __builtin_amdgcn_mfma_f32_16x16x32_bf16(kf[h & 1][e], qf[0][ds], s[kc][0], 0, 0, 0);
          s[kc][1] = __builtin_amdgcn_mfma_f32_16x16x32_bf16(kf[h & 1][e], qf[1][ds], s[kc][1], 0, 0, 0);
        }
        __builtin_amdgcn_sched_barrier(0);
      }
    }
    midfn();
    float mx[2] = {-1e30f, -1e30f};
    if (MODE == 0) {
      const float bias0 = biasfn(it, 0), bias1 = biasfn(it, 1);
      const bool em = ATT_SAFE || emfn(it);
      if (em) {
#pragma unroll
        for (int kc = 0; kc < 4; ++kc)
#pragma unroll
          for (int qs = 0; qs < 2; ++qs)
#pragma unroll
            for (int r = 0; r < 4; ++r) {
              const int kpos = kpos0 + kc * 16 + quad * 4 + r;
              const float x = valid(kpos, qs) ? fmaf(s[kc][qs][r], SCALE2, qs ? bias1 : bias0) : -1e30f;
              s[kc][qs][r] = x;
              mx[qs] = fmaxf(mx[qs], x);
            }
      } else {
        float r0 = -3e38f, r1 = -3e38f;
#pragma unroll
        for (int kc = 0; kc < 4; ++kc)
#pragma unroll
          for (int r = 0; r < 4; ++r) { r0 = fmaxf(r0, s[kc][0][r]); r1 = fmaxf(r1, s[kc][1][r]); }
        mx[0] = fmaf(r0, SCALE2, bias0);
        mx[1] = fmaf(r1, SCALE2, bias1);
      }
      float al[2];
#pragma unroll
      for (int qs = 0; qs < 2; ++qs) {
        float m = mx[qs];
        m = fmaxf(m, __shfl_xor(m, 16));
        m = fmaxf(m, __shfl_xor(m, 32));
        const float mnew = fmaxf(mrow[qs], m);
        al[qs] = __builtin_amdgcn_exp2f(mrow[qs] - mnew);
        mrow[qs] = mnew;
      }
      if (__builtin_amdgcn_ballot_w64(al[0] < 1.f || al[1] < 1.f) != 0ull) {
#pragma unroll
        for (int qs = 0; qs < 2; ++qs) {
          lrow[qs] *= al[qs];
#pragma unroll
          for (int dt = 0; dt < 8; ++dt) o[qs][dt] *= al[qs];
        }
      }
      if (em) {
#pragma unroll
        for (int kc = 0; kc < 4; ++kc)
#pragma unroll
          for (int qs = 0; qs < 2; ++qs)
#pragma unroll
            for (int r = 0; r < 4; ++r) {
              float pv = __builtin_amdgcn_exp2f(s[kc][qs][r] - mrow[qs]);
              if (ATT_SAFE) pv = (s[kc][qs][r] > -1e29f) ? pv : 0.f;
              lrow[qs] += pv;
              s[kc][qs][r] = pv;
            }
      } else {
        const float c0 = bias0 - mrow[0], c1 = bias1 - mrow[1];
#pragma unroll
        for (int kc = 0; kc < 4; ++kc)
#pragma unroll
          for (int qs = 0; qs < 2; ++qs)
#pragma unroll
            for (int r = 0; r < 4; ++r) {
              const float pv = __builtin_amdgcn_exp2f(fmaf(s[kc][qs][r], SCALE2, qs ? c1 : c0));
              lrow[qs] += pv;
              s[kc][qs][r] = pv;
            }
      }
    } else {
#pragma unroll
      for (int kc = 0; kc < 4; ++kc)
#pragma unroll
        for (int qs = 0; qs < 2; ++qs)
#pragma unroll
          for (int r = 0; r < 4; ++r) {
            const int kpos = kpos0 + kc * 16 + quad * 4 + r;
            const float x = valid(kpos, qs) ? s[kc][qs][r] * SCALE2 : -1e30f;
            s[kc][qs][r] = x;
            mx[qs] = fmaxf(mx[qs], x);
          }
      if (MODE == 1) {
#pragma unroll
        for (int qs = 0; qs < 2; ++qs) {
          float m = mx[qs];
          m = fmaxf(m, __shfl_xor(m, 16));
          m = fmaxf(m, __shfl_xor(m, 32));
          const float mnew = fmaxf(mrow[qs], m);
          const float alpha = __builtin_amdgcn_exp2f(mrow[qs] - mnew);
          mrow[qs] = mnew;
          lrow[qs] *= alpha;
        }
      }
#pragma unroll
      for (int kc = 0; kc < 4; ++kc)
#pragma unroll
        for (int qs = 0; qs < 2; ++qs)
#pragma unroll
          for (int r = 0; r < 4; ++r) {
            const float x = s[kc][qs][r];
            float pv = (x > -1e29f) ? __builtin_amdgcn_exp2f(x - mrow[qs]) : 0.f;
            if (MODE == 2) pv *= linv[qs];
            else lrow[qs] += pv;
            s[kc][qs][r] = pv;
          }
    }
    if (MODE == 2) {
#pragma unroll
      for (int kc = 0; kc < 4; ++kc)
#pragma unroll
        for (int qs = 0; qs < 2; ++qs) {
          const int jb = (kpos0 >> 2) + kc * 4 + quad;
          const float a = s[kc][qs][0] + s[kc][qs][1] + s[kc][qs][2] + s[kc][qs][3];
          const float b3 = s[kc][qs][3];
          if (jb < 64) atomicAdd(&imp[(qs * 16 + l15) * 65 + jb], (uint32_t)(a * 67108864.f + 0.5f));
          if (jb + 1 < 64) atomicAdd(&imp[(qs * 16 + l15) * 65 + jb + 1], (uint32_t)(b3 * 67108864.f + 0.5f));
        }
    }
    if (MODE != 1) {
      bf16x8 pb[2][2];
#pragma unroll
      for (int j = 0; j < 2; ++j)
#pragma unroll
        for (int qs = 0; qs < 2; ++qs) {
          union { bf16x8 v; uint32_t u[4]; } cv;
          cv.u[0] = pack2(s[2 * j][qs][0], s[2 * j][qs][1]);
          cv.u[1] = pack2(s[2 * j][qs][2], s[2 * j][qs][3]);
          cv.u[2] = pack2(s[2 * j + 1][qs][0], s[2 * j + 1][qs][1]);
          cv.u[3] = pack2(s[2 * j + 1][qs][2], s[2 * j + 1][qs][3]);
          pb[j][qs] = cv.v;
        }
      const u16* vbase = sV + buf * 64 * 144 + (4 * quad + (l15 >> 2)) * 144 + (l15 & 3) * 4;
      bf16x8 vf[2][4];
#define V_LOAD(DST, G) { _Pragma("unroll") for (int d = 0; d < 4; ++d) { const u16* a0 = vbase + (32 * ((G) >> 1)) * 144 + (((G) & 1) * 4 + d) * 16; \
        s16x4 lo = __builtin_amdgcn_ds_read_tr16_b64_v4i16((__attribute__((address_space(3))) s16x4*)(a0)); \
        s16x4 hi = __builtin_amdgcn_ds_read_tr16_b64_v4i16((__attribute__((address_space(3))) s16x4*)(a0 + 16 * 144)); \
        bf16x8 t; t[0] = lo[0]; t[1] = lo[1]; t[2] = lo[2]; t[3] = lo[3]; t[4] = hi[0]; t[5] = hi[1]; t[6] = hi[2]; t[7] = hi[3]; DST[d] = t; } }
      V_LOAD(vf[0], 0);
#pragma unroll
      for (int g = 0; g < 4; ++g) {
        if (g < 3) V_LOAD(vf[(g + 1) & 1], g + 1);
#pragma unroll
        for (int d = 0; d < 4; ++d) {
          const int dt = (g & 1) * 4 + d;
          o[0][dt] = __builtin_amdgcn_mfma_f32_16x16x32_bf16(vf[g & 1][d], pb[g >> 1][0], o[0][dt], 0, 0, 0);
          o[1][dt] = __builtin_amdgcn_mfma_f32_16x16x32_bf16(vf[g & 1][d], pb[g >> 1][1], o[1][dt], 0, 0, 0);
        }
        __builtin_amdgcn_sched_barrier(0);
      }
#undef V_LOAD
    }
  };
  {
    uint4 rv0[4];
    const u16 *kb_, *vb_; size_t rs_; int kp_;
    tilefn(0, kb_, vb_, rs_, kp_);
#pragma unroll
    for (int i = 0; i < 4; ++i) {
      rk[i] = ldg_o(kb_, (uint32_t)((lr + i * 16) * (int)rs_ + lc) * 2u);
      if (MODE != 1) rv0[i] = ldg_o(vb_, (uint32_t)((lr + i * 16) * (int)rs_ + lc) * 2u);
    }
    K_STORE(0);
    if (MODE != 1) {
#pragma unroll
      for (int i = 0; i < 4; ++i) *(uint4*)(sV + (lr + i * 16) * 144 + lc) = rv0[i];
    }
  }
  __syncthreads();
  for (int it = 0; it < ntiles; ++it) {
    const int buf = it & 1;
    const bool more = (it + 1 < ntiles);
    if (more) K_LOAD(it + 1);
    compute(buf, it, [&]() { if (more) { K_STORE(buf ^ 1); if (MODE != 1) V_LOAD_G(it + 1); } });
    if (more && MODE != 1) V_STORE(buf ^ 1);
    __syncthreads();
  }
#undef K_LOAD
#undef V_LOAD_G
#undef K_STORE
#undef V_STORE
}

__global__ void __launch_bounds__(256, 2) yoco_fwd(Params p) {
  cg::grid_group grid = cg::this_grid();
  __shared__ __attribute__((aligned(16))) u16 smem[40192];
  __shared__ uint4 xb_words;
  if (threadIdx.x == 0) xb_words = make_uint4(0u, 0u, 0u, 0u);
  __syncthreads();
  XcdBarrier xb = xcd_barrier_post((unsigned*)(p.ws + O_BAR), (volatile LAS unsigned*)&xb_words);
  char* ws = p.ws;
  u16* W_AIN = (u16*)(ws + O_WAIN);
  u16* W_GLU = (u16*)(ws + O_WGLU);
  u16* W_AOUT = (u16*)(ws + O_WAOUT);
  u16* W_KV = (u16*)(ws + O_WKV);
  u16* W_C1 = (u16*)(ws + O_WC1);
  u16* W_C2 = (u16*)(ws + O_WC2);
  u16* W_BIN = (u16*)(ws + O_WBIN);
  u16* W_BOUT = (u16*)(ws + O_WBOUT);
  u16* XB = (u16*)(ws + O_XB);
  float* XF = (float*)(ws + O_XF);
  u16* KV = (u16*)(ws + O_KV);
  float* T1P = (float*)(ws + O_T1);
  u16* KCVC = (u16*)(ws + O_KCVC);
  float* C1B = (float*)(ws + O_C1B);
  u16* YB = (u16*)(ws + O_YB);
  float2* STATS = (float2*)(ws + O_STATS);
  u16* UZ = (u16*)(ws + O_UZ);
  u16* GB = (u16*)(ws + O_G);
  u16* VB = (u16*)(ws + O_V);
  float* SB = (float*)(ws + O_S);
  u16* HIN = (u16*)(ws + O_HIN);
  u16* W1 = (u16*)(ws + O_W1);
  u16* W3T = (u16*)(ws + O_W3T);
  u16* KTAB = (u16*)(ws + O_KTAB);
  float2* A64 = (float2*)(ws + O_A64);
  u16* PROJ = (u16*)(ws + O_PROJ);

  float* tl = (float*)smem;
  auto do_jobs = [&](unsigned mask, int b0, int nb) {
      for (int job = 0; job < 15; ++job) {
        if (!((mask >> job) & 1u)) continue;

        const float* src; u16* dst; int K, N, Np;
        switch (job) {
          case 0: src = p.in[1]; dst = W_AIN; K = 2048; N = 2048; Np = 2048; break;
          case 1: src = p.in[1] + (size_t)2048 * 2048; dst = W_AIN + (size_t)2048 * 2048; K = 2048; N = 2048; Np = 2048; break;
          case 2: src = p.in[10]; dst = W_GLU; K = 1024; N = 1024; Np = 1024; break;
          case 3: src = p.in[10] + (size_t)1024 * 1024; dst = W_GLU + (size_t)1024 * 1024; K = 1024; N = 1024; Np = 1024; break;
          case 4: src = p.in[12]; dst = W_AOUT; K = 1024; N = 2048; Np = 2048; break;
          case 5: src = p.in[12] + (size_t)1024 * 2048; dst = W_AOUT + (size_t)2048 * 1024; K = 1024; N = 2048; Np = 2048; break;
          case 6: src = p.in[13]; dst = W_KV; K = 2048; N = 3072; Np = 3072; break;
          case 7: src = p.in[15]; dst = W_C1; K = 4096; N = 128; Np = 128; break;
          case 8: src = p.in[18]; dst = W_C1 + (size_t)128 * 4096; K = 4096; N = 128; Np = 128; break;
          case 9: src = p.in[16]; dst = W_C2; K = 128; N = 128; Np = 128; break;
          case 10: src = p.in[19]; dst = W_C2 + (size_t)128 * 128; K = 128; N = 128; Np = 128; break;
          case 11: src = p.in[20]; dst = W_BIN; K = 2048; N = BIN_N; Np = PROJ_LD; break;
          case 12: src = p.in[20] + (size_t)2048 * BIN_N; dst = W_BIN + (size_t)PROJ_LD * 2048; K = 2048; N = BIN_N; Np = PROJ_LD; break;
          case 13: src = p.in[21]; dst = W_BOUT; K = 2048; N = 2048; Np = 2048; break;
          default: src = p.in[21] + (size_t)2048 * 2048; dst = W_BOUT + (size_t)2048 * 2048; K = 2048; N = 2048; Np = 2048; break;
        }
        if ((int)blockIdx.x >= b0) tconv(tl, src, dst, K, N, Np, b0, nb);
      }
  };
  for (int rep0 = 0; rep0 < REPS_P0; ++rep0) {
    const int tid = tid_l(), lane = tid & 63, wave = tid >> 6; (void)lane; (void)wave;
    do_jobs((1u << 0) | (1u << 2) | (1u << 4) | (1u << 7) | (1u << 8) | (1u << 9) | (1u << 10), 0, (int)gridDim.x);
    {
      const float4* x4 = (const float4*)p.in[0];
      uint2* xb2 = (uint2*)XB;
      const size_t n4 = (size_t)NTOK * DM / 4;
      for (size_t i = (size_t)blockIdx.x * 256 + tid; i < n4; i += (size_t)gridDim.x * 256) {
        float4 v = x4[i];
        uint2 o; o.x = pack2(v.x, v.y); o.y = pack2(v.z, v.w);
        xb2[i] = o;
      }
    }
    {
      float* C1P = (float*)(ws + O_C1P);
      float* red = (float*)smem;
      for (int item = blockIdx.x; item < 64; item += gridDim.x) {
        const int kvs = item >> 5, part = item & 31;
        const float* pos = p.in[kvs ? 17 : 14];
        const float* w1 = p.in[kvs ? 18 : 15];
        const int j = tid & 127, half = tid >> 7;
        const int i0 = part * 128 + half * 64;
        float acc = 0.f;
#pragma unroll 16
        for (int i = 0; i < 64; ++i) acc += pos[i0 + i] * w1[(size_t)(i0 + i) * 128 + j];
        __syncthreads();
        red[tid] = acc;
        __syncthreads();
        if (tid < 128) C1P[(size_t)item * 128 + tid] = red[tid] + red[tid + 128];
        __syncthreads();
      }
    }
    {
      float2* sE = (float2*)smem;
      float2* sCo = sE + 64;
      float2* sM = sCo + 64;
      float2* sC = sM + 1024;
      for (int item = blockIdx.x; item < 2 * 64 * 65; item += gridDim.x) {
        const int j = item % 65, lg = item / 65;
        const float* lam_re = p.in[2] + (size_t)lg * 64;
        const float* lam_im = p.in[3] + (size_t)lg * 64;
        const float dt = __expf(p.in[4][lg]);
        const float* b_re = p.in[5] + (size_t)lg * 1024;
        const float* b_im = p.in[6] + (size_t)lg * 1024;
        const float* c_re = p.in[7] + (size_t)lg * 1024;
        const float* c_im = p.in[8] + (size_t)lg * 1024;
#pragma unroll
        for (int i = 0; i < 4; ++i) sC[tid + i * 256] = make_float2(c_re[tid + i * 256], c_im[tid + i * 256]);
        if (tid < 64) {
          const float lr = lam_re[tid], li = lam_im[tid];
          const float mag = expf(lr * dt);
          float sn, cs;
          sincosf(li * dt, &sn, &cs);
          const float ar = mag * cs, ai = mag * sn;
          const float inv = 1.f / (lr * lr + li * li);
          const float cr = ((ar - 1.f) * lr + ai * li) * inv;
          const float ci = (ai * lr - (ar - 1.f) * li) * inv;
          sCo[tid] = make_float2(cr, ci);
          const float fj = (float)j;
          const float mj = expf(lr * dt * fj);
          float sj, cj;
          if (j == 64) sincosf(li * dt * fj, &sj, &cj);
          else __sincosf(li * dt * fj, &sj, &cj);
          sE[tid] = make_float2(mj * cj, mj * sj);
          if (j == 64) A64[(size_t)lg * 64 + tid] = make_float2(mj * cj, mj * sj);
        }
        __syncthreads();
#pragma unroll
        for (int i = 0; i < 4; ++i) {
          const int idx = tid + i * 256;
          const int pp = idx >> 4, ci = idx & 15;
          const float br = b_re[idx], bi = b_im[idx];
          const float2 co = sCo[pp];
          const float bbr = co.x * br - co.y * bi, bbi = co.x * bi + co.y * br;
          const float2 e = sE[pp];
          const float mr = e.x * bbr - e.y * bbi, mi = e.x * bbi + e.y * bbr;
          sM[idx] = make_float2(mr, mi);
          if (j < 64) {
            const int s = 63 - j;
            u16* w1p = W1 + (size_t)lg * 128 * 1024;
            w1p[(size_t)pp * 1024 + s * 16 + ci] = f2bf(mr);
            w1p[(size_t)(64 + pp) * 1024 + s * 16 + ci] = f2bf(mi);
          }
        }
        __syncthreads();
        if (j < 64) {
          const int co = tid >> 4, ci = tid & 15;
          float acc = 0.f;
          for (int pp = 0; pp < 64; ++pp) {
            const float2 m = sM[pp * 16 + ci];
            const float2 c = sC[co * 64 + pp];
            acc += c.x * m.x - c.y * m.y;
          }
          KTAB[(((size_t)lg * 64 + j) * 16 + co) * 16 + ci] = f2bf(acc);
        }
        if (j >= 1) {
          const int t = j - 1;
          u16* w3p = W3T + (size_t)lg * 1024 * 128;
#pragma unroll
          for (int i = 0; i < 4; ++i) {
            const int idx = tid + i * 256;
            const int co = idx >> 6, pp = idx & 63;
            const float cr = sC[idx].x, ci = sC[idx].y;
            const float2 e = sE[pp];
            const float re = cr * e.x - ci * e.y, im = cr * e.y + ci * e.x;
            w3p[(size_t)(t * 16 + co) * 128 + pp] = f2bf(re);
            w3p[(size_t)(t * 16 + co) * 128 + 64 + pp] = f2bf(-im);
          }
        }
        __syncthreads();
      }
    }
  }
  grid.sync();

  auto kmap64 = [](int ks) { return ks * 64; };

  for (int l = 0; l < 2; ++l) {
    const float* xres = (l == 0) ? p.in[0] : XF;
    {
      const int tid = tid_l(), lane = tid & 63, wave = tid >> 6; (void)lane; (void)wave;
      if (l == 0 && blockIdx.x == 0) {
        const float* C1P = (const float*)(ws + O_C1P);
        float a = 0.f;
        for (int part = 0; part < 32; ++part) a += C1P[((size_t)(tid >> 7) * 32 + part) * 128 + (tid & 127)];
        C1B[tid] = a;
      }
      const u16* Wt = W_AIN + (size_t)l * 2048 * 2048;
      for (int tile = blockIdx.x; tile < 64 * 8; tile += gridDim.x) {
        const int mt = tile & 63, nt = tile >> 6;
        gemm_tile_w(smem, mt * 128, nt * 256, 64,
                  [=](int m, int k0, int kc) { return ldg_o(XB + k0, (uint32_t)(m * 2048 + kc) * 2u); },
                  [=](int n, int k0, int kc) { return ldg_o(Wt + k0, (uint32_t)(n * 2048 + kc) * 2u); },
                  [=](int m, int n, f32x4 v) { st_bf4(UZ + (size_t)m * 2048 + n, v); });
      }
    }
    xcd_barrier(xb);
    {
      float* sS = (float*)smem;
      if (l == 0) do_jobs((1u << 1) | (1u << 3) | (1u << 5) | (1u << 6) | (1u << 11), 64, (int)gridDim.x - 64);
      else do_jobs((1u << 12) | (1u << 13) | (1u << 14), 64, (int)gridDim.x - 64);
      for (int g = blockIdx.x; g < 64; g += gridDim.x) {
        const u16* w1p = W1 + ((size_t)l * 64 + g) * 128 * 1024;
        gemm_tile<1, false>(smem, 0, 0, 16, kmap64,
                  [=](int m, int k0, int kc) { return ldg_o(UZ + (size_t)(k0 >> 4) * 2048 + g * 16, (uint32_t)((m * 64 + (kc >> 4)) * 2048 + (kc & 15)) * 2u); },
                  [=](int n, int k0, int kc) { return ldg_o(w1p + k0, (uint32_t)(n * 1024 + kc) * 2u); },
                  [=](int m, int n, f32x4 v) { *(f32x4*)(sS + m * 132 + n) = v; });
        __syncthreads();
        const int tid = tid_l();
        if (tid < 128) {
          const int b = tid >> 6, pp = tid & 63;
          const float2 a = A64[((size_t)l * 64 + g) * 64 + pp];
          float hr = 0.f, hi = 0.f;
          const float* sp = sS + (b * 64) * 132;
          u16* hp = HIN + ((size_t)g * 128 + b * 64) * 128;
#pragma unroll 4
          for (int c = 0; c < 64; ++c) {
            hp[c * 128 + pp] = f2bf(hr);
            hp[c * 128 + 64 + pp] = f2bf(hi);
            const float sr = sp[c * 132 + pp], si = sp[c * 132 + 64 + pp];
            const float nr = a.x * hr - a.y * hi + sr;
            const float ni = a.x * hi + a.y * hr + si;
            hr = nr; hi = ni;
          }
        }
        __syncthreads();
      }
    }
    xcd_barrier(xb);
    {
      const float* dsk = p.in[9] + (size_t)l * 1024;
      for (int tile = blockIdx.x; tile < 64 * 8; tile += gridDim.x) {
        const int g = tile >> 3, nt = 7 - (tile & 7);
        const int nks1 = 2 * nt + 2;
        const u16* ktab = KTAB + ((size_t)l * 64 + g) * 64 * 256;
        const u16* w3p = W3T + ((size_t)l * 64 + g) * 1024 * 128;
        const u16* hp = HIN + (size_t)g * 128 * 128;
        gemm_tile(smem, 0, nt * 128, nks1 + 2,
                  [=](int ks) { return ks < nks1 ? ks * 64 : 1024 + (ks - nks1) * 64; },
                  [=](int m, int k0, int kc) {
                    if (k0 < 1024) return ldg_o(UZ + (size_t)(k0 >> 4) * 2048 + g * 16, (uint32_t)((m * 64 + (kc >> 4)) * 2048 + (kc & 15)) * 2u);
                    return ldg_o(hp + (k0 - 1024), (uint32_t)(m * 128 + kc) * 2u);
                  },
                  [=](int n, int k0, int kc) {
                    if (k0 < 1024) {
                      const int lag = (n >> 4) - (kc >> 4) - (k0 >> 4);
                      if (lag < 0) return make_uint4(0u, 0u, 0u, 0u);
                      return ldg_o(ktab, (uint32_t)((lag * 16 + (n & 15)) * 16 + (kc & 15)) * 2u);
                    }
                    return ldg_o(w3p + (k0 - 1024), (uint32_t)(n * 128 + kc) * 2u);
                  },
                  [=](int m, int n, f32x4 v) {
                    const int t = n >> 4, co = n & 15;
                    const size_t tok = (size_t)m * 64 + t;
                    const int ch = g * 16 + co;
                    const f32x4 u = ld_bf4(UZ + tok * 2048 + ch);
                    const f32x4 d = *(const f32x4*)(dsk + ch);
                    f32x4 r;
#pragma unroll
                    for (int i = 0; i < 4; ++i) r[i] = gelu_tanh(v[i] + d[i] * u[i]);
                    st_bf4(GB + tok * 1024 + ch, r);
                  });
      }
    }
    xcd_barrier(xb);
    {
      const u16* Wt = W_GLU + (size_t)l * 1024 * 1024;
      const float* bg = p.in[11] + (size_t)l * 1024;
      for (int tile = blockIdx.x; tile < 64 * 8; tile += gridDim.x) {
        const int mt = tile & 63, nt = tile >> 6;
        gemm_tile(smem, mt * 128, nt * 128, 16, kmap64,
                  [=](int m, int k0, int kc) { return ldg_o(GB + k0, (uint32_t)(m * 1024 + kc) * 2u); },
                  [=](int n, int k0, int kc) { return ldg_o(Wt + k0, (uint32_t)(n * 1024 + kc) * 2u); },
                  [=](int m, int n, f32x4 v) {
                    const f32x4 gg = ld_bf4(GB + (size_t)m * 1024 + n);
                    const f32x4 zz = ld_bf4(UZ + (size_t)m * 2048 + 1024 + n);
                    const f32x4 bb = *(const f32x4*)(bg + n);
                    f32x4 r;
#pragma unroll
                    for (int i = 0; i < 4; ++i) r[i] = gg[i] * sigm(v[i] + bb[i]) * silu(zz[i]);
                    st_bf4(VB + (size_t)m * 1024 + n, r);
                  });
      }
    }
    xcd_barrier(xb);
    {
      const u16* Wt = W_AOUT + (size_t)l * 2048 * 1024;
      for (int tile = blockIdx.x; tile < 64 * 8; tile += gridDim.x) {
        const int mt = tile & 63, nt = tile >> 6;
        const float2* stp = STATS;
        const float* pgam = p.in[22] + (size_t)(l > 0 ? l - 1 : 0) * 2048;
        const float* pbet = p.in[23] + (size_t)(l > 0 ? l - 1 : 0) * 2048;
        gemm_tile_w<true>(smem, mt * 128, nt * 256, 32,
                  [=](int m, int k0, int kc) { return ldg_o(VB + k0, (uint32_t)(m * 1024 + kc) * 2u); },
                  [=](int n, int k0, int kc) { return ldg_o(Wt + k0, (uint32_t)(n * 1024 + kc) * 2u); },
                  [=](int m, int n, f32x4 v, f32x4 xr) {
                    if (l > 0) {
                      const float2 st = stp[m];
                      const f32x4 gg = *(const f32x4*)(pgam + n);
                      const f32x4 bb = *(const f32x4*)(pbet + n);
#pragma unroll
                      for (int i = 0; i < 4; ++i) xr[i] = (xr[i] - st.x) * st.y * gg[i] + bb[i];
                    }
                    f32x4 r;
#pragma unroll
                    for (int i = 0; i < 4; ++i) r[i] = DN_ALPHA * xr[i] + v[i];
                    *(f32x4*)((char*)XF + (uint32_t)(m * 2048 + n) * 4u) = r;
                  },
                  [=](int m, int n) { return *(const f32x4*)((const char*)xres + (uint32_t)(m * 2048 + n) * 4u); });
      }
    }
    xcd_barrier(xb);
    {
      const int tid = tid_l(), lane = tid & 63, wave = tid >> 6; (void)lane; (void)wave;
      const float* lg_ = p.in[22] + (size_t)l * 2048;
      const float* lb_ = p.in[23] + (size_t)l * 2048;
      for (int row = blockIdx.x * 4 + wave; row < NTOK; row += gridDim.x * 4) {
        float* xr = XF + (size_t)row * 2048;
        f32x4 v[8];
        float sum = 0.f;
#pragma unroll
        for (int i = 0; i < 8; ++i) { v[i] = *(const f32x4*)(xr + i * 256 + lane * 4); sum += v[i][0] + v[i][1] + v[i][2] + v[i][3]; }
#pragma unroll
        for (int o = 32; o >= 1; o >>= 1) sum += __shfl_xor(sum, o);
        const float mu = sum * (1.f / 2048.f);
        float sq = 0.f;
#pragma unroll
        for (int i = 0; i < 8; ++i)
#pragma unroll
          for (int e = 0; e < 4; ++e) { const float d = v[i][e] - mu; sq += d * d; }
#pragma unroll
        for (int o = 32; o >= 1; o >>= 1) sq += __shfl_xor(sq, o);
        const float rstd = rsqrtf(sq * (1.f / 2048.f) + LN_EPS);
#pragma unroll
        for (int i = 0; i < 8; ++i) {
          const int c = i * 256 + lane * 4;
          const f32x4 gg = *(const f32x4*)(lg_ + c);
          const f32x4 bb = *(const f32x4*)(lb_ + c);
          f32x4 r;
#pragma unroll
          for (int e = 0; e < 4; ++e) r[e] = (v[i][e] - mu) * rstd * gg[e] + bb[e];
          st_bf4(XB + (size_t)row * 2048 + c, r);
        }
        if (lane == 0) STATS[row] = make_float2(mu, rstd);
      }
    }
    xcd_barrier(xb);
  }

  {
    for (int tile = blockIdx.x; tile < 64 * 24; tile += gridDim.x) {
      const int mt = tile & 63, nt = tile >> 6;
      gemm_tile(smem, mt * 128, nt * 128, 32, kmap64,
                [=](int m, int k0, int kc) { return ldg_o(XB + k0, (uint32_t)(m * 2048 + kc) * 2u); },
                [=](int n, int k0, int kc) { return ldg_o(W_KV + k0, (uint32_t)(n * 2048 + kc) * 2u); },
                [=](int m, int n, f32x4 v) { st_bf4(KV + (size_t)m * KV_LD + n, v); });
    }
  }
  xcd_barrier(xb);
  for (int lb = 0; lb < 2; ++lb) {
    const int layer = 2 + lb;
    {
      const u16* Wt = W_BIN + (size_t)lb * PROJ_LD * 2048;
      if (lb == 0 && blockIdx.x >= 64 && blockIdx.x < 128) {
        const int ct = blockIdx.x - 64;
        const int half = ct >> 5, kvs = (ct >> 4) & 1, mt = ct & 15;
        const u16* Wc = W_C1 + (size_t)kvs * 128 * 4096;
        float* t1 = T1P + ((size_t)(half * 2 + kvs)) * 2048 * 128;
        gemm_tile<1>(smem, mt * 128, 0, 32, [=](int ks) { return half * 2048 + ks * 64; },
                  [=](int m, int k0, int kc) {
                    const int b = m >> 10, n = (m >> 2) & 255, g = m & 3;
                    int tok = n * 16 + (k0 >> 7);
                    tok = tok > 4095 ? 4095 : tok;
                    return ldg_o(KV + kvs * 512 + (k0 & 127), (uint32_t)((b * 4096 + tok) * KV_LD + g * 128 + kc) * 2u);
                  },
                  [=](int n, int k0, int kc) { return ldg_o(Wc + k0, (uint32_t)(n * 4096 + kc) * 2u); },
                  [=](int m, int n, f32x4 v) { *(f32x4*)(t1 + (size_t)m * 128 + n) = v; });
      }
      for (int rep = 0; rep < REPS_BIN; ++rep)
      for (int tile = blockIdx.x; tile < 64 * 32; tile += gridDim.x) {
        const int mt = tile & 63, nt = tile >> 6;
        gemm_tile_w(smem, mt * 128, nt * 256, 64,
                  [=](int m, int k0, int kc) { return ldg_o(XB + k0, (uint32_t)(m * 2048 + kc) * 2u); },
                  [=](int n, int k0, int kc) { return ldg_o(Wt + k0, (uint32_t)(n * 2048 + kc) * 2u); },
                  [=](int m, int n, f32x4 v) { st_bf4(PROJ + (size_t)m * PROJ_LD + n, v); });
      }
      for (int tile = blockIdx.x; tile < 64; tile += gridDim.x) {
        const int mt = tile & 63, nt = 64;
        gemm_tile(smem, mt * 128, nt * 128, 32, kmap64,
                  [=](int m, int k0, int kc) { return ldg_o(XB + k0, (uint32_t)(m * 2048 + kc) * 2u); },
                  [=](int n, int k0, int kc) { return ldg_o(Wt + k0, (uint32_t)(n * 2048 + kc) * 2u); },
                  [=](int m, int n, f32x4 v) { st_bf4(PROJ + (size_t)m * PROJ_LD + n, v); });
      }
    }
    xcd_barrier(xb);
    if (lb == 0) {
      for (int tile = blockIdx.x; tile < 32; tile += gridDim.x) {
        const int kvs = tile >> 4, mt = tile & 15;
        const u16* Wt = W_C2 + (size_t)kvs * 128 * 128;
        const float* t1a = T1P + ((size_t)kvs) * 2048 * 128;
        const float* t1b = T1P + ((size_t)(2 + kvs)) * 2048 * 128;
        const float* cb = C1B + kvs * 128;
        u16* kc_ = KCVC + (size_t)kvs * 2048 * 128;
        gemm_tile<1>(smem, mt * 128, 0, 2, kmap64,
                  [=](int m, int k0, int kc) {
                    const int k = k0 + kc;
                    const f32x4 a0 = *(const f32x4*)(t1a + (size_t)m * 128 + k), a1 = *(const f32x4*)(t1a + (size_t)m * 128 + k + 4);
                    const f32x4 b0 = *(const f32x4*)(t1b + (size_t)m * 128 + k), b1 = *(const f32x4*)(t1b + (size_t)m * 128 + k + 4);
                    const f32x4 c0 = *(const f32x4*)(cb + k), c1 = *(const f32x4*)(cb + k + 4);
                    uint4 r;
                    r.x = pack2(gelu_tanh(a0[0] + b0[0] + c0[0]), gelu_tanh(a0[1] + b0[1] + c0[1]));
                    r.y = pack2(gelu_tanh(a0[2] + b0[2] + c0[2]), gelu_tanh(a0[3] + b0[3] + c0[3]));
                    r.z = pack2(gelu_tanh(a1[0] + b1[0] + c1[0]), gelu_tanh(a1[1] + b1[1] + c1[1]));
                    r.w = pack2(gelu_tanh(a1[2] + b1[2] + c1[2]), gelu_tanh(a1[3] + b1[3] + c1[3]));
                    return r;
                  },
                  [=](int n, int k0, int kc) { return ldg_o(Wt + k0, (uint32_t)(n * 128 + kc) * 2u); },
                  [=](int m, int n, f32x4 v) {
                    if (((m >> 2) & 255) == 255) v = f32x4{0.f, 0.f, 0.f, 0.f};
                    st_bf4(kc_ + (size_t)m * 128 + n, v);
                  });
      }
      xcd_barrier(xb);
    }
#ifndef NO_ATTN
    {
      u16* sK = smem;
      u16* sV = smem + 2 * 64 * 136;
      uint32_t* imp = (uint32_t*)(smem + 2 * 64 * 136 + 2 * 64 * 144);
      unsigned long long* selm = (unsigned long long*)(imp + 32 * 65);
      const int tid = tid_l(), lane = tid & 63, wave = tid >> 6;
      const int l15 = lane & 15, quad = lane >> 4;
      const u16* KC = KCVC;
      const u16* VC = KCVC + (size_t)2048 * 128;
      for (int rep = 0; rep < REPS_ATTN; ++rep)
      for (int item = blockIdx.x; item < 1024; item += gridDim.x) {
        const int qt = (item < 512) ? (127 - (item >> 3)) : ((item - 512) >> 3);
        const int bg = item & 7, b = bg >> 2, g = bg & 3;
        const int t0 = qt * 32, h = g * 4 + wave;
        const size_t tokbase = (size_t)b * SEQ;
        const int cur = t0 >> 6;
        if (DESYNC_COND) __builtin_amdgcn_s_sleep(60);
        for (int i = tid; i < 32 * 65; i += 256) imp[i] = 0u;
        bf16x8 qf[2][4];
#pragma unroll
        for (int qs = 0; qs < 2; ++qs)
#pragma unroll
          for (int ds = 0; ds < 4; ++ds) {
            uint4 v = ldg16(PROJ + (tokbase + t0 + qs * 16 + l15) * PROJ_LD + h * 128 + ds * 32 + quad * 8);
            union { uint4 u; bf16x8 v; } cv; cv.u = v; qf[qs][ds] = cv.v;
          }
        const int tq0 = t0 + l15, tq1 = t0 + 16 + l15;
        f32x4 o[2][8];
        float mrow[2], lrow[2], linv[2];
        auto zero_o = [&]() {
#pragma unroll
          for (int qs = 0; qs < 2; ++qs)
#pragma unroll
            for (int dt = 0; dt < 8; ++dt) o[qs][dt] = f32x4{0.f, 0.f, 0.f, 0.f};
        };
        auto finish_l = [&]() {
#pragma unroll
          for (int qs = 0; qs < 2; ++qs) {
            float lsum = lrow[qs];
            lsum += __shfl_xor(lsum, 16);
            lsum += __shfl_xor(lsum, 32);
            linv[qs] = 1.f / fmaxf(lsum, 1e-30f);
          }
        };
        auto emit = [&](int br, bool first, bool scale_l) {
          float* wbuf = (float*)smem + wave * (16 * 132);
          const int rrow = lane >> 5, rcol = (lane & 31) * 4;
          const int tb = (int)tokbase + t0;
          const uint32_t zoff0 = (uint32_t)((tb + rrow) * PROJ_LD + 2048 + br * 2048 + h * 128 + rcol) * 2u;
          const uint32_t yoff0 = (uint32_t)((tb + rrow) * 2048 + h * 128 + rcol) * 2u;
          const u16 graw0 = *(const u16*)((const char*)PROJ + (uint32_t)((tb + l15) * PROJ_LD + 8192 + br * 16 + h) * 2u);
          const u16 graw1 = *(const u16*)((const char*)PROJ + (uint32_t)((tb + 16 + l15) * PROJ_LD + 8192 + br * 16 + h) * 2u);
#pragma unroll
          for (int qs = 0; qs < 2; ++qs) {
            const float gate = sigm(bf2f(qs ? graw1 : graw0));
            const float sc = scale_l ? gate * linv[qs] : gate;
#pragma unroll
            for (int dt = 0; dt < 8; ++dt) *(f32x4*)(wbuf + l15 * 132 + dt * 16 + quad * 4) = o[qs][dt] * sc;
            __builtin_amdgcn_wave_barrier();
#pragma unroll 4
            for (int j = 0; j < 8; ++j) {
              const uint32_t zo = zoff0 + (uint32_t)((qs * 16 + j * 2) * PROJ_LD) * 2u;
              const uint32_t yo = yoff0 + (uint32_t)((qs * 16 + j * 2) * 2048) * 2u;
              const f32x4 a = *(const f32x4*)(wbuf + (j * 2 + rrow) * 132 + rcol);
              const f32x4 zz = ld_bf4((const u16*)((const char*)PROJ + zo));
              u16* yp = (u16*)((char*)YB + yo);
              f32x4 r;
#pragma unroll
              for (int e = 0; e < 4; ++e) r[e] = a[e] * silu(zz[e]);
              if (!first) {
                const f32x4 old = ld_bf4(yp);
#pragma unroll
                for (int e = 0; e < 4; ++e) r[e] += old[e];
              }
              st_bf4(yp, r);
            }
          }
          __syncthreads();
        };
#ifndef NO_CMP
        {
          int nmax = t0 >> 4; if (nmax > 254) nmax = 254;
          const int ntl = (nmax >> 6) + 1;
          auto tilefn = [&](int i, const u16*& kb, const u16*& vb, size_t& rs, int& kp) {
            const size_t off = (((size_t)b * 256 + i * 64) * 4 + g) * 128;
            kb = KC + off; vb = VC + off; rs = 512; kp = i * 64;
          };
          auto valid = [&](int kpos, int qs) { return kpos * 16 + 31 <= (qs ? tq1 : tq0); };
          mrow[0] = mrow[1] = -1e30f; lrow[0] = lrow[1] = 0.f; linv[0] = linv[1] = 1.f;
          auto nobias = [](int, int) { return 0.f; };
          auto allem = [](int) { return true; };
          attn_loop<1>(sK, sV, imp, ntl, tilefn, nobias, allem, valid, qf, o, mrow, lrow, linv);
          finish_l();
          zero_o();
          attn_loop<2>(sK, sV, imp, ntl, tilefn, nobias, allem, valid, qf, o, mrow, lrow, linv);
          emit(0, true, false);
        }
#endif
        {
#pragma unroll 1
          for (int tt = 0; tt < 8; ++tt) {
            const int tok = wave * 8 + tt;
            unsigned long long mask;
            if (cur < 16) {
              mask = (2ull << cur) - 1ull;
            } else {
              const uint32_t v = imp[tok * 65 + lane];
              const bool cand = (lane >= 1) && (lane <= cur - 2);
              const unsigned long long cm = __ballot(cand);
              uint32_t T = 0u;
#pragma unroll 1
              for (int bit = 30; bit >= 0; --bit) {
                const uint32_t tr = T | (1u << bit);
                const unsigned long long m = __ballot(v >= tr) & cm;
                if (__popcll(m) >= 13) T = tr;
              }
              const unsigned long long gt = __ballot(v > T) & cm;
              unsigned long long eq = __ballot(v == T) & cm;
              int need = 13 - (int)__popcll(gt);
              unsigned long long pick = 0ull;
              while (need > 0 && eq != 0ull) {
                const unsigned long long low = eq & (0ull - eq);
                pick |= low; eq ^= low; --need;
              }
              mask = gt | pick | 1ull | (1ull << cur) | (1ull << (cur - 1));
            }
            if (lane == 0) selm[tok] = mask;
          }
          __syncthreads();
        }
        const unsigned long long sm0 = selm[l15], sm1 = selm[16 + l15];
#ifndef NO_SEL
        {
          auto tilefn = [&](int i, const u16*& kb, const u16*& vb, size_t& rs, int& kp) {
            const size_t off = (tokbase + (size_t)i * 64) * KV_LD + 1024 + g * 128;
            kb = KV + off; vb = KV + off + 512; rs = KV_LD; kp = i * 64;
          };
          auto valid = [&](int kpos, int qs) { return kpos <= (qs ? tq1 : tq0); };
          auto biasfn = [&](int i, int qs) { return (((qs ? sm1 : sm0) >> i) & 1ull) ? 0.f : -1e30f; };
          auto emfn = [&](int i) { return i == cur; };
          mrow[0] = mrow[1] = -1e30f; lrow[0] = lrow[1] = 0.f;
          zero_o();
          attn_loop<0>(sK, sV, imp, cur + 1, tilefn, biasfn, emfn, valid, qf, o, mrow, lrow, linv);
          finish_l();
          emit(1, false, true);
        }
#endif
#ifndef NO_WIN
        {
          int jt0 = (t0 - 511) >> 6; if (jt0 < 0) jt0 = 0;
          auto tilefn = [&](int i, const u16*& kb, const u16*& vb, size_t& rs, int& kp) {
            const size_t off = (tokbase + (size_t)(jt0 + i) * 64) * KV_LD + 2048 + g * 128;
            kb = KV + off; vb = KV + off + 512; rs = KV_LD; kp = (jt0 + i) * 64;
          };
          auto valid = [&](int kpos, int qs) {
            const int t = qs ? tq1 : tq0;
            return (kpos <= t) && (kpos > t - 512);
          };
          auto biasfn = [](int, int) { return 0.f; };
          auto emfn = [&](int i) { const int kp = (jt0 + i) * 64; return !((kp + 63 <= t0) && (kp > t0 + 31 - 512)); };
          mrow[0] = mrow[1] = -1e30f; lrow[0] = lrow[1] = 0.f;
          zero_o();
          attn_loop<0>(sK, sV, imp, cur - jt0 + 1, tilefn, biasfn, emfn, valid, qf, o, mrow, lrow, linv);
          finish_l();
          emit(2, false, true);
        }
#endif
        __syncthreads();
      }
    }
#endif
    xcd_barrier(xb);
    {
      const u16* Wt = W_BOUT + (size_t)lb * 2048 * 2048;
      for (int tile = blockIdx.x; tile < 64 * 8; tile += gridDim.x) {
        const int mt = tile & 63, nt = tile >> 6;
        const float2* stp = STATS;
        const float* pgam = p.in[22] + (size_t)(layer - 1) * 2048;
        const float* pbet = p.in[23] + (size_t)(layer - 1) * 2048;
        gemm_tile_w<true>(smem, mt * 128, nt * 256, 64,
                  [=](int m, int k0, int kc) { return ldg_o(YB + k0, (uint32_t)(m * 2048 + kc) * 2u); },
                  [=](int n, int k0, int kc) { return ldg_o(Wt + k0, (uint32_t)(n * 2048 + kc) * 2u); },
                  [=](int m, int n, f32x4 v, f32x4 xr) {
                    const float2 st = stp[m];
                    const f32x4 gg = *(const f32x4*)(pgam + n);
                    const f32x4 bb = *(const f32x4*)(pbet + n);
                    f32x4 r;
#pragma unroll
                    for (int i = 0; i < 4; ++i) r[i] = DN_ALPHA * ((xr[i] - st.x) * st.y * gg[i] + bb[i]) + v[i];
                    *(f32x4*)((char*)XF + (uint32_t)(m * 2048 + n) * 4u) = r;
                  },
                  [=](int m, int n) { return *(const f32x4*)((const char*)XF + (uint32_t)(m * 2048 + n) * 4u); });
      }
    }
    xcd_barrier(xb);
    {
      const int tid = tid_l(), lane = tid & 63, wave = tid >> 6; (void)lane; (void)wave;
      const float* lg_ = p.in[22] + (size_t)layer * 2048;
      const float* lb_ = p.in[23] + (size_t)layer * 2048;
      const bool last = (lb == 1);
      for (int row = blockIdx.x * 4 + wave; row < NTOK; row += gridDim.x * 4) {
        float* xr = XF + (size_t)row * 2048;
        float* orow = last ? (p.out + (size_t)row * 2048) : xr;
        f32x4 v[8];
        float sum = 0.f;
#pragma unroll
        for (int i = 0; i < 8; ++i) { v[i] = *(const f32x4*)(xr + i * 256 + lane * 4); sum += v[i][0] + v[i][1] + v[i][2] + v[i][3]; }
#pragma unroll
        for (int o = 32; o >= 1; o >>= 1) sum += __shfl_xor(sum, o);
        const float mu = sum * (1.f / 2048.f);
        float sq = 0.f;
#pragma unroll
        for (int i = 0; i < 8; ++i)
#pragma unroll
          for (int e = 0; e < 4; ++e) { const float d = v[i][e] - mu; sq += d * d; }
#pragma unroll
        for (int o = 32; o >= 1; o >>= 1) sq += __shfl_xor(sq, o);
        const float rstd = rsqrtf(sq * (1.f / 2048.f) + LN_EPS);
#pragma unroll
        for (int i = 0; i < 8; ++i) {
          const int c = i * 256 + lane * 4;
          const f32x4 gg = *(const f32x4*)(lg_ + c);
          const f32x4 bb = *(const f32x4*)(lb_ + c);
          f32x4 r;
#pragma unroll
          for (int e = 0; e < 4; ++e) r[e] = (v[i][e] - mu) * rstd * gg[e] + bb[e];
          if (last) *(f32x4*)(orow + c) = r;
          else st_bf4(XB + (size_t)row * 2048 + c, r);
        }
        if (!last && lane == 0) STATS[row] = make_float2(mu, rstd);
      }
    }
    if (lb == 0) xcd_barrier(xb);
  }
}

extern "C" void kernel_launch(void* const* d_in, const int* in_sizes, int n_in, void* d_out, int out_size, void* d_ws,
                              size_t ws_size, hipStream_t stream) {
  static int grid_blocks = 0;
  if (!grid_blocks) {
    int dev = 0, cus = 0, per_cu = 0;
    hipGetDevice(&dev);
    hipDeviceGetAttribute(&cus, hipDeviceAttributeMultiprocessorCount, dev);
    hipOccupancyMaxActiveBlocksPerMultiprocessor(&per_cu, yoco_fwd, 256, 0);
    if (per_cu > 2) per_cu = 2;
    if (per_cu < 1) per_cu = 1;
    grid_blocks = cus * per_cu;
  }
  Params p{};
  for (int i = 0; i < 24; ++i) p.in[i] = (const float*)d_in[i];
  p.out = (float*)d_out;
  p.ws = (char*)d_ws;
  if (ws_size < WS_TOTAL) fprintf(stderr, "workspace too small: %zu < %zu\n", ws_size, (size_t)WS_TOTAL);
  (void)hipMemsetAsync((char*)d_ws + O_BAR, 0, XCD_BAR_WORDS * 4, stream);
  void* args[] = {&p};
  hipError_t e = hipLaunchCooperativeKernel((void*)yoco_fwd, dim3(grid_blocks), dim3(256), args, 0, stream);
  if (e != hipSuccess) fprintf(stderr, "cooperative launch failed: %s (grid %d)\n", hipGetErrorString(e), grid_blocks);
}
```

```cpp
#include <hip/hip_runtime.h>
#include <hip/hip_cooperative_groups.h>
#include <stdint.h>
#include <stdio.h>
namespace cg = cooperative_groups;

typedef __attribute__((ext_vector_type(8))) short bf16x8;
typedef __attribute__((ext_vector_type(4))) short s16x4;
typedef __attribute__((ext_vector_type(4))) float f32x4;
typedef unsigned short u16;
#define DI __device__ __forceinline__

#define DESYNC_COND (blockIdx.x >= 256)
#ifndef ATT_SAFE
#define ATT_SAFE 0
#endif
#ifndef REPS_ATTN
#define REPS_ATTN 1
#endif
#ifndef REPS_BIN
#define REPS_BIN 1
#endif
#ifndef REPS_SSM
#define REPS_SSM 1
#endif
#ifndef REPS_P0
#define REPS_P0 1
#endif
constexpr int NTOK = 8192, DM = 2048, SEQ = 4096, EW = 1024;
constexpr int PROJ_LD = 8320, BIN_N = 8240, KV_LD = 3072;
constexpr float DN_ALPHA = 1.681792830507429f;
constexpr float LN_EPS = 1e-5f;
constexpr float SCALE2 = 0.08838834764831845f * 1.4426950408889634f;

constexpr size_t al256(size_t x) { return (x + 255) & ~(size_t)255; }
constexpr size_t O_WAIN = 0;
constexpr size_t O_WGLU = O_WAIN + al256((size_t)2 * 2048 * 2048 * 2);
constexpr size_t O_WAOUT = O_WGLU + al256((size_t)2 * 1024 * 1024 * 2);
constexpr size_t O_WKV = O_WAOUT + al256((size_t)2 * 2048 * 1024 * 2);
constexpr size_t O_WC1 = O_WKV + al256((size_t)3072 * 2048 * 2);
constexpr size_t O_WC2 = O_WC1 + al256((size_t)2 * 128 * 4096 * 2);
constexpr size_t O_WBIN = O_WC2 + al256((size_t)2 * 128 * 128 * 2);
constexpr size_t O_WBOUT = O_WBIN + al256((size_t)2 * PROJ_LD * 2048 * 2);
constexpr size_t O_XB = O_WBOUT + al256((size_t)2 * 2048 * 2048 * 2);
constexpr size_t O_XF = O_XB + al256((size_t)NTOK * DM * 2);
constexpr size_t O_KV = O_XF + al256((size_t)NTOK * DM * 4);
constexpr size_t O_T1 = O_KV + al256((size_t)NTOK * KV_LD * 2);
constexpr size_t O_KCVC = O_T1 + al256((size_t)2 * 2 * 2048 * 128 * 4);
constexpr size_t O_C1B = O_KCVC + al256((size_t)2 * 2048 * 128 * 2);
constexpr size_t O_C1P = O_C1B + al256((size_t)2 * 128 * 4);
constexpr size_t O_BAR = O_C1P + al256((size_t)64 * 128 * 4);
constexpr size_t O_STATS = O_BAR + al256((size_t)4096 * 4);
constexpr size_t O_YB = O_STATS + al256((size_t)NTOK * 8);
constexpr size_t O_UNION = O_YB + al256((size_t)NTOK * DM * 2);
constexpr size_t O_UZ = O_UNION;
constexpr size_t O_G = O_UZ + al256((size_t)NTOK * 2048 * 2);
constexpr size_t O_V = O_G + al256((size_t)NTOK * 1024 * 2);
constexpr size_t O_S = O_V + al256((size_t)NTOK * 1024 * 2);
constexpr size_t O_HIN = O_S + al256((size_t)64 * 128 * 128 * 4);
constexpr size_t O_W1 = O_HIN + al256((size_t)64 * 128 * 128 * 2);
constexpr size_t O_W3T = O_W1 + al256((size_t)2 * 64 * 128 * 1024 * 2);
constexpr size_t O_KTAB = O_W3T + al256((size_t)2 * 64 * 1024 * 128 * 2);
constexpr size_t O_A64 = O_KTAB + al256((size_t)2 * 64 * 64 * 256 * 2);
constexpr size_t O_S5END = O_A64 + al256((size_t)2 * 64 * 64 * 8);
constexpr size_t O_PROJ = O_UNION;
constexpr size_t O_PROJEND = O_PROJ + al256((size_t)NTOK * PROJ_LD * 2);
constexpr size_t WS_TOTAL = (O_S5END > O_PROJEND ? O_S5END : O_PROJEND);

struct Params {
  const float* in[24];
  float* out;
  char* ws;
};

DI u16 f2bf(float f) { uint32_t u = __float_as_uint(f); u += 0x7fffu + ((u >> 16) & 1u); return (u16)(u >> 16); }
typedef float f32x2_t __attribute__((ext_vector_type(2)));
typedef __bf16 bf16x2_t __attribute__((ext_vector_type(2)));
DI uint32_t pack2(float a, float b) { f32x2_t v = {a, b}; bf16x2_t h = __builtin_convertvector(v, bf16x2_t); return __builtin_bit_cast(uint32_t, h); }
DI float bflo(uint32_t v) { return __uint_as_float(v << 16); }
DI float bfhi(uint32_t v) { return __uint_as_float(v & 0xffff0000u); }
DI float bf2f(u16 h) { return __uint_as_float(((uint32_t)h) << 16); }
DI uint4 ldg16(const void* p) { return *(const uint4*)p; }
DI uint4 ldg_o(const void* base, uint32_t byte_off) { return *(const uint4*)((const char*)base + byte_off); }
DI float sigm(float x) { return __builtin_amdgcn_rcpf(1.f + __expf(-x)); }
DI float silu(float x) { return x * sigm(x); }
DI float gelu_tanh(float x) { float u = 0.7978845608028654f * (x + 0.044715f * x * x * x); return x * sigm(2.f * u); }
DI void st_bf4(u16* p, f32x4 v) { uint2 o; o.x = pack2(v[0], v[1]); o.y = pack2(v[2], v[3]); *(uint2*)p = o; }
DI f32x4 ld_bf4(const u16* p) { uint2 o = *(const uint2*)p; f32x4 r; r[0] = bflo(o.x); r[1] = bfhi(o.x); r[2] = bflo(o.y); r[3] = bfhi(o.y); return r; }

DI int tid_l() { int t = threadIdx.x; asm volatile("" : "+v"(t)); return t; }


#define XB_TMO      128
#define XB_XCNT(j)  (256  + 64 * (j))
#define XB_XSUB(j)  (1280 + 64 * (j))
#define XB_XGEN(j)  (2304 + 64 * (j))
#define XB_TOP      3328
#define XB_TOPGEN   3392
#define XCD_BAR_WORDS 3456
#define XB_SPIN_CAP (1u << 22)
#define LAS __attribute__((address_space(3)))
DI unsigned xb_ld(unsigned* p) { return __hip_atomic_load(p, __ATOMIC_RELAXED, __HIP_MEMORY_SCOPE_AGENT); }
DI unsigned xb_add(unsigned* p, unsigned v) { return __hip_atomic_fetch_add(p, v, __ATOMIC_RELAXED, __HIP_MEMORY_SCOPE_AGENT); }
DI unsigned xb_xcc_id() { return (unsigned)__builtin_amdgcn_s_getreg((3 << 11) | 20) & 0xFu; }
#define XB_SPIN(cond, bar) do { unsigned _sp = 0; while (cond) { __builtin_amdgcn_s_sleep(1); \
    if ((++_sp & 255u) == 0u) { if (xb_ld(&(bar)[XB_TMO])) break; if (_sp > XB_SPIN_CAP) { atomicAdd(&(bar)[XB_TMO], 1u); break; } } } } while (0)
struct XcdBarrier { unsigned* bar; unsigned x; volatile LAS unsigned* st; };
DI XcdBarrier xcd_barrier_post(unsigned* bar, volatile LAS unsigned* st) {
  XcdBarrier b; b.bar = bar; b.x = xb_xcc_id(); b.st = st;
  if (threadIdx.x == 0) (void)xb_add(&bar[XB_XCNT(b.x)], 1u);
  return b;
}
DI void xcd_barrier_complete(unsigned* bar, unsigned x, unsigned& nloc, unsigned& nx) {
  const unsigned G = gridDim.x * gridDim.y * gridDim.z;
  unsigned sum, cnt, mine, sp = 0u;
  for (;;) {
    sum = 0u; cnt = 0u; mine = 0u;
#pragma unroll
    for (unsigned j = 0; j < 16; ++j) { const unsigned c = xb_ld(&bar[XB_XCNT(j)]); sum += c; cnt += (c > 0u) ? 1u : 0u; mine = (j == x) ? c : mine; }
    if (sum == G) break;
    __builtin_amdgcn_s_sleep(1);
    if ((++sp & 255u) == 0u) { if (xb_ld(&bar[XB_TMO])) break; if (sp > XB_SPIN_CAP) { atomicAdd(&bar[XB_TMO], 1u); break; } }
  }
  nloc = mine > 0u ? mine : 1u; nx = cnt > 0u ? cnt : 1u;
}
DI void xcd_barrier(const XcdBarrier& b) {
  asm volatile("s_waitcnt vmcnt(0)" ::: "memory");
  __syncthreads();
  if (threadIdx.x == 0) {
    unsigned* bar = b.bar;
    __builtin_amdgcn_s_waitcnt(0);
    unsigned nloc = b.st[0], nx = b.st[1];
    if (nloc == 0u) { xcd_barrier_complete(bar, b.x, nloc, nx); b.st[0] = nloc; b.st[1] = nx; }
    const unsigned old = xb_add(&bar[XB_XSUB(b.x)], 1u);
    const unsigned gen = old / nloc;
    if (old + 1u == (gen + 1u) * nloc) {
      __builtin_amdgcn_fence(__ATOMIC_RELEASE, "agent");
      asm volatile("s_waitcnt vmcnt(0)" ::: "memory");
      const unsigned og = xb_add(&bar[XB_TOP], 1u);
      const unsigned tg = og / nx;
      if (og + 1u == (tg + 1u) * nx) xb_add(&bar[XB_TOPGEN], 1u);
      else XB_SPIN(xb_ld(&bar[XB_TOPGEN]) == tg, bar);
      __builtin_amdgcn_fence(__ATOMIC_ACQUIRE, "agent");
      xb_add(&bar[XB_XGEN(b.x)], 1u);
      asm volatile("s_waitcnt vmcnt(0)" ::: "memory");
    } else {
      XB_SPIN(xb_ld(&bar[XB_XGEN(b.x)]) == gen, bar);
      __builtin_amdgcn_fence(__ATOMIC_ACQUIRE, "agent");
      asm volatile("s_waitcnt vmcnt(0)" ::: "memory");
    }
  }
  __syncthreads();
}

template <int DEPTH = 2, bool STAGED = true, class KMAP, class LA, class LW, class EPI>
DI void gemm_tile(u16* smem, int m0, int n0, int nks, KMAP kmap, LA loadA, LW loadW, EPI epi) {
  const int tid = tid_l(), lane = tid & 63, wave = tid >> 6;
  const int wm = wave >> 1, wn = wave & 1, l15 = lane & 15, quad = lane >> 4;
  u16* sX = smem;
  u16* sW = smem + 2 * 128 * 64;
  f32x4 acc[4][4];
#pragma unroll
  for (int i = 0; i < 4; ++i)
#pragma unroll
    for (int j = 0; j < 4; ++j) acc[i][j] = f32x4{0.f, 0.f, 0.f, 0.f};
  uint4 ra0[4], rw0[4], ra1[4], rw1[4];
  const int lrow = tid >> 3, lkc = (tid & 7) * 8;
  const int wpos = (((tid & 7) ^ ((tid >> 4) & 7)) * 8);
  const int rsw = (l15 >> 1) & 7;
  const int rp0 = ((quad ^ rsw) * 8), rp1 = (((4 + quad) ^ rsw) * 8);
#define G_LOAD(RA, RW, KS) { const int k0_ = __builtin_amdgcn_readfirstlane(kmap(KS)); _Pragma("unroll") for (int i = 0; i < 4; ++i) { RA[i] = loadA(m0 + lrow + i * 32, k0_, lkc); RW[i] = loadW(n0 + lrow + i * 32, k0_, lkc); } }
#define G_STORE(RA, RW, BUF) { u16* dx_ = sX + (BUF) * 128 * 64; u16* dw_ = sW + (BUF) * 128 * 64; _Pragma("unroll") for (int i = 0; i < 4; ++i) { \
    *(uint4*)(dx_ + (lrow + i * 32) * 64 + wpos) = RA[i]; *(uint4*)(dw_ + (lrow + i * 32) * 64 + wpos) = RW[i]; } }
#define G_COMPUTE(BUF, FENCE) { const u16* bx = sX + (BUF) * 128 * 64 + (wm * 64 + l15) * 64; const u16* bw = sW + (BUF) * 128 * 64 + (wn * 64 + l15) * 64; \
    bf16x8 xf[2][4], wf[2][4]; \
    _Pragma("unroll") for (int i = 0; i < 4; ++i) { \
      xf[0][i] = *(const bf16x8*)(bx + i * 16 * 64 + rp0); wf[0][i] = *(const bf16x8*)(bw + i * 16 * 64 + rp0); } \
    _Pragma("unroll") for (int i = 0; i < 4; ++i) { \
      xf[1][i] = *(const bf16x8*)(bx + i * 16 * 64 + rp1); wf[1][i] = *(const bf16x8*)(bw + i * 16 * 64 + rp1); } \
    if (FENCE) __builtin_amdgcn_sched_barrier(0); \
    _Pragma("unroll") for (int kk = 0; kk < 2; ++kk) { \
      _Pragma("unroll") for (int ni = 0; ni < 4; ++ni) _Pragma("unroll") for (int mi = 0; mi < 4; ++mi) \
          acc[ni][mi] = __builtin_amdgcn_mfma_f32_16x16x32_bf16(wf[kk][ni], xf[kk][mi], acc[ni][mi], 0, 0, 0); \
      if (FENCE) __builtin_amdgcn_sched_barrier(0); } }
#define G_PATTERN { __builtin_amdgcn_sched_group_barrier(0x100, 16, 0); \
    _Pragma("unroll") for (int q_ = 0; q_ < 8; ++q_) { __builtin_amdgcn_sched_group_barrier(0x008, 2, 0); __builtin_amdgcn_sched_group_barrier(0x020, 1, 0); } \
    _Pragma("unroll") for (int q_ = 0; q_ < 8; ++q_) { __builtin_amdgcn_sched_group_barrier(0x008, 2, 0); __builtin_amdgcn_sched_group_barrier(0x200, 1, 0); } }
  if (DEPTH == 2) {
    G_LOAD(ra0, rw0, 0);
    G_LOAD(ra1, rw1, 1);
    G_STORE(ra0, rw0, 0);
    __syncthreads();
    for (int ks = 0; ks < nks; ks += 2) {
      G_LOAD(ra0, rw0, (ks + 2 < nks ? ks + 2 : nks - 1));
      G_COMPUTE(0, 0);
      G_STORE(ra1, rw1, 1);
      G_PATTERN;
      __syncthreads();
      G_LOAD(ra1, rw1, (ks + 3 < nks ? ks + 3 : nks - 1));
      G_COMPUTE(1, 0);
      G_STORE(ra0, rw0, 0);
      G_PATTERN;
      __syncthreads();
    }
  } else {
    G_LOAD(ra0, rw0, 0);
    G_STORE(ra0, rw0, 0);
    __syncthreads();
    for (int ks = 0; ks < nks; ++ks) {
      const int buf = ks & 1;
      if (ks + 1 < nks) G_LOAD(ra0, rw0, ks + 1);
      G_COMPUTE(buf, 1);
      if (ks + 1 < nks) G_STORE(ra0, rw0, buf ^ 1);
      __syncthreads();
    }
  }
#undef G_LOAD
#undef G_STORE
#undef G_COMPUTE
#undef G_PATTERN
  if constexpr (!STAGED) {
#pragma unroll
    for (int ni = 0; ni < 4; ++ni)
#pragma unroll
      for (int mi = 0; mi < 4; ++mi)
        epi(m0 + wm * 64 + mi * 16 + l15, n0 + wn * 64 + ni * 16 + quad * 4, acc[ni][mi]);
  } else {
    float* wbuf = (float*)smem + wave * (16 * 68);
    const int rrow = lane >> 4, rcol = (lane & 15) * 4;
#pragma unroll
    for (int mi = 0; mi < 4; ++mi) {
#pragma unroll
      for (int ni = 0; ni < 4; ++ni) *(f32x4*)(wbuf + l15 * 68 + ni * 16 + quad * 4) = acc[ni][mi];
      __builtin_amdgcn_wave_barrier();
#pragma unroll
      for (int j = 0; j < 4; ++j) {
        const f32x4 a = *(const f32x4*)(wbuf + (j * 4 + rrow) * 68 + rcol);
        epi(m0 + wm * 64 + mi * 16 + j * 4 + rrow, n0 + wn * 64 + rcol, a);
      }
    }
    __syncthreads();
  }
}

template <bool HASPRE = false, class LA, class LW, class EPI, class PRE = int>
DI void gemm_tile_w(u16* smem, int m0, int n0, int nks, LA loadA, LW loadW, EPI epi, PRE pre = 0) {
  const int tid = tid_l(), lane = tid & 63, wave = tid >> 6;
  const int wm = wave >> 1, wn = wave & 1, l15 = lane & 15, quad = lane >> 4;
  u16* sX = smem;
  u16* sW = smem + 2 * 128 * 32;
  f32x4 acc[8][4];
#pragma unroll
  for (int i = 0; i < 8; ++i)
#pragma unroll
    for (int j = 0; j < 4; ++j) acc[i][j] = f32x4{0.f, 0.f, 0.f, 0.f};
  uint4 ra0[2], rw0[4], ra1[2], rw1[4];
  const int lrow = tid >> 2, lkc = (tid & 3) * 8;
  const int wpos = ((tid & 3) ^ ((0 - (tid >> 4)) & 3)) * 8;
  const int rpos = (quad ^ ((0 - (l15 >> 2)) & 3)) * 8;
#define W_LOAD(RA, RW, KS) { const int k0_ = __builtin_amdgcn_readfirstlane((KS) * 32); \
    _Pragma("unroll") for (int i = 0; i < 2; ++i) RA[i] = loadA(m0 + lrow + i * 64, k0_, lkc); \
    _Pragma("unroll") for (int i = 0; i < 4; ++i) RW[i] = loadW(n0 + lrow + i * 64, k0_, lkc); }
#define W_STORE(RA, RW, BUF) { u16* dx_ = sX + (BUF) * 128 * 32; u16* dw_ = sW + (BUF) * 256 * 32; \
    _Pragma("unroll") for (int i = 0; i < 2; ++i) *(uint4*)(dx_ + (lrow + i * 64) * 32 + wpos) = RA[i]; \
    _Pragma("unroll") for (int i = 0; i < 4; ++i) *(uint4*)(dw_ + (lrow + i * 64) * 32 + wpos) = RW[i]; }
#define W_COMPUTE(BUF) { const u16* bx = sX + (BUF) * 128 * 32 + (wm * 64 + l15) * 32 + rpos; const u16* bw = sW + (BUF) * 256 * 32 + (wn * 128 + l15) * 32 + rpos; \
    bf16x8 xf[4], wf[8]; \
    _Pragma("unroll") for (int i = 0; i < 4; ++i) xf[i] = *(const bf16x8*)(bx + i * 16 * 32); \
    _Pragma("unroll") for (int i = 0; i < 8; ++i) wf[i] = *(const bf16x8*)(bw + i * 16 * 32); \
    _Pragma("unroll") for (int ni = 0; ni < 8; ++ni) _Pragma("unroll") for (int mi = 0; mi < 4; ++mi) \
        acc[ni][mi] = __builtin_amdgcn_mfma_f32_16x16x32_bf16(wf[ni], xf[mi], acc[ni][mi], 0, 0, 0); }
#define W_PATTERN { __builtin_amdgcn_sched_group_barrier(0x100, 12, 0); \
    _Pragma("unroll") for (int q_ = 0; q_ < 6; ++q_) { __builtin_amdgcn_sched_group_barrier(0x008, 2, 0); __builtin_amdgcn_sched_group_barrier(0x020, 1, 0); } \
    _Pragma("unroll") for (int q_ = 0; q_ < 6; ++q_) { __builtin_amdgcn_sched_group_barrier(0x008, 3, 0); __builtin_amdgcn_sched_group_barrier(0x200, 1, 0); } \
    __builtin_amdgcn_sched_group_barrier(0x008, 2, 0); }
  W_LOAD(ra0, rw0, 0);
  W_LOAD(ra1, rw1, 1);
  W_STORE(ra0, rw0, 0);
  __syncthreads();
  for (int ks = 0; ks < nks; ks += 2) {
    W_LOAD(ra0, rw0, (ks + 2 < nks ? ks + 2 : nks - 1));
    W_COMPUTE(0);
    W_STORE(ra1, rw1, 1);
    W_PATTERN;
    __syncthreads();
    W_LOAD(ra1, rw1, (ks + 3 < nks ? ks + 3 : nks - 1));
    W_COMPUTE(1);
    W_STORE(ra0, rw0, 0);
    W_PATTERN;
    __syncthreads();
  }
#undef W_LOAD
#undef W_STORE
#undef W_COMPUTE
#undef W_PATTERN
  if constexpr (HASPRE) {
    float* wbuf = (float*)smem + wave * (16 * 132);
    const int rrow = lane >> 5, rcol = (lane & 31) * 4;
#pragma unroll
    for (int mi = 0; mi < 4; ++mi) {
#pragma unroll
      for (int ni = 0; ni < 8; ++ni) *(f32x4*)(wbuf + l15 * 132 + ni * 16 + quad * 4) = acc[ni][mi];
      __builtin_amdgcn_wave_barrier();
      f32x4 pv[8];
#pragma unroll
      for (int j = 0; j < 8; ++j) pv[j] = pre(m0 + wm * 64 + mi * 16 + j * 2 + rrow, n0 + wn * 128 + rcol);
#pragma unroll
      for (int j = 0; j < 8; ++j) {
        const f32x4 a = *(const f32x4*)(wbuf + (j * 2 + rrow) * 132 + rcol);
        epi(m0 + wm * 64 + mi * 16 + j * 2 + rrow, n0 + wn * 128 + rcol, a, pv[j]);
      }
    }
    __syncthreads();
  } else {
    float* wbuf = (float*)smem + wave * (16 * 132);
    const int rrow = lane >> 5, rcol = (lane & 31) * 4;
#pragma unroll
    for (int mi = 0; mi < 4; ++mi) {
#pragma unroll
      for (int ni = 0; ni < 8; ++ni) *(f32x4*)(wbuf + l15 * 132 + ni * 16 + quad * 4) = acc[ni][mi];
      __builtin_amdgcn_wave_barrier();
#pragma unroll
      for (int j = 0; j < 8; ++j) {
        const f32x4 a = *(const f32x4*)(wbuf + (j * 2 + rrow) * 132 + rcol);
        epi(m0 + wm * 64 + mi * 16 + j * 2 + rrow, n0 + wn * 128 + rcol, a);
      }
    }
    __syncthreads();
  }
}

DI void tconv(float* tl, const float* src, u16* dst, int K, int N, int Npad, int b0, int nb) {
  const int tid = tid_l();
  const int nkt = K >> 6, nnt = Npad >> 6, ntl = nkt * nnt;
  const int r = tid >> 4, c4 = (tid & 15) * 4;
  float4 v[4];
  int tile = (int)blockIdx.x - b0;
  auto ld = [&](int t) {
    const int kt = t % nkt, nt = t / nkt;
    const int k0 = kt * 64, n0 = nt * 64;
#pragma unroll
    for (int i = 0; i < 4; ++i) {
      v[i] = make_float4(0.f, 0.f, 0.f, 0.f);
      if (n0 + c4 < N) v[i] = *(const float4*)(src + (size_t)(k0 + r + i * 16) * N + n0 + c4);
    }
  };
  if (tile < ntl) ld(tile);
  for (; tile < ntl; tile += nb) {
    const int kt = tile % nkt, nt = tile / nkt;
    const int k0 = kt * 64, n0 = nt * 64;
#pragma unroll
    for (int i = 0; i < 4; ++i) {
      const int k = r + i * 16;
      tl[k * 65 + c4 + 0] = v[i].x; tl[k * 65 + c4 + 1] = v[i].y; tl[k * 65 + c4 + 2] = v[i].z; tl[k * 65 + c4 + 3] = v[i].w;
    }
    if (tile + nb < ntl) ld(tile + nb);
    __syncthreads();
#pragma unroll
    for (int i = 0; i < 2; ++i) {
      const int c = tid + i * 256;
      const int n = c >> 3, k8 = (c & 7) * 8;
      uint4 o;
      o.x = pack2(tl[(k8 + 0) * 65 + n], tl[(k8 + 1) * 65 + n]);
      o.y = pack2(tl[(k8 + 2) * 65 + n], tl[(k8 + 3) * 65 + n]);
      o.z = pack2(tl[(k8 + 4) * 65 + n], tl[(k8 + 5) * 65 + n]);
      o.w = pack2(tl[(k8 + 6) * 65 + n], tl[(k8 + 7) * 65 + n]);
      *(uint4*)(dst + (size_t)(n0 + n) * K + k0 + k8) = o;
    }
    __syncthreads();
  }
}

template <int MODE, class TILE, class BIAS, class EM, class MASK>
DI void attn_loop(u16* sK, u16* sV, uint32_t* imp, int ntiles, TILE tilefn, BIAS biasfn, EM emfn, MASK valid, const bf16x8 (&qf)[2][4],
                  f32x4 (&o)[2][8], float (&mrow)[2], float (&lrow)[2], const float (&linv)[2]) {
  const int tid = tid_l(), lane = tid & 63;
  const int l15 = lane & 15, quad = lane >> 4;
  const int lr = tid >> 4, lc = (tid & 15) * 8;
  uint4 rk[4];
#define K_LOAD(IT) { const u16 *kb_, *vb_; size_t rs_; int kp_; tilefn(IT, kb_, vb_, rs_, kp_); _Pragma("unroll") for (int i = 0; i < 4; ++i) rk[i] = ldg_o(kb_, (uint32_t)((lr + i * 16) * (int)rs_ + lc) * 2u); }
#define V_LOAD_G(IT) { const u16 *kb_, *vb_; size_t rs_; int kp_; tilefn(IT, kb_, vb_, rs_, kp_); _Pragma("unroll") for (int i = 0; i < 4; ++i) rk[i] = ldg_o(vb_, (uint32_t)((lr + i * 16) * (int)rs_ + lc) * 2u); }
#define K_STORE(BUF) { _Pragma("unroll") for (int i = 0; i < 4; ++i) *(uint4*)(sK + (BUF) * 64 * 136 + (lr + i * 16) * 136 + lc) = rk[i]; }
#define V_STORE(BUF) { _Pragma("unroll") for (int i = 0; i < 4; ++i) *(uint4*)(sV + (BUF) * 64 * 144 + (lr + i * 16) * 144 + lc) = rk[i]; }
  auto compute = [&](const int buf, const int it, auto midfn) {
    int kpos0;
    { const u16 *kb, *vb; size_t rs; tilefn(it, kb, vb, rs, kpos0); }
    f32x4 s[4][2];
#pragma unroll
    for (int kc = 0; kc < 4; ++kc) { s[kc][0] = f32x4{0.f, 0.f, 0.f, 0.f}; s[kc][1] = f32x4{0.f, 0.f, 0.f, 0.f}; }
    const u16* kbase = sK + buf * 64 * 136 + l15 * 136 + quad * 8;
    {
      bf16x8 kf[2][2];
      kf[0][0] = *(const bf16x8*)(kbase);
      kf[0][1] = *(const bf16x8*)(kbase + 32);
#pragma unroll
      for (int h = 0; h < 8; ++h) {
        const int kc = h >> 1, dh = h & 1;
        if (h < 7) {
          const int kc2 = (h + 1) >> 1, dh2 = (h + 1) & 1;
          kf[(h + 1) & 1][0] = *(const bf16x8*)(kbase + kc2 * 16 * 136 + (dh2 * 2) * 32);
          kf[(h + 1) & 1][1] = *(const bf16x8*)(kbase + kc2 * 16 * 136 + (dh2 * 2 + 1) * 32);
        }
#pragma unroll
        for (int e = 0; e < 2; ++e) {
          const int ds = dh * 2 + e;
          s[kc][0] = __builtin_amdgcn_mfma_f32_16x16x32_bf16(kf[h & 1][e], qf[0][ds], s[kc][0], 0, 0, 0);
          s[kc][1] = __builtin_amdgcn_mfma_f32_16x16x32_bf16(kf[h & 1][e], qf[1][ds], s[kc][1], 0, 0, 0);
        }
        __builtin_amdgcn_sched_barrier(0);
      }
    }
    midfn();
    float mx[2] = {-1e30f, -1e30f};
    if (MODE == 0) {
      const float bias0 = biasfn(it, 0), bias1 = biasfn(it, 1);
      const bool em = ATT_SAFE || emfn(it);
      if (em) {
#pragma unroll
        for (int kc = 0; kc < 4; ++kc)
#pragma unroll
          for (int qs = 0; qs < 2; ++qs)
#pragma unroll
            for (int r = 0; r < 4; ++r) {
              const int kpos = kpos0 + kc * 16 + quad * 4 + r;
              const float x = valid(kpos, qs) ? fmaf(s[kc][qs][r], SCALE2, qs ? bias1 : bias0) : -1e30f;
              s[kc][qs][r] = x;
              mx[qs] = fmaxf(mx[qs], x);
            }
      } else {
        float r0 = -3e38f, r1 = -3e38f;
#pragma unroll
        for (int kc = 0; kc < 4; ++kc)
#pragma unroll
          for (int r = 0; r < 4; ++r) { r0 = fmaxf(r0, s[kc][0][r]); r1 = fmaxf(r1, s[kc][1][r]); }
        mx[0] = fmaf(r0, SCALE2, bias0);
        mx[1] = fmaf(r1, SCALE2, bias1);
      }
      float al[2];
#pragma unroll
      for (int qs = 0; qs < 2; ++qs) {
        float m = mx[qs];
        m = fmaxf(m, __shfl_xor(m, 16));
        m = fmaxf(m, __shfl_xor(m, 32));
        const float mnew = fmaxf(mrow[qs], m);
        al[qs] = __builtin_amdgcn_exp2f(mrow[qs] - mnew);
        mrow[qs] = mnew;
      }
      if (__builtin_amdgcn_ballot_w64(al[0] < 1.f || al[1] < 1.f) != 0ull) {
#pragma unroll
        for (int qs = 0; qs < 2; ++qs) {
          lrow[qs] *= al[qs];
#pragma unroll
          for (int dt = 0; dt < 8; ++dt) o[qs][dt] *= al[qs];
        }
      }
      if (em) {
#pragma unroll
        for (int kc = 0; kc < 4; ++kc)
#pragma unroll
          for (int qs = 0; qs < 2; ++qs)
#pragma unroll
            for (int r = 0; r < 4; ++r) {
              float pv = __builtin_amdgcn_exp2f(s[kc][qs][r] - mrow[qs]);
              if (ATT_SAFE) pv = (s[kc][qs][r] > -1e29f) ? pv : 0.f;
              lrow[qs] += pv;
              s[kc][qs][r] = pv;
            }
      } else {
        const float c0 = bias0 - mrow[0], c1 = bias1 - mrow[1];
#pragma unroll
        for (int kc = 0; kc < 4; ++kc)
#pragma unroll
          for (int qs = 0; qs < 2; ++qs)
#pragma unroll
            for (int r = 0; r < 4; ++r) {
              const float pv = __builtin_amdgcn_exp2f(fmaf(s[kc][qs][r], SCALE2, qs ? c1 : c0));
              lrow[qs] += pv;
              s[kc][qs][r] = pv;
            }
      }
    } else {
#pragma unroll
      for (int kc = 0; kc < 4; ++kc)
#pragma unroll
        for (int qs = 0; qs < 2; ++qs)
#pragma unroll
          for (int r = 0; r < 4; ++r) {
            const int kpos = kpos0 + kc * 16 + quad * 4 + r;
            const float x = valid(kpos, qs) ? s[kc][qs][r] * SCALE2 : -1e30f;
            s[kc][qs][r] = x;
            mx[qs] = fmaxf(mx[qs], x);
          }
      if (MODE == 1) {
#pragma unroll
        for (int qs = 0; qs < 2; ++qs) {
          float m = mx[qs];
          m = fmaxf(m, __shfl_xor(m, 16));
          m = fmaxf(m, __shfl_xor(m, 32));
          const float mnew = fmaxf(mrow[qs], m);
          const float alpha = __builtin_amdgcn_exp2f(mrow[qs] - mnew);
          mrow[qs] = mnew;
          lrow[qs] *= alpha;
        }
      }
#pragma unroll
      for (int kc = 0; kc < 4; ++kc)
#pragma unroll
        for (int qs = 0; qs < 2; ++qs)
#pragma unroll
          for (int r = 0; r < 4; ++r) {
            const float x = s[kc][qs][r];
            float pv = (x > -1e29f) ? __builtin_amdgcn_exp2f(x - mrow[qs]) : 0.f;
            if (MODE == 2) pv *= linv[qs];
            else lrow[qs] += pv;
            s[kc][qs][r] = pv;
          }
    }
    if (MODE == 2) {
#pragma unroll
      for (int kc = 0; kc < 4; ++kc)
#pragma unroll
        for (int qs = 0; qs < 2; ++qs) {
          const int jb = (kpos0 >> 2) + kc * 4 + quad;
          const float a = s[kc][qs][0] + s[kc][qs][1] + s[kc][qs][2] + s[kc][qs][3];
          const float b3 = s[kc][qs][3];
          if (jb < 64) atomicAdd(&imp[(qs * 16 + l15) * 65 + jb], (uint32_t)(a * 67108864.f + 0.5f));
          if (jb + 1 < 64) atomicAdd(&imp[(qs * 16 + l15) * 65 + jb + 1], (uint32_t)(b3 * 67108864.f + 0.5f));
        }
    }
    if (MODE != 1) {
      bf16x8 pb[2][2];
#pragma unroll
      for (int j = 0; j < 2; ++j)
#pragma unroll
        for (int qs = 0; qs < 2; ++qs) {
          union { bf16x8 v; uint32_t u[4]; } cv;
          cv.u[0] = pack2(s[2 * j][qs][0], s[2 * j][qs][1]);
          cv.u[1] = pack2(s[2 * j][qs][2], s[2 * j][qs][3]);
          cv.u[2] = pack2(s[2 * j + 1][qs][0], s[2 * j + 1][qs][1]);
          cv.u[3] = pack2(s[2 * j + 1][qs][2], s[2 * j + 1][qs][3]);
          pb[j][qs] = cv.v;
        }
      const u16* vbase = sV + buf * 64 * 144 + (4 * quad + (l15 >> 2)) * 144 + (l15 & 3) * 4;
      bf16x8 vf[2][4];
#define V_LOAD(DST, G) { _Pragma("unroll") for (int d = 0; d < 4; ++d) { const u16* a0 = vbase + (32 * ((G) >> 1)) * 144 + (((G) & 1) * 4 + d) * 16; \
        s16x4 lo = __builtin_amdgcn_ds_read_tr16_b64_v4i16((__attribute__((address_space(3))) s16x4*)(a0)); \
        s16x4 hi = __builtin_amdgcn_ds_read_tr16_b64_v4i16((__attribute__((address_space(3))) s16x4*)(a0 + 16 * 144)); \
        bf16x8 t; t[0] = lo[0]; t[1] = lo[1]; t[2] = lo[2]; t[3] = lo[3]; t[4] = hi[0]; t[5] = hi[1]; t[6] = hi[2]; t[7] = hi[3]; DST[d] = t; } }
      V_LOAD(vf[0], 0);
#pragma unroll
      for (int g = 0; g < 4; ++g) {
        if (g < 3) V_LOAD(vf[(g + 1) & 1], g + 1);
#pragma unroll
        for (int d = 0; d < 4; ++d) {
          const int dt = (g & 1) * 4 + d;
          o[0][dt] = __builtin_amdgcn_mfma_f32_16x16x32_bf16(vf[g & 1][d], pb[g >> 1][0], o[0][dt], 0, 0, 0);
          o[1][dt] = __builtin_amdgcn_mfma_f32_16x16x32_bf16(vf[g & 1][d], pb[g >> 1][1], o[1][dt], 0, 0, 0);
        }
        __builtin_amdgcn_sched_barrier(0);
      }
#undef V_LOAD
    }
  };
  {
    uint4 rv0[4];
    const u16 *kb_, *vb_; size_t rs_; int kp_;
    tilefn(0, kb_, vb_, rs_, kp_);
#pragma unroll
    for (int i = 0; i < 4; ++i) {
      rk[i] = ldg_o(kb_, (uint32_t)((lr + i * 16) * (int)rs_ + lc) * 2u);
      if (MODE != 1) rv0[i] = ldg_o(vb_, (uint32_t)((lr + i * 16) * (int)rs_ + lc) * 2u);
    }
    K_STORE(0);
    if (MODE != 1) {
#pragma unroll
      for (int i = 0; i < 4; ++i) *(uint4*)(sV + (lr + i * 16) * 144 + lc) = rv0[i];
    }
  }
  __syncthreads();
  for (int it = 0; it < ntiles; ++it) {
    const int buf = it & 1;
    const bool more = (it + 1 < ntiles);
    if (more) K_LOAD(it + 1);
    compute(buf, it, [&]() { if (more) { K_STORE(buf ^ 1); if (MODE != 1) V_LOAD_G(it + 1); } });
    if (more && MODE != 1) V_STORE(buf ^ 1);
    __syncthreads();
  }
#undef K_LOAD
#undef V_LOAD_G
#undef K_STORE
#undef V_STORE
}

__global__ void __launch_bounds__(256, 2) yoco_fwd(Params p) {
  cg::grid_group grid = cg::this_grid();
  __shared__ __attribute__((aligned(16))) u16 smem[40192];
  __shared__ uint4 xb_words;
  if (threadIdx.x == 0) xb_words = make_uint4(0u, 0u, 0u, 0u);
  __syncthreads();
  XcdBarrier xb = xcd_barrier_post((unsigned*)(p.ws + O_BAR), (volatile LAS unsigned*)&xb_words);
  char* ws = p.ws;
  u16* W_AIN = (u16*)(ws + O_WAIN);
  u16* W_GLU = (u16*)(ws + O_WGLU);
  u16* W_AOUT = (u16*)(ws + O_WAOUT);
  u16* W_KV = (u16*)(ws + O_WKV);
  u16* W_C1 = (u16*)(ws + O_WC1);
  u16* W_C2 = (u16*)(ws + O_WC2);
  u16* W_BIN = (u16*)(ws + O_WBIN);
  u16* W_BOUT = (u16*)(ws + O_WBOUT);
  u16* XB = (u16*)(ws + O_XB);
  float* XF = (float*)(ws + O_XF);
  u16* KV = (u16*)(ws + O_KV);
  float* T1P = (float*)(ws + O_T1);
  u16* KCVC = (u16*)(ws + O_KCVC);
  float* C1B = (float*)(ws + O_C1B);
  u16* YB = (u16*)(ws + O_YB);
  float2* STATS = (float2*)(ws + O_STATS);
  u16* UZ = (u16*)(ws + O_UZ);
  u16* GB = (u16*)(ws + O_G);
  u16* VB = (u16*)(ws + O_V);
  float* SB = (float*)(ws + O_S);
  u16* HIN = (u16*)(ws + O_HIN);
  u16* W1 = (u16*)(ws + O_W1);
  u16* W3T = (u16*)(ws + O_W3T);
  u16* KTAB = (u16*)(ws + O_KTAB);
  float2* A64 = (float2*)(ws + O_A64);
  u16* PROJ = (u16*)(ws + O_PROJ);

  float* tl = (float*)smem;
  auto do_jobs = [&](unsigned mask, int b0, int nb) {
      for (int job = 0; job < 15; ++job) {
        if (!((mask >> job) & 1u)) continue;

        const float* src; u16* dst; int K, N, Np;
        switch (job) {
          case 0: src = p.in[1]; dst = W_AIN; K = 2048; N = 2048; Np = 2048; break;
          case 1: src = p.in[1] + (size_t)2048 * 2048; dst = W_AIN + (size_t)2048 * 2048; K = 2048; N = 2048; Np = 2048; break;
          case 2: src = p.in[10]; dst = W_GLU; K = 1024; N = 1024; Np = 1024; break;
          case 3: src = p.in[10] + (size_t)1024 * 1024; dst = W_GLU + (size_t)1024 * 1024; K = 1024; N = 1024; Np = 1024; break;
          case 4: src = p.in[12]; dst = W_AOUT; K = 1024; N = 2048; Np = 2048; break;
          case 5: src = p.in[12] + (size_t)1024 * 2048; dst = W_AOUT + (size_t)2048 * 1024; K = 1024; N = 2048; Np = 2048; break;
          case 6: src = p.in[13]; dst = W_KV; K = 2048; N = 3072; Np = 3072; break;
          case 7: src = p.in[15]; dst = W_C1; K = 4096; N = 128; Np = 128; break;
          case 8: src = p.in[18]; dst = W_C1 + (size_t)128 * 4096; K = 4096; N = 128; Np = 128; break;
          case 9: src = p.in[16]; dst = W_C2; K = 128; N = 128; Np = 128; break;
          case 10: src = p.in[19]; dst = W_C2 + (size_t)128 * 128; K = 128; N = 128; Np = 128; break;
          case 11: src = p.in[20]; dst = W_BIN; K = 2048; N = BIN_N; Np = PROJ_LD; break;
          case 12: src = p.in[20] + (size_t)2048 * BIN_N; dst = W_BIN + (size_t)PROJ_LD * 2048; K = 2048; N = BIN_N; Np = PROJ_LD; break;
          case 13: src = p.in[21]; dst = W_BOUT; K = 2048; N = 2048; Np = 2048; break;
          default: src = p.in[21] + (size_t)2048 * 2048; dst = W_BOUT + (size_t)2048 * 2048; K = 2048; N = 2048; Np = 2048; break;
        }
        if ((int)blockIdx.x >= b0) tconv(tl, src, dst, K, N, Np, b0, nb);
      }
  };
  for (int rep0 = 0; rep0 < REPS_P0; ++rep0) {
    const int tid = tid_l(), lane = tid & 63, wave = tid >> 6; (void)lane; (void)wave;
    do_jobs((1u << 0) | (1u << 2) | (1u << 4) | (1u << 7) | (1u << 8) | (1u << 9) | (1u << 10), 0, (int)gridDim.x);
    {
      const float4* x4 = (const float4*)p.in[0];
      uint2* xb2 = (uint2*)XB;
      const size_t n4 = (size_t)NTOK * DM / 4;
      for (size_t i = (size_t)blockIdx.x * 256 + tid; i < n4; i += (size_t)gridDim.x * 256) {
        float4 v = x4[i];
        uint2 o; o.x = pack2(v.x, v.y); o.y = pack2(v.z, v.w);
        xb2[i] = o;
      }
    }
    {
      float* C1P = (float*)(ws + O_C1P);
      float* red = (float*)smem;
      for (int item = blockIdx.x; item < 64; item += gridDim.x) {
        const int kvs = item >> 5, part = item & 31;
        const float* pos = p.in[kvs ? 17 : 14];
        const float* w1 = p.in[kvs ? 18 : 15];
        const int j = tid & 127, half = tid >> 7;
        const int i0 = part * 128 + half * 64;
        float acc = 0.f;
#pragma unroll 16
        for (int i = 0; i < 64; ++i) acc += pos[i0 + i] * w1[(size_t)(i0 + i) * 128 + j];
        __syncthreads();
        red[tid] = acc;
        __syncthreads();
        if (tid < 128) C1P[(size_t)item * 128 + tid] = red[tid] + red[tid + 128];
        __syncthreads();
      }
    }
    {
      float2* sE = (float2*)smem;
      float2* sCo = sE + 64;
      float2* sM = sCo + 64;
      float2* sC = sM + 1024;
      for (int item = blockIdx.x; item < 2 * 64 * 65; item += gridDim.x) {
        const int j = item % 65, lg = item / 65;
        const float* lam_re = p.in[2] + (size_t)lg * 64;
        const float* lam_im = p.in[3] + (size_t)lg * 64;
        const float dt = __expf(p.in[4][lg]);
        const float* b_re = p.in[5] + (size_t)lg * 1024;
        const float* b_im = p.in[6] + (size_t)lg * 1024;
        const float* c_re = p.in[7] + (size_t)lg * 1024;
        const float* c_im = p.in[8] + (size_t)lg * 1024;
#pragma unroll
        for (int i = 0; i < 4; ++i) sC[tid + i * 256] = make_float2(c_re[tid + i * 256], c_im[tid + i * 256]);
        if (tid < 64) {
          const float lr = lam_re[tid], li = lam_im[tid];
          const float mag = expf(lr * dt);
          float sn, cs;
          sincosf(li * dt, &sn, &cs);
          const float ar = mag * cs, ai = mag * sn;
          const float inv = 1.f / (lr * lr + li * li);
          const float cr = ((ar - 1.f) * lr + ai * li) * inv;
          const float ci = (ai * lr - (ar - 1.f) * li) * inv;
          sCo[tid] = make_float2(cr, ci);
          const float fj = (float)j;
          const float mj = expf(lr * dt * fj);
          float sj, cj;
          if (j == 64) sincosf(li * dt * fj, &sj, &cj);
          else __sincosf(li * dt * fj, &sj, &cj);
          sE[tid] = make_float2(mj * cj, mj * sj);
          if (j == 64) A64[(size_t)lg * 64 + tid] = make_float2(mj * cj, mj * sj);
        }
        __syncthreads();
#pragma unroll
        for (int i = 0; i < 4; ++i) {
          const int idx = tid + i * 256;
          const int pp = idx >> 4, ci = idx & 15;
          const float br = b_re[idx], bi = b_im[idx];
          const float2 co = sCo[pp];
          const float bbr = co.x * br - co.y * bi, bbi = co.x * bi + co.y * br;
          const float2 e = sE[pp];
          const float mr = e.x * bbr - e.y * bbi, mi = e.x * bbi + e.y * bbr;
          sM[idx] = make_float2(mr, mi);
          if (j < 64) {
            const int s = 63 - j;
            u16* w1p = W1 + (size_t)lg * 128 * 1024;
            w1p[(size_t)pp * 1024 + s * 16 + ci] = f2bf(mr);
            w1p[(size_t)(64 + pp) * 1024 + s * 16 + ci] = f2bf(mi);
          }
        }
        __syncthreads();
        if (j < 64) {
          const int co = tid >> 4, ci = tid & 15;
          float acc = 0.f;
          for (int pp = 0; pp < 64; ++pp) {
            const float2 m = sM[pp * 16 + ci];
            const float2 c = sC[co * 64 + pp];
            acc += c.x * m.x - c.y * m.y;
          }
          KTAB[(((size_t)lg * 64 + j) * 16 + co) * 16 + ci] = f2bf(acc);
        }
        if (j >= 1) {
          const int t = j - 1;
          u16* w3p = W3T + (size_t)lg * 1024 * 128;
#pragma unroll
          for (int i = 0; i < 4; ++i) {
            const int idx = tid + i * 256;
            const int co = idx >> 6, pp = idx & 63;
            const float cr = sC[idx].x, ci = sC[idx].y;
            const float2 e = sE[pp];
            const float re = cr * e.x - ci * e.y, im = cr * e.y + ci * e.x;
            w3p[(size_t)(t * 16 + co) * 128 + pp] = f2bf(re);
            w3p[(size_t)(t * 16 + co) * 128 + 64 + pp] = f2bf(-im);
          }
        }
        __syncthreads();
      }
    }
  }
  grid.sync();

  auto kmap64 = [](int ks) { return ks * 64; };

  for (int l = 0; l < 2; ++l) {
    const float* xres = (l == 0) ? p.in[0] : XF;
    {
      const int tid = tid_l(), lane = tid & 63, wave = tid >> 6; (void)lane; (void)wave;
      if (l == 0 && blockIdx.x == 0) {
        const float* C1P = (const float*)(ws + O_C1P);
        float a = 0.f;
        for (int part = 0; part < 32; ++part) a += C1P[((size_t)(tid >> 7) * 32 + part) * 128 + (tid & 127)];
        C1B[tid] = a;
      }
      const u16* Wt = W_AIN + (size_t)l * 2048 * 2048;
      for (int tile = blockIdx.x; tile < 64 * 8; tile += gridDim.x) {
        const int mt = tile & 63, nt = tile >> 6;
        gemm_tile_w(smem, mt * 128, nt * 256, 64,
                  [=](int m, int k0, int kc) { return ldg_o(XB + k0, (uint32_t)(m * 2048 + kc) * 2u); },
                  [=](int n, int k0, int kc) { return ldg_o(Wt + k0, (uint32_t)(n * 2048 + kc) * 2u); },
                  [=](int m, int n, f32x4 v) { st_bf4(UZ + (size_t)m * 2048 + n, v); });
      }
    }
    xcd_barrier(xb);
    {
      float* sS = (float*)smem;
      if (l == 0) do_jobs((1u << 1) | (1u << 3) | (1u << 5) | (1u << 6) | (1u << 11), 64, (int)gridDim.x - 64);
      else do_jobs((1u << 12) | (1u << 13) | (1u << 14), 64, (int)gridDim.x - 64);
      for (int g = blockIdx.x; g < 64; g += gridDim.x) {
        const u16* w1p = W1 + ((size_t)l * 64 + g) * 128 * 1024;
        gemm_tile<1, false>(smem, 0, 0, 16, kmap64,
                  [=](int m, int k0, int kc) { return ldg_o(UZ + (size_t)(k0 >> 4) * 2048 + g * 16, (uint32_t)((m * 64 + (kc >> 4)) * 2048 + (kc & 15)) * 2u); },
                  [=](int n, int k0, int kc) { return ldg_o(w1p + k0, (uint32_t)(n * 1024 + kc) * 2u); },
                  [=](int m, int n, f32x4 v) { *(f32x4*)(sS + m * 132 + n) = v; });
        __syncthreads();
        const int tid = tid_l();
        if (tid < 128) {
          const int b = tid >> 6, pp = tid & 63;
          const float2 a = A64[((size_t)l * 64 + g) * 64 + pp];
          float hr = 0.f, hi = 0.f;
          const float* sp = sS + (b * 64) * 132;
          u16* hp = HIN + ((size_t)g * 128 + b * 64) * 128;
#pragma unroll 4
          for (int c = 0; c < 64; ++c) {
            hp[c * 128 + pp] = f2bf(hr);
            hp[c * 128 + 64 + pp] = f2bf(hi);
            const float sr = sp[c * 132 + pp], si = sp[c * 132 + 64 + pp];
            const float nr = a.x * hr - a.y * hi + sr;
            const float ni = a.x * hi + a.y * hr + si;
            hr = nr; hi = ni;
          }
        }
        __syncthreads();
      }
    }
    xcd_barrier(xb);
    {
      const float* dsk = p.in[9] + (size_t)l * 1024;
      for (int tile = blockIdx.x; tile < 64 * 8; tile += gridDim.x) {
        const int g = tile >> 3, nt = (tile < 256) ? 7 - (tile & 7) : (tile & 7);
        const int nks1 = 2 * nt + 2;
        const u16* ktab = KTAB + ((size_t)l * 64 + g) * 64 * 256;
        const u16* w3p = W3T + ((size_t)l * 64 + g) * 1024 * 128;
        const u16* hp = HIN + (size_t)g * 128 * 128;
        gemm_tile(smem, 0, nt * 128, nks1 + 2,
                  [=](int ks) { return ks < nks1 ? ks * 64 : 1024 + (ks - nks1) * 64; },
                  [=](int m, int k0, int kc) {
                    if (k0 < 1024) return ldg_o(UZ + (size_t)(k0 >> 4) * 2048 + g * 16, (uint32_t)((m * 64 + (kc >> 4)) * 2048 + (kc & 15)) * 2u);
                    return ldg_o(hp + (k0 - 1024), (uint32_t)(m * 128 + kc) * 2u);
                  },
                  [=](int n, int k0, int kc) {
                    if (k0 < 1024) {
                      const int lag = (n >> 4) - (kc >> 4) - (k0 >> 4);
                      if (lag < 0) return make_uint4(0u, 0u, 0u, 0u);
                      return ldg_o(ktab, (uint32_t)((lag * 16 + (n & 15)) * 16 + (kc & 15)) * 2u);
                    }
                    return ldg_o(w3p + (k0 - 1024), (uint32_t)(n * 128 + kc) * 2u);
                  },
                  [=](int m, int n, f32x4 v) {
                    const int t = n >> 4, co = n & 15;
                    const size_t tok = (size_t)m * 64 + t;
                    const int ch = g * 16 + co;
                    const f32x4 u = ld_bf4(UZ + tok * 2048 + ch);
                    const f32x4 d = *(const f32x4*)(dsk + ch);
                    f32x4 r;
#pragma unroll
                    for (int i = 0; i < 4; ++i) r[i] = gelu_tanh(v[i] + d[i] * u[i]);
                    st_bf4(GB + tok * 1024 + ch, r);
                  });
      }
    }
    xcd_barrier(xb);
    {
      const u16* Wt = W_GLU + (size_t)l * 1024 * 1024;
      const float* bg = p.in[11] + (size_t)l * 1024;
      for (int tile = blockIdx.x; tile < 64 * 8; tile += gridDim.x) {
        const int mt = tile & 63, nt = tile >> 6;
        gemm_tile(smem, mt * 128, nt * 128, 16, kmap64,
                  [=](int m, int k0, int kc) { return ldg_o(GB + k0, (uint32_t)(m * 1024 + kc) * 2u); },
                  [=](int n, int k0, int kc) { return ldg_o(Wt + k0, (uint32_t)(n * 1024 + kc) * 2u); },
                  [=](int m, int n, f32x4 v) {
                    const f32x4 gg = ld_bf4(GB + (size_t)m * 1024 + n);
                    const f32x4 zz = ld_bf4(UZ + (size_t)m * 2048 + 1024 + n);
                    const f32x4 bb = *(const f32x4*)(bg + n);
                    f32x4 r;
#pragma unroll
                    for (int i = 0; i < 4; ++i) r[i] = gg[i] * sigm(v[i] + bb[i]) * silu(zz[i]);
                    st_bf4(VB + (size_t)m * 1024 + n, r);
                  });
      }
    }
    xcd_barrier(xb);
    {
      const u16* Wt = W_AOUT + (size_t)l * 2048 * 1024;
      for (int tile = blockIdx.x; tile < 64 * 8; tile += gridDim.x) {
        const int mt = tile & 63, nt = tile >> 6;
        const float2* stp = STATS;
        const float* pgam = p.in[22] + (size_t)(l > 0 ? l - 1 : 0) * 2048;
        const float* pbet = p.in[23] + (size_t)(l > 0 ? l - 1 : 0) * 2048;
        gemm_tile_w<true>(smem, mt * 128, nt * 256, 32,
                  [=](int m, int k0, int kc) { return ldg_o(VB + k0, (uint32_t)(m * 1024 + kc) * 2u); },
                  [=](int n, int k0, int kc) { return ldg_o(Wt + k0, (uint32_t)(n * 1024 + kc) * 2u); },
                  [=](int m, int n, f32x4 v, f32x4 xr) {
                    if (l > 0) {
                      const float2 st = stp[m];
                      const f32x4 gg = *(const f32x4*)(pgam + n);
                      const f32x4 bb = *(const f32x4*)(pbet + n);
#pragma unroll
                      for (int i = 0; i < 4; ++i) xr[i] = (xr[i] - st.x) * st.y * gg[i] + bb[i];
                    }
                    f32x4 r;
#pragma unroll
                    for (int i = 0; i < 4; ++i) r[i] = DN_ALPHA * xr[i] + v[i];
                    *(f32x4*)((char*)XF + (uint32_t)(m * 2048 + n) * 4u) = r;
                  },
                  [=](int m, int n) { return *(const f32x4*)((const char*)xres + (uint32_t)(m * 2048 + n) * 4u); });
      }
    }
    xcd_barrier(xb);
    {
      const int tid = tid_l(), lane = tid & 63, wave = tid >> 6; (void)lane; (void)wave;
      const float* lg_ = p.in[22] + (size_t)l * 2048;
      const float* lb_ = p.in[23] + (size_t)l * 2048;
      for (int row = blockIdx.x * 4 + wave; row < NTOK; row += gridDim.x * 4) {
        float* xr = XF + (size_t)row * 2048;
        f32x4 v[8];
        float sum = 0.f;
#pragma unroll
        for (int i = 0; i < 8; ++i) { v[i] = *(const f32x4*)(xr + i * 256 + lane * 4); sum += v[i][0] + v[i][1] + v[i][2] + v[i][3]; }
#pragma unroll
        for (int o = 32; o >= 1; o >>= 1) sum += __shfl_xor(sum, o);
        const float mu = sum * (1.f / 2048.f);
        float sq = 0.f;
#pragma unroll
        for (int i = 0; i < 8; ++i)
#pragma unroll
          for (int e = 0; e < 4; ++e) { const float d = v[i][e] - mu; sq += d * d; }
#pragma unroll
        for (int o = 32; o >= 1; o >>= 1) sq += __shfl_xor(sq, o);
        const float rstd = rsqrtf(sq * (1.f / 2048.f) + LN_EPS);
#pragma unroll
        for (int i = 0; i < 8; ++i) {
          const int c = i * 256 + lane * 4;
          const f32x4 gg = *(const f32x4*)(lg_ + c);
          const f32x4 bb = *(const f32x4*)(lb_ + c);
          f32x4 r;
#pragma unroll
          for (int e = 0; e < 4; ++e) r[e] = (v[i][e] - mu) * rstd * gg[e] + bb[e];
          st_bf4(XB + (size_t)row * 2048 + c, r);
        }
        if (lane == 0) STATS[row] = make_float2(mu, rstd);
      }
    }
    xcd_barrier(xb);
  }

  {
    for (int tile = blockIdx.x; tile < 64 * 24; tile += gridDim.x) {
      const int mt = tile & 63, nt = tile >> 6;
      gemm_tile(smem, mt * 128, nt * 128, 32, kmap64,
                [=](int m, int k0, int kc) { return ldg_o(XB + k0, (uint32_t)(m * 2048 + kc) * 2u); },
                [=](int n, int k0, int kc) { return ldg_o(W_KV + k0, (uint32_t)(n * 2048 + kc) * 2u); },
                [=](int m, int n, f32x4 v) { st_bf4(KV + (size_t)m * KV_LD + n, v); });
    }
  }
  xcd_barrier(xb);
  for (int lb = 0; lb < 2; ++lb) {
    const int layer = 2 + lb;
    {
      const u16* Wt = W_BIN + (size_t)lb * PROJ_LD * 2048;
      if (lb == 0 && blockIdx.x >= 64 && blockIdx.x < 128) {
        const int ct = blockIdx.x - 64;
        const int half = ct >> 5, kvs = (ct >> 4) & 1, mt = ct & 15;
        const u16* Wc = W_C1 + (size_t)kvs * 128 * 4096;
        float* t1 = T1P + ((size_t)(half * 2 + kvs)) * 2048 * 128;
        gemm_tile<1>(smem, mt * 128, 0, 32, [=](int ks) { return half * 2048 + ks * 64; },
                  [=](int m, int k0, int kc) {
                    const int b = m >> 10, n = (m >> 2) & 255, g = m & 3;
                    int tok = n * 16 + (k0 >> 7);
                    tok = tok > 4095 ? 4095 : tok;
                    return ldg_o(KV + kvs * 512 + (k0 & 127), (uint32_t)((b * 4096 + tok) * KV_LD + g * 128 + kc) * 2u);
                  },
                  [=](int n, int k0, int kc) { return ldg_o(Wc + k0, (uint32_t)(n * 4096 + kc) * 2u); },
                  [=](int m, int n, f32x4 v) { *(f32x4*)(t1 + (size_t)m * 128 + n) = v; });
      }
      for (int rep = 0; rep < REPS_BIN; ++rep)
      for (int tile = blockIdx.x; tile < 64 * 32; tile += gridDim.x) {
        const int mt = tile & 63, nt = tile >> 6;
        gemm_tile_w(smem, mt * 128, nt * 256, 64,
                  [=](int m, int k0, int kc) { return ldg_o(XB + k0, (uint32_t)(m * 2048 + kc) * 2u); },
                  [=](int n, int k0, int kc) { return ldg_o(Wt + k0, (uint32_t)(n * 2048 + kc) * 2u); },
                  [=](int m, int n, f32x4 v) { st_bf4(PROJ + (size_t)m * PROJ_LD + n, v); });
      }
      for (int tile = blockIdx.x; tile < 64; tile += gridDim.x) {
        const int mt = tile & 63, nt = 64;
        gemm_tile(smem, mt * 128, nt * 128, 32, kmap64,
                  [=](int m, int k0, int kc) { return ldg_o(XB + k0, (uint32_t)(m * 2048 + kc) * 2u); },
                  [=](int n, int k0, int kc) { return ldg_o(Wt + k0, (uint32_t)(n * 2048 + kc) * 2u); },
                  [=](int m, int n, f32x4 v) { st_bf4(PROJ + (size_t)m * PROJ_LD + n, v); });
      }
    }
    xcd_barrier(xb);
    if (lb == 0) {
      for (int tile = blockIdx.x; tile < 32; tile += gridDim.x) {
        const int kvs = tile >> 4, mt = tile & 15;
        const u16* Wt = W_C2 + (size_t)kvs * 128 * 128;
        const float* t1a = T1P + ((size_t)kvs) * 2048 * 128;
        const float* t1b = T1P + ((size_t)(2 + kvs)) * 2048 * 128;
        const float* cb = C1B + kvs * 128;
        u16* kc_ = KCVC + (size_t)kvs * 2048 * 128;
        gemm_tile<1>(smem, mt * 128, 0, 2, kmap64,
                  [=](int m, int k0, int kc) {
                    const int k = k0 + kc;
                    const f32x4 a0 = *(const f32x4*)(t1a + (size_t)m * 128 + k), a1 = *(const f32x4*)(t1a + (size_t)m * 128 + k + 4);
                    const f32x4 b0 = *(const f32x4*)(t1b + (size_t)m * 128 + k), b1 = *(const f32x4*)(t1b + (size_t)m * 128 + k + 4);
                    const f32x4 c0 = *(const f32x4*)(cb + k), c1 = *(const f32x4*)(cb + k + 4);
                    uint4 r;
                    r.x = pack2(gelu_tanh(a0[0] + b0[0] + c0[0]), gelu_tanh(a0[1] + b0[1] + c0[1]));
                    r.y = pack2(gelu_tanh(a0[2] + b0[2] + c0[2]), gelu_tanh(a0[3] + b0[3] + c0[3]));
                    r.z = pack2(gelu_tanh(a1[0] + b1[0] + c1[0]), gelu_tanh(a1[1] + b1[1] + c1[1]));
                    r.w = pack2(gelu_tanh(a1[2] + b1[2] + c1[2]), gelu_tanh(a1[3] + b1[3] + c1[3]));
                    return r;
                  },
                  [=](int n, int k0, int kc) { return ldg_o(Wt + k0, (uint32_t)(n * 128 + kc) * 2u); },
                  [=](int m, int n, f32x4 v) {
                    if (((m >> 2) & 255) == 255) v = f32x4{0.f, 0.f, 0.f, 0.f};
                    st_bf4(kc_ + (size_t)m * 128 + n, v);
                  });
      }
      xcd_barrier(xb);
    }
#ifndef NO_ATTN
    {
      u16* sK = smem;
      u16* sV = smem + 2 * 64 * 136;
      uint32_t* imp = (uint32_t*)(smem + 2 * 64 * 136 + 2 * 64 * 144);
      unsigned long long* selm = (unsigned long long*)(imp + 32 * 65);
      const int tid = tid_l(), lane = tid & 63, wave = tid >> 6;
      const int l15 = lane & 15, quad = lane >> 4;
      const u16* KC = KCVC;
      const u16* VC = KCVC + (size_t)2048 * 128;
      for (int rep = 0; rep < REPS_ATTN; ++rep)
      for (int item = blockIdx.x; item < 1024; item += gridDim.x) {
        const int qt = (item < 512) ? (127 - (item >> 3)) : ((item - 512) >> 3);
        const int bg = item & 7, b = bg >> 2, g = bg & 3;
        const int t0 = qt * 32, h = g * 4 + wave;
        const size_t tokbase = (size_t)b * SEQ;
        const int cur = t0 >> 6;
        if (DESYNC_COND) __builtin_amdgcn_s_sleep(60);
        for (int i = tid; i < 32 * 65; i += 256) imp[i] = 0u;
        bf16x8 qf[2][4];
#pragma unroll
        for (int qs = 0; qs < 2; ++qs)
#pragma unroll
          for (int ds = 0; ds < 4; ++ds) {
            uint4 v = ldg16(PROJ + (tokbase + t0 + qs * 16 + l15) * PROJ_LD + h * 128 + ds * 32 + quad * 8);
            union { uint4 u; bf16x8 v; } cv; cv.u = v; qf[qs][ds] = cv.v;
          }
        const int tq0 = t0 + l15, tq1 = t0 + 16 + l15;
        f32x4 o[2][8];
        float mrow[2], lrow[2], linv[2];
        auto zero_o = [&]() {
#pragma unroll
          for (int qs = 0; qs < 2; ++qs)
#pragma unroll
            for (int dt = 0; dt < 8; ++dt) o[qs][dt] = f32x4{0.f, 0.f, 0.f, 0.f};
        };
        auto finish_l = [&]() {
#pragma unroll
          for (int qs = 0; qs < 2; ++qs) {
            float lsum = lrow[qs];
            lsum += __shfl_xor(lsum, 16);
            lsum += __shfl_xor(lsum, 32);
            linv[qs] = 1.f / fmaxf(lsum, 1e-30f);
          }
        };
        auto emit = [&](int br, bool first, bool scale_l) {
          float* wbuf = (float*)smem + wave * (16 * 132);
          const int rrow = lane >> 5, rcol = (lane & 31) * 4;
          const int tb = (int)tokbase + t0;
          const uint32_t zoff0 = (uint32_t)((tb + rrow) * PROJ_LD + 2048 + br * 2048 + h * 128 + rcol) * 2u;
          const uint32_t yoff0 = (uint32_t)((tb + rrow) * 2048 + h * 128 + rcol) * 2u;
          const u16 graw0 = *(const u16*)((const char*)PROJ + (uint32_t)((tb + l15) * PROJ_LD + 8192 + br * 16 + h) * 2u);
          const u16 graw1 = *(const u16*)((const char*)PROJ + (uint32_t)((tb + 16 + l15) * PROJ_LD + 8192 + br * 16 + h) * 2u);
#pragma unroll
          for (int qs = 0; qs < 2; ++qs) {
            const float gate = sigm(bf2f(qs ? graw1 : graw0));
            const float sc = scale_l ? gate * linv[qs] : gate;
#pragma unroll
            for (int dt = 0; dt < 8; ++dt) *(f32x4*)(wbuf + l15 * 132 + dt * 16 + quad * 4) = o[qs][dt] * sc;
            __builtin_amdgcn_wave_barrier();
#pragma unroll 4
            for (int j = 0; j < 8; ++j) {
              const uint32_t zo = zoff0 + (uint32_t)((qs * 16 + j * 2) * PROJ_LD) * 2u;
              const uint32_t yo = yoff0 + (uint32_t)((qs * 16 + j * 2) * 2048) * 2u;
              const f32x4 a = *(const f32x4*)(wbuf + (j * 2 + rrow) * 132 + rcol);
              const f32x4 zz = ld_bf4((const u16*)((const char*)PROJ + zo));
              u16* yp = (u16*)((char*)YB + yo);
              f32x4 r;
#pragma unroll
              for (int e = 0; e < 4; ++e) r[e] = a[e] * silu(zz[e]);
              if (!first) {
                const f32x4 old = ld_bf4(yp);
#pragma unroll
                for (int e = 0; e < 4; ++e) r[e] += old[e];
              }
              st_bf4(yp, r);
            }
          }
          __syncthreads();
        };
#ifndef NO_CMP
        {
          int nmax = t0 >> 4; if (nmax > 254) nmax = 254;
          const int ntl = (nmax >> 6) + 1;
          auto tilefn = [&](int i, const u16*& kb, const u16*& vb, size_t& rs, int& kp) {
            const size_t off = (((size_t)b * 256 + i * 64) * 4 + g) * 128;
            kb = KC + off; vb = VC + off; rs = 512; kp = i * 64;
          };
          auto valid = [&](int kpos, int qs) { return kpos * 16 + 31 <= (qs ? tq1 : tq0); };
          mrow[0] = mrow[1] = -1e30f; lrow[0] = lrow[1] = 0.f; linv[0] = linv[1] = 1.f;
          auto nobias = [](int, int) { return 0.f; };
          auto allem = [](int) { return true; };
          attn_loop<1>(sK, sV, imp, ntl, tilefn, nobias, allem, valid, qf, o, mrow, lrow, linv);
          finish_l();
          zero_o();
          attn_loop<2>(sK, sV, imp, ntl, tilefn, nobias, allem, valid, qf, o, mrow, lrow, linv);
          emit(0, true, false);
        }
#endif
        {
#pragma unroll 1
          for (int tt = 0; tt < 8; ++tt) {
            const int tok = wave * 8 + tt;
            unsigned long long mask;
            if (cur < 16) {
              mask = (2ull << cur) - 1ull;
            } else {
              const uint32_t v = imp[tok * 65 + lane];
              const bool cand = (lane >= 1) && (lane <= cur - 2);
              const unsigned long long cm = __ballot(cand);
              uint32_t T = 0u;
#pragma unroll 1
              for (int bit = 30; bit >= 0; --bit) {
                const uint32_t tr = T | (1u << bit);
                const unsigned long long m = __ballot(v >= tr) & cm;
                if (__popcll(m) >= 13) T = tr;
              }
              const unsigned long long gt = __ballot(v > T) & cm;
              unsigned long long eq = __ballot(v == T) & cm;
              int need = 13 - (int)__popcll(gt);
              unsigned long long pick = 0ull;
              while (need > 0 && eq != 0ull) {
                const unsigned long long low = eq & (0ull - eq);
                pick |= low; eq ^= low; --need;
              }
              mask = gt | pick | 1ull | (1ull << cur) | (1ull << (cur - 1));
            }
            if (lane == 0) selm[tok] = mask;
          }
          __syncthreads();
        }
        const unsigned long long sm0 = selm[l15], sm1 = selm[16 + l15];
#ifndef NO_SEL
        {
          auto tilefn = [&](int i, const u16*& kb, const u16*& vb, size_t& rs, int& kp) {
            const size_t off = (tokbase + (size_t)i * 64) * KV_LD + 1024 + g * 128;
            kb = KV + off; vb = KV + off + 512; rs = KV_LD; kp = i * 64;
          };
          auto valid = [&](int kpos, int qs) { return kpos <= (qs ? tq1 : tq0); };
          auto biasfn = [&](int i, int qs) { return (((qs ? sm1 : sm0) >> i) & 1ull) ? 0.f : -1e30f; };
          auto emfn = [&](int i) { return i == cur; };
          mrow[0] = mrow[1] = -1e30f; lrow[0] = lrow[1] = 0.f;
          zero_o();
          attn_loop<0>(sK, sV, imp, cur + 1, tilefn, biasfn, emfn, valid, qf, o, mrow, lrow, linv);
          finish_l();
          emit(1, false, true);
        }
#endif
#ifndef NO_WIN
        {
          int jt0 = (t0 - 511) >> 6; if (jt0 < 0) jt0 = 0;
          auto tilefn = [&](int i, const u16*& kb, const u16*& vb, size_t& rs, int& kp) {
            const size_t off = (tokbase + (size_t)(jt0 + i) * 64) * KV_LD + 2048 + g * 128;
            kb = KV + off; vb = KV + off + 512; rs = KV_LD; kp = (jt0 + i) * 64;
          };
          auto valid = [&](int kpos, int qs) {
            const int t = qs ? tq1 : tq0;
            return (kpos <= t) && (kpos > t - 512);
          };
          auto biasfn = [](int, int) { return 0.f; };
          auto emfn = [&](int i) { const int kp = (jt0 + i) * 64; return !((kp + 63 <= t0) && (kp > t0 + 31 - 512)); };
          mrow[0] = mrow[1] = -1e30f; lrow[0] = lrow[1] = 0.f;
          zero_o();
          attn_loop<0>(sK, sV, imp, cur - jt0 + 1, tilefn, biasfn, emfn, valid, qf, o, mrow, lrow, linv);
          finish_l();
          emit(2, false, true);
        }
#endif
        __syncthreads();
      }
    }
#endif
    xcd_barrier(xb);
    {
      const u16* Wt = W_BOUT + (size_t)lb * 2048 * 2048;
      for (int tile = blockIdx.x; tile < 64 * 8; tile += gridDim.x) {
        const int mt = tile & 63, nt = tile >> 6;
        const float2* stp = STATS;
        const float* pgam = p.in[22] + (size_t)(layer - 1) * 2048;
        const float* pbet = p.in[23] + (size_t)(layer - 1) * 2048;
        gemm_tile_w<true>(smem, mt * 128, nt * 256, 64,
                  [=](int m, int k0, int kc) { return ldg_o(YB + k0, (uint32_t)(m * 2048 + kc) * 2u); },
                  [=](int n, int k0, int kc) { return ldg_o(Wt + k0, (uint32_t)(n * 2048 + kc) * 2u); },
                  [=](int m, int n, f32x4 v, f32x4 xr) {
                    const float2 st = stp[m];
                    const f32x4 gg = *(const f32x4*)(pgam + n);
                    const f32x4 bb = *(const f32x4*)(pbet + n);
                    f32x4 r;
#pragma unroll
                    for (int i = 0; i < 4; ++i) r[i] = DN_ALPHA * ((xr[i] - st.x) * st.y * gg[i] + bb[i]) + v[i];
                    *(f32x4*)((char*)XF + (uint32_t)(m * 2048 + n) * 4u) = r;
                  },
                  [=](int m, int n) { return *(const f32x4*)((const char*)XF + (uint32_t)(m * 2048 + n) * 4u); });
      }
    }
    xcd_barrier(xb);
    {
      const int tid = tid_l(), lane = tid & 63, wave = tid >> 6; (void)lane; (void)wave;
      const float* lg_ = p.in[22] + (size_t)layer * 2048;
      const float* lb_ = p.in[23] + (size_t)layer * 2048;
      const bool last = (lb == 1);
      for (int row = blockIdx.x * 4 + wave; row < NTOK; row += gridDim.x * 4) {
        float* xr = XF + (size_t)row * 2048;
        float* orow = last ? (p.out + (size_t)row * 2048) : xr;
        f32x4 v[8];
        float sum = 0.f;
#pragma unroll
        for (int i = 0; i < 8; ++i) { v[i] = *(const f32x4*)(xr + i * 256 + lane * 4); sum += v[i][0] + v[i][1] + v[i][2] + v[i][3]; }
#pragma unroll
        for (int o = 32; o >= 1; o >>= 1) sum += __shfl_xor(sum, o);
        const float mu = sum * (1.f / 2048.f);
        float sq = 0.f;
#pragma unroll
        for (int i = 0; i < 8; ++i)
#pragma unroll
          for (int e = 0; e < 4; ++e) { const float d = v[i][e] - mu; sq += d * d; }
#pragma unroll
        for (int o = 32; o >= 1; o >>= 1) sq += __shfl_xor(sq, o);
        const float rstd = rsqrtf(sq * (1.f / 2048.f) + LN_EPS);
#pragma unroll
        for (int i = 0; i < 8; ++i) {
          const int c = i * 256 + lane * 4;
          const f32x4 gg = *(const f32x4*)(lg_ + c);
          const f32x4 bb = *(const f32x4*)(lb_ + c);
          f32x4 r;
#pragma unroll
          for (int e = 0; e < 4; ++e) r[e] = (v[i][e] - mu) * rstd * gg[e] + bb[e];
          if (last) *(f32x4*)(orow + c) = r;
          else st_bf4(XB + (size_t)row * 2048 + c, r);
        }
        if (!last && lane == 0) STATS[row] = make_float2(mu, rstd);
      }
    }
    if (lb == 0) xcd_barrier(xb);
  }
}

extern "C" void kernel_launch(void* const* d_in, const int* in_sizes, int n_in, void* d_out, int out_size, void* d_ws,
                              size_t ws_size, hipStream_t stream) {
  static int grid_blocks = 0;
  if (!grid_blocks) {
    int dev = 0, cus = 0, per_cu = 0;
    hipGetDevice(&dev);
    hipDeviceGetAttribute(&cus, hipDeviceAttributeMultiprocessorCount, dev);
    hipOccupancyMaxActiveBlocksPerMultiprocessor(&per_cu, yoco_fwd, 256, 0);
    if (per_cu > 2) per_cu = 2;
    if (per_cu < 1) per_cu = 1;
    grid_blocks = cus * per_cu;
  }
  Params p{};
  for (int i = 0; i < 24; ++i) p.in[i] = (const float*)d_in[i];
  p.out = (float*)d_out;
  p.ws = (char*)d_ws;
  if (ws_size < WS_TOTAL) fprintf(stderr, "workspace too small: %zu < %zu\n", ws_size, (size_t)WS_TOTAL);
  (void)hipMemsetAsync((char*)d_ws + O_BAR, 0, XCD_BAR_WORDS * 4, stream);
  void* args[] = {&p};
  hipError_t e = hipLaunchCooperativeKernel((void*)yoco_fwd, dim3(grid_blocks), dim3(256), args, 0, stream);
  if (e != hipSuccess) fprintf(stderr, "cooperative launch failed: %s (grid %d)\n", hipGetErrorString(e), grid_blocks);
}
```

```cpp
#include <hip/hip_runtime.h>
#include <hip/hip_cooperative_groups.h>
#include <stdint.h>
#include <stdio.h>
namespace cg = cooperative_groups;

typedef __attribute__((ext_vector_type(8))) short bf16x8;
typedef __attribute__((ext_vector_type(4))) short s16x4;
typedef __attribute__((ext_vector_type(4))) float f32x4;
typedef unsigned short u16;
#define DI __device__ __forceinline__

#define DESYNC_COND (blockIdx.x >= 256)
#ifndef ATT_SAFE
#define ATT_SAFE 0
#endif
#ifndef REPS_ATTN
#define REPS_ATTN 1
#endif
#ifndef REPS_BIN
#define REPS_BIN 1
#endif
#ifndef REPS_SSM
#define REPS_SSM 1
#endif
#ifndef REPS_P0
#define REPS_P0 1
#endif
constexpr int NTOK = 8192, DM = 2048, SEQ = 4096, EW = 1024;
constexpr int PROJ_LD = 8320, BIN_N = 8240, KV_LD = 3072;
constexpr float DN_ALPHA = 1.681792830507429f;
constexpr float LN_EPS = 1e-5f;
constexpr float SCALE2 = 0.08838834764831845f * 1.4426950408889634f;

constexpr size_t al256(size_t x) { return (x + 255) & ~(size_t)255; }
constexpr size_t O_WAIN = 0;
constexpr size_t O_WGLU = O_WAIN + al256((size_t)2 * 2048 * 2048 * 2);
constexpr size_t O_WAOUT = O_WGLU + al256((size_t)2 * 1024 * 1024 * 2);
constexpr size_t O_WKV = O_WAOUT + al256((size_t)2 * 2048 * 1024 * 2);
constexpr size_t O_WC1 = O_WKV + al256((size_t)3072 * 2048 * 2);
constexpr size_t O_WC2 = O_WC1 + al256((size_t)2 * 128 * 4096 * 2);
constexpr size_t O_WBIN = O_WC2 + al256((size_t)2 * 128 * 128 * 2);
constexpr size_t O_WBOUT = O_WBIN + al256((size_t)2 * PROJ_LD * 2048 * 2);
constexpr size_t O_XB = O_WBOUT + al256((size_t)2 * 2048 * 2048 * 2);
constexpr size_t O_XF = O_XB + al256((size_t)NTOK * DM * 2);
constexpr size_t O_KV = O_XF + al256((size_t)NTOK * DM * 4);
constexpr size_t O_T1 = O_KV + al256((size_t)NTOK * KV_LD * 2);
constexpr size_t O_KCVC = O_T1 + al256((size_t)2 * 2 * 2048 * 128 * 4);
constexpr size_t O_C1B = O_KCVC + al256((size_t)2 * 2048 * 128 * 2);
constexpr size_t O_C1P = O_C1B + al256((size_t)2 * 128 * 4);
constexpr size_t O_BAR = O_C1P + al256((size_t)64 * 128 * 4);
constexpr size_t O_STATS = O_BAR + al256((size_t)4096 * 4);
constexpr size_t O_YB = O_STATS + al256((size_t)NTOK * 8);
constexpr size_t O_UNION = O_YB + al256((size_t)NTOK * DM * 2);
constexpr size_t O_UZ = O_UNION;
constexpr size_t O_G = O_UZ + al256((size_t)NTOK * 2048 * 2);
constexpr size_t O_V = O_G + al256((size_t)NTOK * 1024 * 2);
constexpr size_t O_S = O_V + al256((size_t)NTOK * 1024 * 2);
constexpr size_t O_HIN = O_S + al256((size_t)64 * 128 * 128 * 4);
constexpr size_t O_W1 = O_HIN + al256((size_t)64 * 128 * 128 * 2);
constexpr size_t O_W3T = O_W1 + al256((size_t)2 * 64 * 128 * 1024 * 2);
constexpr size_t O_KTAB = O_W3T + al256((size_t)2 * 64 * 1024 * 128 * 2);
constexpr size_t O_A64 = O_KTAB + al256((size_t)2 * 64 * 64 * 256 * 2);
constexpr size_t O_S5END = O_A64 + al256((size_t)2 * 64 * 64 * 8);
constexpr size_t O_PROJ = O_UNION;
constexpr size_t O_PROJEND = O_PROJ + al256((size_t)NTOK * PROJ_LD * 2);
constexpr size_t WS_TOTAL = (O_S5END > O_PROJEND ? O_S5END : O_PROJEND);

struct Params {
  const float* in[24];
  float* out;
  char* ws;
};

DI u16 f2bf(float f) { uint32_t u = __float_as_uint(f); u += 0x7fffu + ((u >> 16) & 1u); return (u16)(u >> 16); }
typedef float f32x2_t __attribute__((ext_vector_type(2)));
typedef __bf16 bf16x2_t __attribute__((ext_vector_type(2)));
DI uint32_t pack2(float a, float b) { f32x2_t v = {a, b}; bf16x2_t h = __builtin_convertvector(v, bf16x2_t); return __builtin_bit_cast(uint32_t, h); }
DI float bflo(uint32_t v) { return __uint_as_float(v << 16); }
DI float bfhi(uint32_t v) { return __uint_as_float(v & 0xffff0000u); }
DI float bf2f(u16 h) { return __uint_as_float(((uint32_t)h) << 16); }
DI uint4 ldg16(const void* p) { return *(const uint4*)p; }
DI uint4 ldg_o(const void* base, uint32_t byte_off) { return *(const uint4*)((const char*)base + byte_off); }
DI float sigm(float x) { return __builtin_amdgcn_rcpf(1.f + __expf(-x)); }
DI float silu(float x) { return x * sigm(x); }
DI float gelu_tanh(float x) { float u = 0.7978845608028654f * (x + 0.044715f * x * x * x); return x * sigm(2.f * u); }
DI void st_bf4(u16* p, f32x4 v) { uint2 o; o.x = pack2(v[0], v[1]); o.y = pack2(v[2], v[3]); *(uint2*)p = o; }
DI f32x4 ld_bf4(const u16* p) { uint2 o = *(const uint2*)p; f32x4 r; r[0] = bflo(o.x); r[1] = bfhi(o.x); r[2] = bflo(o.y); r[3] = bfhi(o.y); return r; }

DI int tid_l() { int t = threadIdx.x; asm volatile("" : "+v"(t)); return t; }


#define XB_TMO      128
#define XB_XCNT(j)  (256  + 64 * (j))
#define XB_XSUB(j)  (1280 + 64 * (j))
#define XB_XGEN(j)  (2304 + 64 * (j))
#define XB_TOP      3328
#define XB_TOPGEN   3392
#define XCD_BAR_WORDS 3456
#define XB_SPIN_CAP (1u << 22)
#define LAS __attribute__((address_space(3)))
DI unsigned xb_ld(unsigned* p) { return __hip_atomic_load(p, __ATOMIC_RELAXED, __HIP_MEMORY_SCOPE_AGENT); }
DI unsigned xb_add(unsigned* p, unsigned v) { return __hip_atomic_fetch_add(p, v, __ATOMIC_RELAXED, __HIP_MEMORY_SCOPE_AGENT); }
DI unsigned xb_xcc_id() { return (unsigned)__builtin_amdgcn_s_getreg((3 << 11) | 20) & 0xFu; }
#define XB_SPIN(cond, bar) do { unsigned _sp = 0; while (cond) { __builtin_amdgcn_s_sleep(1); \
    if ((++_sp & 255u) == 0u) { if (xb_ld(&(bar)[XB_TMO])) break; if (_sp > XB_SPIN_CAP) { atomicAdd(&(bar)[XB_TMO], 1u); break; } } } } while (0)
struct XcdBarrier { unsigned* bar; unsigned x; volatile LAS unsigned* st; };
DI XcdBarrier xcd_barrier_post(unsigned* bar, volatile LAS unsigned* st) {
  XcdBarrier b; b.bar = bar; b.x = xb_xcc_id(); b.st = st;
  if (threadIdx.x == 0) (void)xb_add(&bar[XB_XCNT(b.x)], 1u);
  return b;
}
DI void xcd_barrier_complete(unsigned* bar, unsigned x, unsigned& nloc, unsigned& nx) {
  const unsigned G = gridDim.x * gridDim.y * gridDim.z;
  unsigned sum, cnt, mine, sp = 0u;
  for (;;) {
    sum = 0u; cnt = 0u; mine = 0u;
#pragma unroll
    for (unsigned j = 0; j < 16; ++j) { const unsigned c = xb_ld(&bar[XB_XCNT(j)]); sum += c; cnt += (c > 0u) ? 1u : 0u; mine = (j == x) ? c : mine; }
    if (sum == G) break;
    __builtin_amdgcn_s_sleep(1);
    if ((++sp & 255u) == 0u) { if (xb_ld(&bar[XB_TMO])) break; if (sp > XB_SPIN_CAP) { atomicAdd(&bar[XB_TMO], 1u); break; } }
  }
  nloc = mine > 0u ? mine : 1u; nx = cnt > 0u ? cnt : 1u;
}
DI void xcd_barrier(const XcdBarrier& b) {
  asm volatile("s_waitcnt vmcnt(0)" ::: "memory");
  __syncthreads();
  if (threadIdx.x == 0) {
    unsigned* bar = b.bar;
    __builtin_amdgcn_s_waitcnt(0);
    unsigned nloc = b.st[0], nx = b.st[1];
    if (nloc == 0u) { xcd_barrier_complete(bar, b.x, nloc, nx); b.st[0] = nloc; b.st[1] = nx; }
    const unsigned old = xb_add(&bar[XB_XSUB(b.x)], 1u);
    const unsigned gen = old / nloc;
    if (old + 1u == (gen + 1u) * nloc) {
      __builtin_amdgcn_fence(__ATOMIC_RELEASE, "agent");
      asm volatile("s_waitcnt vmcnt(0)" ::: "memory");
      const unsigned og = xb_add(&bar[XB_TOP], 1u);
      const unsigned tg = og / nx;
      if (og + 1u == (tg + 1u) * nx) xb_add(&bar[XB_TOPGEN], 1u);
      else XB_SPIN(xb_ld(&bar[XB_TOPGEN]) == tg, bar);
      __builtin_amdgcn_fence(__ATOMIC_ACQUIRE, "agent");
      xb_add(&bar[XB_XGEN(b.x)], 1u);
      asm volatile("s_waitcnt vmcnt(0)" ::: "memory");
    } else {
      XB_SPIN(xb_ld(&bar[XB_XGEN(b.x)]) == gen, bar);
      __builtin_amdgcn_fence(__ATOMIC_ACQUIRE, "agent");
      asm volatile("s_waitcnt vmcnt(0)" ::: "memory");
    }
  }
  __syncthreads();
}

template <int DEPTH = 2, bool STAGED = true, class KMAP, class LA, class LW, class EPI>
DI void gemm_tile(u16* smem, int m0, int n0, int nks, KMAP kmap, LA loadA, LW loadW, EPI epi) {
  const int tid = tid_l(), lane = tid & 63, wave = tid >> 6;
  const int wm = wave >> 1, wn = wave & 1, l15 = lane & 15, quad = lane >> 4;
  u16* sX = smem;
  u16* sW = smem + 2 * 128 * 64;
  f32x4 acc[4][4];
#pragma unroll
  for (int i = 0; i < 4; ++i)
#pragma unroll
    for (int j = 0; j < 4; ++j) acc[i][j] = f32x4{0.f, 0.f, 0.f, 0.f};
  uint4 ra0[4], rw0[4], ra1[4], rw1[4];
  const int lrow = tid >> 3, lkc = (tid & 7) * 8;
  const int wpos = (((tid & 7) ^ ((tid >> 4) & 7)) * 8);
  const int rsw = (l15 >> 1) & 7;
  const int rp0 = ((quad ^ rsw) * 8), rp1 = (((4 + quad) ^ rsw) * 8);
#define G_LOAD(RA, RW, KS) { const int k0_ = __builtin_amdgcn_readfirstlane(kmap(KS)); _Pragma("unroll") for (int i = 0; i < 4; ++i) { RA[i] = loadA(m0 + lrow + i * 32, k0_, lkc); RW[i] = loadW(n0 + lrow + i * 32, k0_, lkc); } }
#define G_STORE(RA, RW, BUF) { u16* dx_ = sX + (BUF) * 128 * 64; u16* dw_ = sW + (BUF) * 128 * 64; _Pragma("unroll") for (int i = 0; i < 4; ++i) { \
    *(uint4*)(dx_ + (lrow + i * 32) * 64 + wpos) = RA[i]; *(uint4*)(dw_ + (lrow + i * 32) * 64 + wpos) = RW[i]; } }
#define G_COMPUTE(BUF, FENCE) { const u16* bx = sX + (BUF) * 128 * 64 + (wm * 64 + l15) * 64; const u16* bw = sW + (BUF) * 128 * 64 + (wn * 64 + l15) * 64; \
    bf16x8 xf[2][4], wf[2][4]; \
    _Pragma("unroll") for (int i = 0; i < 4; ++i) { \
      xf[0][i] = *(const bf16x8*)(bx + i * 16 * 64 + rp0); wf[0][i] = *(const bf16x8*)(bw + i * 16 * 64 + rp0); } \
    _Pragma("unroll") for (int i = 0; i < 4; ++i) { \
      xf[1][i] = *(const bf16x8*)(bx + i * 16 * 64 + rp1); wf[1][i] = *(const bf16x8*)(bw + i * 16 * 64 + rp1); } \
    if (FENCE) __builtin_amdgcn_sched_barrier(0); \
    _Pragma("unroll") for (int kk = 0; kk < 2; ++kk) { \
      _Pragma("unroll") for (int ni = 0; ni < 4; ++ni) _Pragma("unroll") for (int mi = 0; mi < 4; ++mi) \
          acc[ni][mi] = __builtin_amdgcn_mfma_f32_16x16x32_bf16(wf[kk][ni], xf[kk][mi], acc[ni][mi], 0, 0, 0); \
      if (FENCE) __builtin_amdgcn_sched_barrier(0); } }
#define G_PATTERN { __builtin_amdgcn_sched_group_barrier(0x100, 16, 0); \
    _Pragma("unroll") for (int q_ = 0; q_ < 8; ++q_) { __builtin_amdgcn_sched_group_barrier(0x008, 2, 0); __builtin_amdgcn_sched_group_barrier(0x020, 1, 0); } \
    _Pragma("unroll") for (int q_ = 0; q_ < 8; ++q_) { __builtin_amdgcn_sched_group_barrier(0x008, 2, 0); __builtin_amdgcn_sched_group_barrier(0x200, 1, 0); } }
  if (DEPTH == 2) {
    G_LOAD(ra0, rw0, 0);
    G_LOAD(ra1, rw1, 1);
    G_STORE(ra0, rw0, 0);
    __syncthreads();
    for (int ks = 0; ks < nks; ks += 2) {
      G_LOAD(ra0, rw0, (ks + 2 < nks ? ks + 2 : nks - 1));
      G_COMPUTE(0, 0);
      G_STORE(ra1, rw1, 1);
      G_PATTERN;
      __syncthreads();
      G_LOAD(ra1, rw1, (ks + 3 < nks ? ks + 3 : nks - 1));
      G_COMPUTE(1, 0);
      G_STORE(ra0, rw0, 0);
      G_PATTERN;
      __syncthreads();
    }
  } else {
    G_LOAD(ra0, rw0, 0);
    G_STORE(ra0, rw0, 0);
    __syncthreads();
    for (int ks = 0; ks < nks; ++ks) {
      const int buf = ks & 1;
      if (ks + 1 < nks) G_LOAD(ra0, rw0, ks + 1);
      G_COMPUTE(buf, 1);
      if (ks + 1 < nks) G_STORE(ra0, rw0, buf ^ 1);
      __syncthreads();
    }
  }
#undef G_LOAD
#undef G_STORE
#undef G_COMPUTE
#undef G_PATTERN
  if constexpr (!STAGED) {
#pragma unroll
    for (int ni = 0; ni < 4; ++ni)
#pragma unroll
      for (int mi = 0; mi < 4; ++mi)
        epi(m0 + wm * 64 + mi * 16 + l15, n0 + wn * 64 + ni * 16 + quad * 4, acc[ni][mi]);
  } else {
    float* wbuf = (float*)smem + wave * (16 * 68);
    const int rrow = lane >> 4, rcol = (lane & 15) * 4;
#pragma unroll
    for (int mi = 0; mi < 4; ++mi) {
#pragma unroll
      for (int ni = 0; ni < 4; ++ni) *(f32x4*)(wbuf + l15 * 68 + ni * 16 + quad * 4) = acc[ni][mi];
      __builtin_amdgcn_wave_barrier();
#pragma unroll
      for (int j = 0; j < 4; ++j) {
        const f32x4 a = *(const f32x4*)(wbuf + (j * 4 + rrow) * 68 + rcol);
        epi(m0 + wm * 64 + mi * 16 + j * 4 + rrow, n0 + wn * 64 + rcol, a);
      }
    }
    __syncthreads();
  }
}

template <bool HASPRE = false, class LA, class LW, class EPI, class PRE = int>
DI void gemm_tile_w(u16* smem, int m0, int n0, int nks, LA loadA, LW loadW, EPI epi, PRE pre = 0) {
  const int tid = tid_l(), lane = tid & 63, wave = tid >> 6;
  const int wm = wave >> 1, wn = wave & 1, l15 = lane & 15, quad = lane >> 4;
  u16* sX = smem;
  u16* sW = smem + 2 * 128 * 32;
  f32x4 acc[8][4];
#pragma unroll
  for (int i = 0; i < 8; ++i)
#pragma unroll
    for (int j = 0; j < 4; ++j) acc[i][j] = f32x4{0.f, 0.f, 0.f, 0.f};
  uint4 ra0[2], rw0[4], ra1[2], rw1[4];
  const int lrow = tid >> 2, lkc = (tid & 3) * 8;
  const int wpos = ((tid & 3) ^ ((0 - (tid >> 4)) & 3)) * 8;
  const int rpos = (quad ^ ((0 - (l15 >> 2)) & 3)) * 8;
#define W_LOAD(RA, RW, KS) { const int k0_ = __builtin_amdgcn_readfirstlane((KS) * 32); \
    _Pragma("unroll") for (int i = 0; i < 2; ++i) RA[i] = loadA(m0 + lrow + i * 64, k0_, lkc); \
    _Pragma("unroll") for (int i = 0; i < 4; ++i) RW[i] = loadW(n0 + lrow + i * 64, k0_, lkc); }
#define W_STORE(RA, RW, BUF) { u16* dx_ = sX + (BUF) * 128 * 32; u16* dw_ = sW + (BUF) * 256 * 32; \
    _Pragma("unroll") for (int i = 0; i < 2; ++i) *(uint4*)(dx_ + (lrow + i * 64) * 32 + wpos) = RA[i]; \
    _Pragma("unroll") for (int i = 0; i < 4; ++i) *(uint4*)(dw_ + (lrow + i * 64) * 32 + wpos) = RW[i]; }
#define W_COMPUTE(BUF) { const u16* bx = sX + (BUF) * 128 * 32 + (wm * 64 + l15) * 32 + rpos; const u16* bw = sW + (BUF) * 256 * 32 + (wn * 128 + l15) * 32 + rpos; \
    bf16x8 xf[4], wf[8]; \
    _Pragma("unroll") for (int i = 0; i < 4; ++i) xf[i] = *(const bf16x8*)(bx + i * 16 * 32); \
    _Pragma("unroll") for (int i = 0; i < 8; ++i) wf[i] = *(const bf16x8*)(bw + i * 16 * 32); \
    _Pragma("unroll") for (int ni = 0; ni < 8; ++ni) _Pragma("unroll") for (int mi = 0; mi < 4; ++mi) \
        acc[ni][mi] = __builtin_amdgcn_mfma_f32_16x16x32_bf16(wf[ni], xf[mi], acc[ni][mi], 0, 0, 0); }
#define W_PATTERN { __builtin_amdgcn_sched_group_barrier(0x100, 12, 0); \
    _Pragma("unroll") for (int q_ = 0; q_ < 6; ++q_) { __builtin_amdgcn_sched_group_barrier(0x008, 2, 0); __builtin_amdgcn_sched_group_barrier(0x020, 1, 0); } \
    _Pragma("unroll") for (int q_ = 0; q_ < 6; ++q_) { __builtin_amdgcn_sched_group_barrier(0x008, 3, 0); __builtin_amdgcn_sched_group_barrier(0x200, 1, 0); } \
    __builtin_amdgcn_sched_group_barrier(0x008, 2, 0); }
  W_LOAD(ra0, rw0, 0);
  W_LOAD(ra1, rw1, 1);
  W_STORE(ra0, rw0, 0);
  __syncthreads();
  for (int ks = 0; ks < nks; ks += 2) {
    W_LOAD(ra0, rw0, (ks + 2 < nks ? ks + 2 : nks - 1));
    W_COMPUTE(0);
    W_STORE(ra1, rw1, 1);
    W_PATTERN;
    __syncthreads();
    W_LOAD(ra1, rw1, (ks + 3 < nks ? ks + 3 : nks - 1));
    W_COMPUTE(1);
    W_STORE(ra0, rw0, 0);
    W_PATTERN;
    __syncthreads();
  }
#undef W_LOAD
#undef W_STORE
#undef W_COMPUTE
#undef W_PATTERN
  if constexpr (HASPRE) {
    float* wbuf = (float*)smem + wave * (16 * 132);
    const int rrow = lane >> 5, rcol = (lane & 31) * 4;
#pragma unroll
    for (int mi = 0; mi < 4; ++mi) {
#pragma unroll
      for (int ni = 0; ni < 8; ++ni) *(f32x4*)(wbuf + l15 * 132 + ni * 16 + quad * 4) = acc[ni][mi];
      __builtin_amdgcn_wave_barrier();
      f32x4 pv[8];
#pragma unroll
      for (int j = 0; j < 8; ++j) pv[j] = pre(m0 + wm * 64 + mi * 16 + j * 2 + rrow, n0 + wn * 128 + rcol);
#pragma unroll
      for (int j = 0; j < 8; ++j) {
        const f32x4 a = *(const f32x4*)(wbuf + (j * 2 + rrow) * 132 + rcol);
        epi(m0 + wm * 64 + mi * 16 + j * 2 + rrow, n0 + wn * 128 + rcol, a, pv[j]);
      }
    }
    __syncthreads();
  } else {
    float* wbuf = (float*)smem + wave * (16 * 132);
    const int rrow = lane >> 5, rcol = (lane & 31) * 4;
#pragma unroll
    for (int mi = 0; mi < 4; ++mi) {
#pragma unroll
      for (int ni = 0; ni < 8; ++ni) *(f32x4*)(wbuf + l15 * 132 + ni * 16 + quad * 4) = acc[ni][mi];
      __builtin_amdgcn_wave_barrier();
#pragma unroll
      for (int j = 0; j < 8; ++j) {
        const f32x4 a = *(const f32x4*)(wbuf + (j * 2 + rrow) * 132 + rcol);
        epi(m0 + wm * 64 + mi * 16 + j * 2 + rrow, n0 + wn * 128 + rcol, a);
      }
    }
    __syncthreads();
  }
}

DI void tconv(float* tl, const float* src, u16* dst, int K, int N, int Npad, int b0, int nb) {
  const int tid = tid_l();
  const int nkt = K >> 6, nnt = Npad >> 6, ntl = nkt * nnt;
  const int r = tid >> 4, c4 = (tid & 15) * 4;
  float4 v[4];
  int tile = (int)blockIdx.x - b0;
  auto ld = [&](int t) {
    const int kt = t % nkt, nt = t / nkt;
    const int k0 = kt * 64, n0 = nt * 64;
#pragma unroll
    for (int i = 0; i < 4; ++i) {
      v[i] = make_float4(0.f, 0.f, 0.f, 0.f);
      if (n0 + c4 < N) v[i] = *(const float4*)(src + (size_t)(k0 + r + i * 16) * N + n0 + c4);
    }
  };
  if (tile < ntl) ld(tile);
  for (; tile < ntl; tile += nb) {
    const int kt = tile % nkt, nt = tile / nkt;
    const int k0 = kt * 64, n0 = nt * 64;
#pragma unroll
    for (int i = 0; i < 4; ++i) {
      const int k = r + i * 16;
      tl[k * 65 + c4 + 0] = v[i].x; tl[k * 65 + c4 + 1] = v[i].y; tl[k * 65 + c4 + 2] = v[i].z; tl[k * 65 + c4 + 3] = v[i].w;
    }
    if (tile + nb < ntl) ld(tile + nb);
    __syncthreads();
#pragma unroll
    for (int i = 0; i < 2; ++i) {
      const int c = tid + i * 256;
      const int n = c >> 3, k8 = (c & 7) * 8;
      uint4 o;
      o.x = pack2(tl[(k8 + 0) * 65 + n], tl[(k8 + 1) * 65 + n]);
      o.y = pack2(tl[(k8 + 2) * 65 + n], tl[(k8 + 3) * 65 + n]);
      o.z = pack2(tl[(k8 + 4) * 65 + n], tl[(k8 + 5) * 65 + n]);
      o.w = pack2(tl[(k8 + 6) * 65 + n], tl[(k8 + 7) * 65 + n]);
      *(uint4*)(dst + (size_t)(n0 + n) * K + k0 + k8) = o;
    }
    __syncthreads();
  }
}

template <int MODE, class TILE, class BIAS, class EM, class MASK>
DI void attn_loop(u16* sK, u16* sV, uint32_t* imp, int ntiles, TILE tilefn, BIAS biasfn, EM emfn, MASK valid, const bf16x8 (&qf)[2][4],
                  f32x4 (&o)[2][8], float (&mrow)[2], float (&lrow)[2], const float (&linv)[2]) {
  const int tid = tid_l(), lane = tid & 63;
  const int l15 = lane & 15, quad = lane >> 4;
  const int lr = tid >> 4, lc = (tid & 15) * 8;
  uint4 rk[4];
#define K_LOAD(IT) { const u16 *kb_, *vb_; size_t rs_; int kp_; tilefn(IT, kb_, vb_, rs_, kp_); _Pragma("unroll") for (int i = 0; i < 4; ++i) rk[i] = ldg_o(kb_, (uint32_t)((lr + i * 16) * (int)rs_ + lc) * 2u); }
#define V_LOAD_G(IT) { const u16 *kb_, *vb_; size_t rs_; int kp_; tilefn(IT, kb_, vb_, rs_, kp_); _Pragma("unroll") for (int i = 0; i < 4; ++i) rk[i] = ldg_o(vb_, (uint32_t)((lr + i * 16) * (int)rs_ + lc) * 2u); }
#define K_STORE(BUF) { _Pragma("unroll") for (int i = 0; i < 4; ++i) *(uint4*)(sK + (BUF) * 64 * 136 + (lr + i * 16) * 136 + lc) = rk[i]; }
#define V_STORE(BUF) { _Pragma("unroll") for (int i = 0; i < 4; ++i) *(uint4*)(sV + (BUF) * 64 * 144 + (lr + i * 16) * 144 + lc) = rk[i]; }
  auto compute = [&](const int buf, const int it, auto midfn) {
    int kpos0;
    { const u16 *kb, *vb; size_t rs; tilefn(it, kb, vb, rs, kpos0); }
    f32x4 s[4][2];
#pragma unroll
    for (int kc = 0; kc < 4; ++kc) { s[kc][0] = f32x4{0.f, 0.f, 0.f, 0.f}; s[kc][1] = f32x4{0.f, 0.f, 0.f, 0.f}; }
    const u16* kbase = sK + buf * 64 * 136 + l15 * 136 + quad * 8;
    {
      bf16x8 kf[2][2];
      kf[0][0] = *(const bf16x8*)(kbase);
      kf[0][1] = *(const bf16x8*)(kbase + 32);
#pragma unroll
      for (int h = 0; h < 8; ++h) {
        const int kc = h >> 1, dh = h & 1;
        if (h < 7) {
          const int kc2 = (h + 1) >> 1, dh2 = (h + 1) & 1;
          kf[(h + 1) & 1][0] = *(const bf16x8*)(kbase + kc2 * 16 * 136 + (dh2 * 2) * 32);
          kf[(h + 1) & 1][1] = *(const bf16x8*)(kbase + kc2 * 16 * 136 + (dh2 * 2 + 1) * 32);
        }
#pragma unroll
        for (int e = 0; e < 2; ++e) {
          const int ds = dh * 2 + e;
          s[kc][0] = __builtin_amdgcn_mfma_f32_16x16x32_bf16(kf[h & 1][e], qf[0][ds], s[kc][0], 0, 0, 0);
          s[kc][1] = __builtin_amdgcn_mfma_f32_16x16x32_bf16(kf[h & 1][e], qf[1][ds], s[kc][1], 0, 0, 0);
        }
        __builtin_amdgcn_sched_barrier(0);
      }
    }
    midfn();
    float mx[2] = {-1e30f, -1e30f};
    if (MODE == 0) {
      const float bias0 = biasfn(it, 0), bias1 = biasfn(it, 1);
      const bool em = ATT_SAFE || emfn(it);
      if (em) {
#pragma unroll
        for (int kc = 0; kc < 4; ++kc)
#pragma unroll
          for (int qs = 0; qs < 2; ++qs)
#pragma unroll
            for (int r = 0; r < 4; ++r) {
              const int kpos = kpos0 + kc * 16 + quad * 4 + r;
              const float x = valid(kpos, qs) ? fmaf(s[kc][qs][r], SCALE2, qs ? bias1 : bias0) : -1e30f;
              s[kc][qs][r] = x;
              mx[qs] = fmaxf(mx[qs], x);
            }
      } else {
        float r0 = -3e38f, r1 = -3e38f;
#pragma unroll
        for (int kc = 0; kc < 4; ++kc)
#pragma unroll
          for (int r = 0; r < 4; ++r) { r0 = fmaxf(r0, s[kc][0][r]); r1 = fmaxf(r1, s[kc][1][r]); }
        mx[0] = fmaf(r0, SCALE2, bias0);
        mx[1] = fmaf(r1, SCALE2, bias1);
      }
      float al[2];
#pragma unroll
      for (int qs = 0; qs < 2; ++qs) {
        float m = mx[qs];
        m = fmaxf(m, __shfl_xor(m, 16));
        m = fmaxf(m, __shfl_xor(m, 32));
        const float mnew = fmaxf(mrow[qs], m);
        al[qs] = __builtin_amdgcn_exp2f(mrow[qs] - mnew);
        mrow[qs] = mnew;
      }
      if (__builtin_amdgcn_ballot_w64(al[0] < 1.f || al[1] < 1.f) != 0ull) {
#pragma unroll
        for (int qs = 0; qs < 2; ++qs) {
          lrow[qs] *= al[qs];
#pragma unroll
          for (int dt = 0; dt < 8; ++dt) o[qs][dt] *= al[qs];
        }
      }
      if (em) {
#pragma unroll
        for (int kc = 0; kc < 4; ++kc)
#pragma unroll
          for (int qs = 0; qs < 2; ++qs)
#pragma unroll
            for (int r = 0; r < 4; ++r) {
              float pv = __builtin_amdgcn_exp2f(s[kc][qs][r] - mrow[qs]);
              if (ATT_SAFE) pv = (s[kc][qs][r] > -1e29f) ? pv : 0.f;
              lrow[qs] += pv;
              s[kc][qs][r] = pv;
            }
      } else {
        const float c0 = bias0 - mrow[0], c1 = bias1 - mrow[1];
#pragma unroll
        for (int kc = 0; kc < 4; ++kc)
#pragma unroll
          for (int qs = 0; qs < 2; ++qs)
#pragma unroll
            for (int r = 0; r < 4; ++r) {
              const float pv = __builtin_amdgcn_exp2f(fmaf(s[kc][qs][r], SCALE2, qs ? c1 : c0));
              lrow[qs] += pv;
              s[kc][qs][r] = pv;
            }
      }
    } else {
#pragma unroll
      for (int kc = 0; kc < 4; ++kc)
#pragma unroll
        for (int qs = 0; qs < 2; ++qs)
#pragma unroll
          for (int r = 0; r < 4; ++r) {
            const int kpos = kpos0 + kc * 16 + quad * 4 + r;
            const float x = valid(kpos, qs) ? s[kc][qs][r] * SCALE2 : -1e30f;
            s[kc][qs][r] = x;
            mx[qs] = fmaxf(mx[qs], x);
          }
      if (MODE == 1) {
#pragma unroll
        for (int qs = 0; qs < 2; ++qs) {
          float m = mx[qs];
          m = fmaxf(m, __shfl_xor(m, 16));
          m = fmaxf(m, __shfl_xor(m, 32));
          const float mnew = fmaxf(mrow[qs], m);
          const float alpha = __builtin_amdgcn_exp2f(mrow[qs] - mnew);
          mrow[qs] = mnew;
          lrow[qs] *= alpha;
        }
      }
#pragma unroll
      for (int kc = 0; kc < 4; ++kc)
#pragma unroll
        for (int qs = 0; qs < 2; ++qs)
#pragma unroll
          for (int r = 0; r < 4; ++r) {
            const float x = s[kc][qs][r];
            float pv = (x > -1e29f) ? __builtin_amdgcn_exp2f(x - mrow[qs]) : 0.f;
            if (MODE == 2) pv *= linv[qs];
            else lrow[qs] += pv;
            s[kc][qs][r] = pv;
          }
    }
    if (MODE == 2) {
#pragma unroll
      for (int kc = 0; kc < 4; ++kc)
#pragma unroll
        for (int qs = 0; qs < 2; ++qs) {
          const int jb = (kpos0 >> 2) + kc * 4 + quad;
          const float a = s[kc][qs][0] + s[kc][qs][1] + s[kc][qs][2] + s[kc][qs][3];
          const float b3 = s[kc][qs][3];
          if (jb < 64) atomicAdd(&imp[(qs * 16 + l15) * 65 + jb], (uint32_t)(a * 67108864.f + 0.5f));
          if (jb + 1 < 64) atomicAdd(&imp[(qs * 16 + l15) * 65 + jb + 1], (uint32_t)(b3 * 67108864.f + 0.5f));
        }
    }
    if (MODE != 1) {
      bf16x8 pb[2][2];
#pragma unroll
      for (int j = 0; j < 2; ++j)
#pragma unroll
        for (int qs = 0; qs < 2; ++qs) {
          union { bf16x8 v; uint32_t u[4]; } cv;
          cv.u[0] = pack2(s[2 * j][qs][0], s[2 * j][qs][1]);
          cv.u[1] = pack2(s[2 * j][qs][2], s[2 * j][qs][3]);
          cv.u[2] = pack2(s[2 * j + 1][qs][0], s[2 * j + 1][qs][1]);
          cv.u[3] = pack2(s[2 * j + 1][qs][2], s[2 * j + 1][qs][3]);
          pb[j][qs] = cv.v;
        }
      const u16* vbase = sV + buf * 64 * 144 + (4 * quad + (l15 >> 2)) * 144 + (l15 & 3) * 4;
      bf16x8 vf[2][4];
#define V_LOAD(DST, G) { _Pragma("unroll") for (int d = 0; d < 4; ++d) { const u16* a0 = vbase + (32 * ((G) >> 1)) * 144 + (((G) & 1) * 4 + d) * 16; \
        s16x4 lo = __builtin_amdgcn_ds_read_tr16_b64_v4i16((__attribute__((address_space(3))) s16x4*)(a0)); \
        s16x4 hi = __builtin_amdgcn_ds_read_tr16_b64_v4i16((__attribute__((address_space(3))) s16x4*)(a0 + 16 * 144)); \
        bf16x8 t; t[0] = lo[0]; t[1] = lo[1]; t[2] = lo[2]; t[3] = lo[3]; t[4] = hi[0]; t[5] = hi[1]; t[6] = hi[2]; t[7] = hi[3]; DST[d] = t; } }
      V_LOAD(vf[0], 0);
#pragma unroll
      for (int g = 0; g < 4; ++g) {
        if (g < 3) V_LOAD(vf[(g + 1) & 1], g + 1);
#pragma unroll
        for (int d = 0; d < 4; ++d) {
          const int dt = (g & 1) * 4 + d;
          o[0][dt] = __builtin_amdgcn_mfma_f32_16x16x32_bf16(vf[g & 1][d], pb[g >> 1][0], o[0][dt], 0, 0, 0);
          o[1][dt] = __builtin_amdgcn_mfma_f32_16x16x32_bf16(vf[g & 1][d], pb[g >> 1][1], o[1][dt], 0, 0, 0);
        }
        __builtin_amdgcn_sched_barrier(0);
      }
#undef V_LOAD
    }
  };
  {
    uint4 rv0[4];
    const u16 *kb_, *vb_; size_t rs_; int kp_;
    tilefn(0, kb_, vb_, rs_, kp_);
#pragma unroll
    for (int i = 0; i < 4; ++i) {
      rk[i] = ldg_o(kb_, (uint32_t)((lr + i * 16) * (int)rs_ + lc) * 2u);
      if (MODE != 1) rv0[i] = ldg_o(vb_, (uint32_t)((lr + i * 16) * (int)rs_ + lc) * 2u);
    }
    K_STORE(0);
    if (MODE != 1) {
#pragma unroll
      for (int i = 0; i < 4; ++i) *(uint4*)(sV + (lr + i * 16) * 144 + lc) = rv0[i];
    }
  }
  __syncthreads();
  for (int it = 0; it < ntiles; ++it) {
    const int buf = it & 1;
    const bool more = (it + 1 < ntiles);
    if (more) K_LOAD(it + 1);
    compute(buf, it, [&]() { if (more) { K_STORE(buf ^ 1); if (MODE != 1) V_LOAD_G(it + 1); } });
    if (more && MODE != 1) V_STORE(buf ^ 1);
    __syncthreads();
  }
#undef K_LOAD
#undef V_LOAD_G
#undef K_STORE
#undef V_STORE
}

__global__ void __launch_bounds__(256, 2) yoco_fwd(Params p) {
  cg::grid_group grid = cg::this_grid();
  __shared__ __attribute__((aligned(16))) u16 smem[40192];
  __shared__ uint4 xb_words;
  if (threadIdx.x == 0) xb_words = make_uint4(0u, 0u, 0u, 0u);
  __syncthreads();
  XcdBarrier xb = xcd_barrier_post((unsigned*)(p.ws + O_BAR), (volatile LAS unsigned*)&xb_words);
  char* ws = p.ws;
  u16* W_AIN = (u16*)(ws + O_WAIN);
  u16* W_GLU = (u16*)(ws + O_WGLU);
  u16* W_AOUT = (u16*)(ws + O_WAOUT);
  u16* W_KV = (u16*)(ws + O_WKV);
  u16* W_C1 = (u16*)(ws + O_WC1);
  u16* W_C2 = (u16*)(ws + O_WC2);
  u16* W_BIN = (u16*)(ws + O_WBIN);
  u16* W_BOUT = (u16*)(ws + O_WBOUT);
  u16* XB = (u16*)(ws + O_XB);
  float* XF = (float*)(ws + O_XF);
  u16* KV = (u16*)(ws + O_KV);
  float* T1P = (float*)(ws + O_T1);
  u16* KCVC = (u16*)(ws + O_KCVC);
  float* C1B = (float*)(ws + O_C1B);
  u16* YB = (u16*)(ws + O_YB);
  float2* STATS = (float2*)(ws + O_STATS);
  u16* UZ = (u16*)(ws + O_UZ);
  u16* GB = (u16*)(ws + O_G);
  u16* VB = (u16*)(ws + O_V);
  float* SB = (float*)(ws + O_S);
  u16* HIN = (u16*)(ws + O_HIN);
  u16* W1 = (u16*)(ws + O_W1);
  u16* W3T = (u16*)(ws + O_W3T);
  u16* KTAB = (u16*)(ws + O_KTAB);
  float2* A64 = (float2*)(ws + O_A64);
  u16* PROJ = (u16*)(ws + O_PROJ);

  float* tl = (float*)smem;
  auto do_jobs = [&](unsigned mask, int b0, int nb) {
      for (int job = 0; job < 15; ++job) {
        if (!((mask >> job) & 1u)) continue;

        const float* src; u16* dst; int K, N, Np;
        switch (job) {
          case 0: src = p.in[1]; dst = W_AIN; K = 2048; N = 2048; Np = 2048; break;
          case 1: src = p.in[1] + (size_t)2048 * 2048; dst = W_AIN + (size_t)2048 * 2048; K = 2048; N = 2048; Np = 2048; break;
          case 2: src = p.in[10]; dst = W_GLU; K = 1024; N = 1024; Np = 1024; break;
          case 3: src = p.in[10] + (size_t)1024 * 1024; dst = W_GLU + (size_t)1024 * 1024; K = 1024; N = 1024; Np = 1024; break;
          case 4: src = p.in[12]; dst = W_AOUT; K = 1024; N = 2048; Np = 2048; break;
          case 5: src = p.in[12] + (size_t)1024 * 2048; dst = W_AOUT + (size_t)2048 * 1024; K = 1024; N = 2048; Np = 2048; break;
          case 6: src = p.in[13]; dst = W_KV; K = 2048; N = 3072; Np = 3072; break;
          case 7: src = p.in[15]; dst = W_C1; K = 4096; N = 128; Np = 128; break;
          case 8: src = p.in[18]; dst = W_C1 + (size_t)128 * 4096; K = 4096; N = 128; Np = 128; break;
          case 9: src = p.in[16]; dst = W_C2; K = 128; N = 128; Np = 128; break;
          case 10: src = p.in[19]; dst = W_C2 + (size_t)128 * 128; K = 128; N = 128; Np = 128; break;
          case 11: src = p.in[20]; dst = W_BIN; K = 2048; N = BIN_N; Np = PROJ_LD; break;
          case 12: src = p.in[20] + (size_t)2048 * BIN_N; dst = W_BIN + (size_t)PROJ_LD * 2048; K = 2048; N = BIN_N; Np = PROJ_LD; break;
          case 13: src = p.in[21]; dst = W_BOUT; K = 2048; N = 2048; Np = 2048; break;
          default: src = p.in[21] + (size_t)2048 * 2048; dst = W_BOUT + (size_t)2048 * 2048; K = 2048; N = 2048; Np = 2048; break;
        }
        if ((int)blockIdx.x >= b0) tconv(tl, src, dst, K, N, Np, b0, nb);
      }
  };
  for (int rep0 = 0; rep0 < REPS_P0; ++rep0) {
    const int tid = tid_l(), lane = tid & 63, wave = tid >> 6; (void)lane; (void)wave;
    do_jobs((1u << 0) | (1u << 2) | (1u << 4) | (1u << 7) | (1u << 8) | (1u << 9) | (1u << 10), 0, (int)gridDim.x);
    {
      const float4* x4 = (const float4*)p.in[0];
      uint2* xb2 = (uint2*)XB;
      const size_t n4 = (size_t)NTOK * DM / 4;
      for (size_t i = (size_t)blockIdx.x * 256 + tid; i < n4; i += (size_t)gridDim.x * 256) {
        float4 v = x4[i];
        uint2 o; o.x = pack2(v.x, v.y); o.y = pack2(v.z, v.w);
        xb2[i] = o;
      }
    }
    {
      float* C1P = (float*)(ws + O_C1P);
      float* red = (float*)smem;
      for (int item = blockIdx.x; item < 64; item += gridDim.x) {
        const int kvs = item >> 5, part = item & 31;
        const float* pos = p.in[kvs ? 17 : 14];
        const float* w1 = p.in[kvs ? 18 : 15];
        const int j = tid & 127, half = tid >> 7;
        const int i0 = part * 128 + half * 64;
        float acc = 0.f;
#pragma unroll 16
        for (int i = 0; i < 64; ++i) acc += pos[i0 + i] * w1[(size_t)(i0 + i) * 128 + j];
        __syncthreads();
        red[tid] = acc;
        __syncthreads();
        if (tid < 128) C1P[(size_t)item * 128 + tid] = red[tid] + red[tid + 128];
        __syncthreads();
      }
    }
    {
      float2* sE = (float2*)smem;
      float2* sCo = sE + 64;
      float2* sM = sCo + 64;
      float2* sC = sM + 1024;
      float2* sBb = sC + 1024;
      const int nper = 4;
      for (int w = blockIdx.x; w < 128 * nper; w += gridDim.x) {
        const int lg = w / nper, j0 = w % nper;
        const float* lam_re = p.in[2] + (size_t)lg * 64;
        const float* lam_im = p.in[3] + (size_t)lg * 64;
        const float dt = __expf(p.in[4][lg]);
        const float* b_re = p.in[5] + (size_t)lg * 1024;
        const float* b_im = p.in[6] + (size_t)lg * 1024;
        const float* c_re = p.in[7] + (size_t)lg * 1024;
        const float* c_im = p.in[8] + (size_t)lg * 1024;
        __syncthreads();
#pragma unroll
        for (int i = 0; i < 4; ++i) sC[tid + i * 256] = make_float2(c_re[tid + i * 256], c_im[tid + i * 256]);
        float lr = 0.f, li = 0.f;
        if (tid < 64) {
          lr = lam_re[tid]; li = lam_im[tid];
          const float mag = expf(lr * dt);
          float sn, cs;
          sincosf(li * dt, &sn, &cs);
          const float ar = mag * cs, ai = mag * sn;
          const float inv = 1.f / (lr * lr + li * li);
          sCo[tid] = make_float2(((ar - 1.f) * lr + ai * li) * inv, (ai * lr - (ar - 1.f) * li) * inv);
        }
        __syncthreads();
#pragma unroll
        for (int i = 0; i < 4; ++i) {
          const int idx = tid + i * 256;
          const float br = b_re[idx], bi = b_im[idx];
          const float2 co = sCo[idx >> 4];
          sBb[idx] = make_float2(co.x * br - co.y * bi, co.x * bi + co.y * br);
        }
        for (int j = j0; j < 65; j += nper) {
          if (tid < 64) {
            const float fj = (float)j;
            const float mj = expf(lr * dt * fj);
            float sj, cj;
            if (j == 64) sincosf(li * dt * fj, &sj, &cj);
            else __sincosf(li * dt * fj, &sj, &cj);
            sE[tid] = make_float2(mj * cj, mj * sj);
            if (j == 64) A64[(size_t)lg * 64 + tid] = make_float2(mj * cj, mj * sj);
          }
          __syncthreads();
#pragma unroll
          for (int i = 0; i < 4; ++i) {
            const int idx = tid + i * 256;
            const int pp = idx >> 4, ci = idx & 15;
            const float2 bb = sBb[idx];
            const float2 e = sE[pp];
            const float mr = e.x * bb.x - e.y * bb.y, mi = e.x * bb.y + e.y * bb.x;
            sM[idx] = make_float2(mr, mi);
            if (j < 64) {
              const int s = 63 - j;
              u16* w1p = W1 + (size_t)lg * 128 * 1024;
              w1p[(size_t)pp * 1024 + s * 16 + ci] = f2bf(mr);
              w1p[(size_t)(64 + pp) * 1024 + s * 16 + ci] = f2bf(mi);
            }
          }
          __syncthreads();
          if (j < 64) {
            const int co = tid >> 4, ci = tid & 15;
            float acc = 0.f;
            for (int pp = 0; pp < 64; ++pp) {
              const float2 m = sM[pp * 16 + ci];
              const float2 c = sC[co * 64 + pp];
              acc += c.x * m.x - c.y * m.y;
            }
            KTAB[(((size_t)lg * 64 + j) * 16 + co) * 16 + ci] = f2bf(acc);
          }
          if (j >= 1) {
            const int t = j - 1;
            u16* w3p = W3T + (size_t)lg * 1024 * 128;
#pragma unroll
            for (int i = 0; i < 4; ++i) {
              const int idx = tid + i * 256;
              const int co = idx >> 6, pp = idx & 63;
              const float cr = sC[idx].x, ci = sC[idx].y;
              const float2 e = sE[pp];
              const float re = cr * e.x - ci * e.y, im = cr * e.y + ci * e.x;
              w3p[(size_t)(t * 16 + co) * 128 + pp] = f2bf(re);
              w3p[(size_t)(t * 16 + co) * 128 + 64 + pp] = f2bf(-im);
            }
          }
          __syncthreads();
        }
      }
    }
  }
  grid.sync();

  auto kmap64 = [](int ks) { return ks * 64; };

  for (int l = 0; l < 2; ++l) {
    const float* xres = (l == 0) ? p.in[0] : XF;
    {
      const int tid = tid_l(), lane = tid & 63, wave = tid >> 6; (void)lane; (void)wave;
      if (l == 0 && blockIdx.x == 0) {
        const float* C1P = (const float*)(ws + O_C1P);
        float a = 0.f;
        for (int part = 0; part < 32; ++part) a += C1P[((size_t)(tid >> 7) * 32 + part) * 128 + (tid & 127)];
        C1B[tid] = a;
      }
      const u16* Wt = W_AIN + (size_t)l * 2048 * 2048;
      for (int tile = blockIdx.x; tile < 64 * 8; tile += gridDim.x) {
        const int mt = tile & 63, nt = tile >> 6;
        gemm_tile_w(smem, mt * 128, nt * 256, 64,
                  [=](int m, int k0, int kc) { return ldg_o(XB + k0, (uint32_t)(m * 2048 + kc) * 2u); },
                  [=](int n, int k0, int kc) { return ldg_o(Wt + k0, (uint32_t)(n * 2048 + kc) * 2u); },
                  [=](int m, int n, f32x4 v) { st_bf4(UZ + (size_t)m * 2048 + n, v); });
      }
    }
    xcd_barrier(xb);
    {
      float* sS = (float*)smem;
      if (l == 0) do_jobs((1u << 1) | (1u << 3) | (1u << 5) | (1u << 6) | (1u << 11), 64, (int)gridDim.x - 64);
      else do_jobs((1u << 12) | (1u << 13) | (1u << 14), 64, (int)gridDim.x - 64);
      for (int g = blockIdx.x; g < 64; g += gridDim.x) {
        const u16* w1p = W1 + ((size_t)l * 64 + g) * 128 * 1024;
        gemm_tile<1, false>(smem, 0, 0, 16, kmap64,
                  [=](int m, int k0, int kc) { return ldg_o(UZ + (size_t)(k0 >> 4) * 2048 + g * 16, (uint32_t)((m * 64 + (kc >> 4)) * 2048 + (kc & 15)) * 2u); },
                  [=](int n, int k0, int kc) { return ldg_o(w1p + k0, (uint32_t)(n * 1024 + kc) * 2u); },
                  [=](int m, int n, f32x4 v) { *(f32x4*)(sS + m * 132 + n) = v; });
        __syncthreads();
        const int tid = tid_l();
        if (tid < 128) {
          const int b = tid >> 6, pp = tid & 63;
          const float2 a = A64[((size_t)l * 64 + g) * 64 + pp];
          float hr = 0.f, hi = 0.f;
          const float* sp = sS + (b * 64) * 132;
          u16* hp = HIN + ((size_t)g * 128 + b * 64) * 128;
#pragma unroll 4
          for (int c = 0; c < 64; ++c) {
            hp[c * 128 + pp] = f2bf(hr);
            hp[c * 128 + 64 + pp] = f2bf(hi);
            const float sr = sp[c * 132 + pp], si = sp[c * 132 + 64 + pp];
            const float nr = a.x * hr - a.y * hi + sr;
            const float ni = a.x * hi + a.y * hr + si;
            hr = nr; hi = ni;
          }
        }
        __syncthreads();
      }
    }
    xcd_barrier(xb);
    {
      const float* dsk = p.in[9] + (size_t)l * 1024;
      for (int tile = blockIdx.x; tile < 64 * 8; tile += gridDim.x) {
        const int g = tile >> 3, nt = (tile < 256) ? 7 - (tile & 7) : (tile & 7);
        const int nks1 = 2 * nt + 2;
        const u16* ktab = KTAB + ((size_t)l * 64 + g) * 64 * 256;
        const u16* w3p = W3T + ((size_t)l * 64 + g) * 1024 * 128;
        const u16* hp = HIN + (size_t)g * 128 * 128;
        gemm_tile(smem, 0, nt * 128, nks1 + 2,
                  [=](int ks) { return ks < nks1 ? ks * 64 : 1024 + (ks - nks1) * 64; },
                  [=](int m, int k0, int kc) {
                    if (k0 < 1024) return ldg_o(UZ + (size_t)(k0 >> 4) * 2048 + g * 16, (uint32_t)((m * 64 + (kc >> 4)) * 2048 + (kc & 15)) * 2u);
                    return ldg_o(hp + (k0 - 1024), (uint32_t)(m * 128 + kc) * 2u);
                  },
                  [=](int n, int k0, int kc) {
                    if (k0 < 1024) {
                      const int lag = (n >> 4) - (kc >> 4) - (k0 >> 4);
                      if (lag < 0) return make_uint4(0u, 0u, 0u, 0u);
                      return ldg_o(ktab, (uint32_t)((lag * 16 + (n & 15)) * 16 + (kc & 15)) * 2u);
                    }
                    return ldg_o(w3p + (k0 - 1024), (uint32_t)(n * 128 + kc) * 2u);
                  },
                  [=](int m, int n, f32x4 v) {
                    const int t = n >> 4, co = n & 15;
                    const size_t tok = (size_t)m * 64 + t;
                    const int ch = g * 16 + co;
                    const f32x4 u = ld_bf4(UZ + tok * 2048 + ch);
                    const f32x4 d = *(const f32x4*)(dsk + ch);
                    f32x4 r;
#pragma unroll
                    for (int i = 0; i < 4; ++i) r[i] = gelu_tanh(v[i] + d[i] * u[i]);
                    st_bf4(GB + tok * 1024 + ch, r);
                  });
      }
    }
    xcd_barrier(xb);
    {
      const u16* Wt = W_GLU + (size_t)l * 1024 * 1024;
      const float* bg = p.in[11] + (size_t)l * 1024;
      for (int tile = blockIdx.x; tile < 64 * 8; tile += gridDim.x) {
        const int mt = tile & 63, nt = tile >> 6;
        gemm_tile(smem, mt * 128, nt * 128, 16, kmap64,
                  [=](int m, int k0, int kc) { return ldg_o(GB + k0, (uint32_t)(m * 1024 + kc) * 2u); },
                  [=](int n, int k0, int kc) { return ldg_o(Wt + k0, (uint32_t)(n * 1024 + kc) * 2u); },
                  [=](int m, int n, f32x4 v) {
                    const f32x4 gg = ld_bf4(GB + (size_t)m * 1024 + n);
                    const f32x4 zz = ld_bf4(UZ + (size_t)m * 2048 + 1024 + n);
                    const f32x4 bb = *(const f32x4*)(bg + n);
                    f32x4 r;
#pragma unroll
                    for (int i = 0; i < 4; ++i) r[i] = gg[i] * sigm(v[i] + bb[i]) * silu(zz[i]);
                    st_bf4(VB + (size_t)m * 1024 + n, r);
                  });
      }
    }
    xcd_barrier(xb);
    {
      const u16* Wt = W_AOUT + (size_t)l * 2048 * 1024;
      for (int tile = blockIdx.x; tile < 64 * 8; tile += gridDim.x) {
        const int mt = tile & 63, nt = tile >> 6;
        const float2* stp = STATS;
        const float* pgam = p.in[22] + (size_t)(l > 0 ? l - 1 : 0) * 2048;
        const float* pbet = p.in[23] + (size_t)(l > 0 ? l - 1 : 0) * 2048;
        gemm_tile_w<true>(smem, mt * 128, nt * 256, 32,
                  [=](int m, int k0, int kc) { return ldg_o(VB + k0, (uint32_t)(m * 1024 + kc) * 2u); },
                  [=](int n, int k0, int kc) { return ldg_o(Wt + k0, (uint32_t)(n * 1024 + kc) * 2u); },
                  [=](int m, int n, f32x4 v, f32x4 xr) {
                    if (l > 0) {
                      const float2 st = stp[m];
                      const f32x4 gg = *(const f32x4*)(pgam + n);
                      const f32x4 bb = *(const f32x4*)(pbet + n);
#pragma unroll
                      for (int i = 0; i < 4; ++i) xr[i] = (xr[i] - st.x) * st.y * gg[i] + bb[i];
                    }
                    f32x4 r;
#pragma unroll
                    for (int i = 0; i < 4; ++i) r[i] = DN_ALPHA * xr[i] + v[i];
                    *(f32x4*)((char*)XF + (uint32_t)(m * 2048 + n) * 4u) = r;
                  },
                  [=](int m, int n) { return *(const f32x4*)((const char*)xres + (uint32_t)(m * 2048 + n) * 4u); });
      }
    }
    xcd_barrier(xb);
    {
      const int tid = tid_l(), lane = tid & 63, wave = tid >> 6; (void)lane; (void)wave;
      const float* lg_ = p.in[22] + (size_t)l * 2048;
      const float* lb_ = p.in[23] + (size_t)l * 2048;
      for (int row = blockIdx.x * 4 + wave; row < NTOK; row += gridDim.x * 4) {
        float* xr = XF + (size_t)row * 2048;
        f32x4 v[8];
        float sum = 0.f;
#pragma unroll
        for (int i = 0; i < 8; ++i) { v[i] = *(const f32x4*)(xr + i * 256 + lane * 4); sum += v[i][0] + v[i][1] + v[i][2] + v[i][3]; }
#pragma unroll
        for (int o = 32; o >= 1; o >>= 1) sum += __shfl_xor(sum, o);
        const float mu = sum * (1.f / 2048.f);
        float sq = 0.f;
#pragma unroll
        for (int i = 0; i < 8; ++i)
#pragma unroll
          for (int e = 0; e < 4; ++e) { const float d = v[i][e] - mu; sq += d * d; }
#pragma unroll
        for (int o = 32; o >= 1; o >>= 1) sq += __shfl_xor(sq, o);
        const float rstd = rsqrtf(sq * (1.f / 2048.f) + LN_EPS);
#pragma unroll
        for (int i = 0; i < 8; ++i) {
          const int c = i * 256 + lane * 4;
          const f32x4 gg = *(const f32x4*)(lg_ + c);
          const f32x4 bb = *(const f32x4*)(lb_ + c);
          f32x4 r;
#pragma unroll
          for (int e = 0; e < 4; ++e) r[e] = (v[i][e] - mu) * rstd * gg[e] + bb[e];
          st_bf4(XB + (size_t)row * 2048 + c, r);
        }
        if (lane == 0) STATS[row] = make_float2(mu, rstd);
      }
    }
    xcd_barrier(xb);
  }

  {
    for (int tile = blockIdx.x; tile < 64 * 24; tile += gridDim.x) {
      const int mt = tile & 63, nt = tile >> 6;
      gemm_tile(smem, mt * 128, nt * 128, 32, kmap64,
                [=](int m, int k0, int kc) { return ldg_o(XB + k0, (uint32_t)(m * 2048 + kc) * 2u); },
                [=](int n, int k0, int kc) { return ldg_o(W_KV + k0, (uint32_t)(n * 2048 + kc) * 2u); },
                [=](int m, int n, f32x4 v) { st_bf4(KV + (size_t)m * KV_LD + n, v); });
    }
  }
  xcd_barrier(xb);
  for (int lb = 0; lb < 2; ++lb) {
    const int layer = 2 + lb;
    {
      const u16* Wt = W_BIN + (size_t)lb * PROJ_LD * 2048;
      if (lb == 0 && blockIdx.x >= 64 && blockIdx.x < 128) {
        const int ct = blockIdx.x - 64;
        const int half = ct >> 5, kvs = (ct >> 4) & 1, mt = ct & 15;
        const u16* Wc = W_C1 + (size_t)kvs * 128 * 4096;
        float* t1 = T1P + ((size_t)(half * 2 + kvs)) * 2048 * 128;
        gemm_tile<1>(smem, mt * 128, 0, 32, [=](int ks) { return half * 2048 + ks * 64; },
                  [=](int m, int k0, int kc) {
                    const int b = m >> 10, n = (m >> 2) & 255, g = m & 3;
                    int tok = n * 16 + (k0 >> 7);
                    tok = tok > 4095 ? 4095 : tok;
                    return ldg_o(KV + kvs * 512 + (k0 & 127), (uint32_t)((b * 4096 + tok) * KV_LD + g * 128 + kc) * 2u);
                  },
                  [=](int n, int k0, int kc) { return ldg_o(Wc + k0, (uint32_t)(n * 4096 + kc) * 2u); },
                  [=](int m, int n, f32x4 v) { *(f32x4*)(t1 + (size_t)m * 128 + n) = v; });
      }
      for (int rep = 0; rep < REPS_BIN; ++rep)
      for (int tile = blockIdx.x; tile < 64 * 32; tile += gridDim.x) {
        const int mt = tile & 63, nt = tile >> 6;
        gemm_tile_w(smem, mt * 128, nt * 256, 64,
                  [=](int m, int k0, int kc) { return ldg_o(XB + k0, (uint32_t)(m * 2048 + kc) * 2u); },
                  [=](int n, int k0, int kc) { return ldg_o(Wt + k0, (uint32_t)(n * 2048 + kc) * 2u); },
                  [=](int m, int n, f32x4 v) { st_bf4(PROJ + (size_t)m * PROJ_LD + n, v); });
      }
      for (int tile = blockIdx.x; tile < 64; tile += gridDim.x) {
        const int mt = tile & 63, nt = 64;
        gemm_tile(smem, mt * 128, nt * 128, 32, kmap64,
                  [=](int m, int k0, int kc) { return ldg_o(XB + k0, (uint32_t)(m * 2048 + kc) * 2u); },
                  [=](int n, int k0, int kc) { return ldg_o(Wt + k0, (uint32_t)(n * 2048 + kc) * 2u); },
                  [=](int m, int n, f32x4 v) { st_bf4(PROJ + (size_t)m * PROJ_LD + n, v); });
      }
    }
    xcd_barrier(xb);
    if (lb == 0) {
      for (int tile = blockIdx.x; tile < 32; tile += gridDim.x) {
        const int kvs = tile >> 4, mt = tile & 15;
        const u16* Wt = W_C2 + (size_t)kvs * 128 * 128;
        const float* t1a = T1P + ((size_t)kvs) * 2048 * 128;
        const float* t1b = T1P + ((size_t)(2 + kvs)) * 2048 * 128;
        const float* cb = C1B + kvs * 128;
        u16* kc_ = KCVC + (size_t)kvs * 2048 * 128;
        gemm_tile<1>(smem, mt * 128, 0, 2, kmap64,
                  [=](int m, int k0, int kc) {
                    const int k = k0 + kc;
                    const f32x4 a0 = *(const f32x4*)(t1a + (size_t)m * 128 + k), a1 = *(const f32x4*)(t1a + (size_t)m * 128 + k + 4);
                    const f32x4 b0 = *(const f32x4*)(t1b + (size_t)m * 128 + k), b1 = *(const f32x4*)(t1b + (size_t)m * 128 + k + 4);
                    const f32x4 c0 = *(const f32x4*)(cb + k), c1 = *(const f32x4*)(cb + k + 4);
                    uint4 r;
                    r.x = pack2(gelu_tanh(a0[0] + b0[0] + c0[0]), gelu_tanh(a0[1] + b0[1] + c0[1]));
                    r.y = pack2(gelu_tanh(a0[2] + b0[2] + c0[2]), gelu_tanh(a0[3] + b0[3] + c0[3]));
                    r.z = pack2(gelu_tanh(a1[0] + b1[0] + c1[0]), gelu_tanh(a1[1] + b1[1] + c1[1]));
                    r.w = pack2(gelu_tanh(a1[2] + b1[2] + c1[2]), gelu_tanh(a1[3] + b1[3] + c1[3]));
                    return r;
                  },
                  [=](int n, int k0, int kc) { return ldg_o(Wt + k0, (uint32_t)(n * 128 + kc) * 2u); },
                  [=](int m, int n, f32x4 v) {
                    if (((m >> 2) & 255) == 255) v = f32x4{0.f, 0.f, 0.f, 0.f};
                    st_bf4(kc_ + (size_t)m * 128 + n, v);
                  });
      }
      xcd_barrier(xb);
    }
#ifndef NO_ATTN
    {
      u16* sK = smem;
      u16* sV = smem + 2 * 64 * 136;
      uint32_t* imp = (uint32_t*)(smem + 2 * 64 * 136 + 2 * 64 * 144);
      unsigned long long* selm = (unsigned long long*)(imp + 32 * 65);
      const int tid = tid_l(), lane = tid & 63, wave = tid >> 6;
      const int l15 = lane & 15, quad = lane >> 4;
      const u16* KC = KCVC;
      const u16* VC = KCVC + (size_t)2048 * 128;
      for (int rep = 0; rep < REPS_ATTN; ++rep)
      for (int item = blockIdx.x; item < 1024; item += gridDim.x) {
        const int qt = (item < 512) ? (127 - (item >> 3)) : ((item - 512) >> 3);
        const int bg = item & 7, b = bg >> 2, g = bg & 3;
        const int t0 = qt * 32, h = g * 4 + wave;
        const size_t tokbase = (size_t)b * SEQ;
        const int cur = t0 >> 6;
        if (DESYNC_COND) __builtin_amdgcn_s_sleep(60);
        for (int i = tid; i < 32 * 65; i += 256) imp[i] = 0u;
        bf16x8 qf[2][4];
#pragma unroll
        for (int qs = 0; qs < 2; ++qs)
#pragma unroll
          for (int ds = 0; ds < 4; ++ds) {
            uint4 v = ldg16(PROJ + (tokbase + t0 + qs * 16 + l15) * PROJ_LD + h * 128 + ds * 32 + quad * 8);
            union { uint4 u; bf16x8 v; } cv; cv.u = v; qf[qs][ds] = cv.v;
          }
        const int tq0 = t0 + l15, tq1 = t0 + 16 + l15;
        f32x4 o[2][8];
        float mrow[2], lrow[2], linv[2];
        auto zero_o = [&]() {
#pragma unroll
          for (int qs = 0; qs < 2; ++qs)
#pragma unroll
            for (int dt = 0; dt < 8; ++dt) o[qs][dt] = f32x4{0.f, 0.f, 0.f, 0.f};
        };
        auto finish_l = [&]() {
#pragma unroll
          for (int qs = 0; qs < 2; ++qs) {
            float lsum = lrow[qs];
            lsum += __shfl_xor(lsum, 16);
            lsum += __shfl_xor(lsum, 32);
            linv[qs] = 1.f / fmaxf(lsum, 1e-30f);
          }
        };
        auto emit = [&](int br, bool first, bool scale_l) {
          float* wbuf = (float*)smem + wave * (16 * 132);
          const int rrow = lane >> 5, rcol = (lane & 31) * 4;
          const int tb = (int)tokbase + t0;
          const uint32_t zoff0 = (uint32_t)((tb + rrow) * PROJ_LD + 2048 + br * 2048 + h * 128 + rcol) * 2u;
          const uint32_t yoff0 = (uint32_t)((tb + rrow) * 2048 + h * 128 + rcol) * 2u;
          const u16 graw0 = *(const u16*)((const char*)PROJ + (uint32_t)((tb + l15) * PROJ_LD + 8192 + br * 16 + h) * 2u);
          const u16 graw1 = *(const u16*)((const char*)PROJ + (uint32_t)((tb + 16 + l15) * PROJ_LD + 8192 + br * 16 + h) * 2u);
#pragma unroll
          for (int qs = 0; qs < 2; ++qs) {
            const float gate = sigm(bf2f(qs ? graw1 : graw0));
            const float sc = scale_l ? gate * linv[qs] : gate;
#pragma unroll
            for (int dt = 0; dt < 8; ++dt) *(f32x4*)(wbuf + l15 * 132 + dt * 16 + quad * 4) = o[qs][dt] * sc;
            __builtin_amdgcn_wave_barrier();
#pragma unroll 4
            for (int j = 0; j < 8; ++j) {
              const uint32_t zo = zoff0 + (uint32_t)((qs * 16 + j * 2) * PROJ_LD) * 2u;
              const uint32_t yo = yoff0 + (uint32_t)((qs * 16 + j * 2) * 2048) * 2u;
              const f32x4 a = *(const f32x4*)(wbuf + (j * 2 + rrow) * 132 + rcol);
              const f32x4 zz = ld_bf4((const u16*)((const char*)PROJ + zo));
              u16* yp = (u16*)((char*)YB + yo);
              f32x4 r;
#pragma unroll
              for (int e = 0; e < 4; ++e) r[e] = a[e] * silu(zz[e]);
              if (!first) {
                const f32x4 old = ld_bf4(yp);
#pragma unroll
                for (int e = 0; e < 4; ++e) r[e] += old[e];
              }
              st_bf4(yp, r);
            }
          }
          __syncthreads();
        };
#ifndef NO_CMP
        {
          int nmax = t0 >> 4; if (nmax > 254) nmax = 254;
          const int ntl = (nmax >> 6) + 1;
          auto tilefn = [&](int i, const u16*& kb, const u16*& vb, size_t& rs, int& kp) {
            const size_t off = (((size_t)b * 256 + i * 64) * 4 + g) * 128;
            kb = KC + off; vb = VC + off; rs = 512; kp = i * 64;
          };
          auto valid = [&](int kpos, int qs) { return kpos * 16 + 31 <= (qs ? tq1 : tq0); };
          mrow[0] = mrow[1] = -1e30f; lrow[0] = lrow[1] = 0.f; linv[0] = linv[1] = 1.f;
          auto nobias = [](int, int) { return 0.f; };
          auto allem = [](int) { return true; };
          attn_loop<1>(sK, sV, imp, ntl, tilefn, nobias, allem, valid, qf, o, mrow, lrow, linv);
          finish_l();
          zero_o();
          attn_loop<2>(sK, sV, imp, ntl, tilefn, nobias, allem, valid, qf, o, mrow, lrow, linv);
          emit(0, true, false);
        }
#endif
        {
#pragma unroll 1
          for (int tt = 0; tt < 8; ++tt) {
            const int tok = wave * 8 + tt;
            unsigned long long mask;
            if (cur < 16) {
              mask = (2ull << cur) - 1ull;
            } else {
              const uint32_t v = imp[tok * 65 + lane];
              const bool cand = (lane >= 1) && (lane <= cur - 2);
              const unsigned long long cm = __ballot(cand);
              uint32_t T = 0u;
#pragma unroll 1
              for (int bit = 30; bit >= 0; --bit) {
                const uint32_t tr = T | (1u << bit);
                const unsigned long long m = __ballot(v >= tr) & cm;
                if (__popcll(m) >= 13) T = tr;
              }
              const unsigned long long gt = __ballot(v > T) & cm;
              unsigned long long eq = __ballot(v == T) & cm;
              int need = 13 - (int)__popcll(gt);
              unsigned long long pick = 0ull;
              while (need > 0 && eq != 0ull) {
                const unsigned long long low = eq & (0ull - eq);
                pick |= low; eq ^= low; --need;
              }
              mask = gt | pick | 1ull | (1ull << cur) | (1ull << (cur - 1));
            }
            if (lane == 0) selm[tok] = mask;
          }
          __syncthreads();
        }
        const unsigned long long sm0 = selm[l15], sm1 = selm[16 + l15];
#ifndef NO_SEL
        {
          auto tilefn = [&](int i, const u16*& kb, const u16*& vb, size_t& rs, int& kp) {
            const size_t off = (tokbase + (size_t)i * 64) * KV_LD + 1024 + g * 128;
            kb = KV + off; vb = KV + off + 512; rs = KV_LD; kp = i * 64;
          };
          auto valid = [&](int kpos, int qs) { return kpos <= (qs ? tq1 : tq0); };
          auto biasfn = [&](int i, int qs) { return (((qs ? sm1 : sm0) >> i) & 1ull) ? 0.f : -1e30f; };
          auto emfn = [&](int i) { return i == cur; };
          mrow[0] = mrow[1] = -1e30f; lrow[0] = lrow[1] = 0.f;
          zero_o();
          attn_loop<0>(sK, sV, imp, cur + 1, tilefn, biasfn, emfn, valid, qf, o, mrow, lrow, linv);
          finish_l();
          emit(1, false, true);
        }
#endif
#ifndef NO_WIN
        {
          int jt0 = (t0 - 511) >> 6; if (jt0 < 0) jt0 = 0;
          auto tilefn = [&](int i, const u16*& kb, const u16*& vb, size_t& rs, int& kp) {
            const size_t off = (tokbase + (size_t)(jt0 + i) * 64) * KV_LD + 2048 + g * 128;
            kb = KV + off; vb = KV + off + 512; rs = KV_LD; kp = (jt0 + i) * 64;
          };
          auto valid = [&](int kpos, int qs) {
            const int t = qs ? tq1 : tq0;
            return (kpos <= t) && (kpos > t - 512);
          };
          auto biasfn = [](int, int) { return 0.f; };
          auto emfn = [&](int i) { const int kp = (jt0 + i) * 64; return !((kp + 63 <= t0) && (kp > t0 + 31 - 512)); };
          mrow[0] = mrow[1] = -1e30f; lrow[0] = lrow[1] = 0.f;
          zero_o();
          attn_loop<0>(sK, sV, imp, cur - jt0 + 1, tilefn, biasfn, emfn, valid, qf, o, mrow, lrow, linv);
          finish_l();
          emit(2, false, true);
        }
#endif
        __syncthreads();
      }
    }
#endif
    xcd_barrier(xb);
    {
      const u16* Wt = W_BOUT + (size_t)lb * 2048 * 2048;
      for (int tile = blockIdx.x; tile < 64 * 8; tile += gridDim.x) {
        const int mt = tile & 63, nt = tile >> 6;
        const float2* stp = STATS;
        const float* pgam = p.in[22] + (size_t)(layer - 1) * 2048;
        const float* pbet = p.in[23] + (size_t)(layer - 1) * 2048;
        gemm_tile_w<true>(smem, mt * 128, nt * 256, 64,
                  [=](int m, int k0, int kc) { return ldg_o(YB + k0, (uint32_t)(m * 2048 + kc) * 2u); },
                  [=](int n, int k0, int kc) { return ldg_o(Wt + k0, (uint32_t)(n * 2048 + kc) * 2u); },
                  [=](int m, int n, f32x4 v, f32x4 xr) {
                    const float2 st = stp[m];
                    const f32x4 gg = *(const f32x4*)(pgam + n);
                    const f32x4 bb = *(const f32x4*)(pbet + n);
                    f32x4 r;
#pragma unroll
                    for (int i = 0; i < 4; ++i) r[i] = DN_ALPHA * ((xr[i] - st.x) * st.y * gg[i] + bb[i]) + v[i];
                    *(f32x4*)((char*)XF + (uint32_t)(m * 2048 + n) * 4u) = r;
                  },
                  [=](int m, int n) { return *(const f32x4*)((const char*)XF + (uint32_t)(m * 2048 + n) * 4u); });
      }
    }
    xcd_barrier(xb);
    {
      const int tid = tid_l(), lane = tid & 63, wave = tid >> 6; (void)lane; (void)wave;
      const float* lg_ = p.in[22] + (size_t)layer * 2048;
      const float* lb_ = p.in[23] + (size_t)layer * 2048;
      const bool last = (lb == 1);
      for (int row = blockIdx.x * 4 + wave; row < NTOK; row += gridDim.x * 4) {
        float* xr = XF + (size_t)row * 2048;
        float* orow = last ? (p.out + (size_t)row * 2048) : xr;
        f32x4 v[8];
        float sum = 0.f;
#pragma unroll
        for (int i = 0; i < 8; ++i) { v[i] = *(const f32x4*)(xr + i * 256 + lane * 4); sum += v[i][0] + v[i][1] + v[i][2] + v[i][3]; }
#pragma unroll
        for (int o = 32; o >= 1; o >>= 1) sum += __shfl_xor(sum, o);
        const float mu = sum * (1.f / 2048.f);
        float sq = 0.f;
#pragma unroll
        for (int i = 0; i < 8; ++i)
#pragma unroll
          for (int e = 0; e < 4; ++e) { const float d = v[i][e] - mu; sq += d * d; }
#pragma unroll
        for (int o = 32; o >= 1; o >>= 1) sq += __shfl_xor(sq, o);
        const float rstd = rsqrtf(sq * (1.f / 2048.f) + LN_EPS);
#pragma unroll
        for (int i = 0; i < 8; ++i) {
          const int c = i * 256 + lane * 4;
          const f32x4 gg = *(const f32x4*)(lg_ + c);
          const f32x4 bb = *(const f32x4*)(lb_ + c);
          f32x4 r;
#pragma unroll
          for (int e = 0; e < 4; ++e) r[e] = (v[i][e] - mu) * rstd * gg[e] + bb[e];
          if (last) *(f32x4*)(orow + c) = r;
          else st_bf4(XB + (size_t)row * 2048 + c, r);
        }
        if (!last && lane == 0) STATS[row] = make_float2(mu, rstd);
      }
    }
    if (lb == 0) xcd_barrier(xb);
  }
}

extern "C" void kernel_launch(void* const* d_in, const int* in_sizes, int n_in, void* d_out, int out_size, void* d_ws,
                              size_t ws_size, hipStream_t stream) {
  static int grid_blocks = 0;
  if (!grid_blocks) {
    int dev = 0, cus = 0, per_cu = 0;
    hipGetDevice(&dev);
    hipDeviceGetAttribute(&cus, hipDeviceAttributeMultiprocessorCount, dev);
    hipOccupancyMaxActiveBlocksPerMultiprocessor(&per_cu, yoco_fwd, 256, 0);
    if (per_cu > 2) per_cu = 2;
    if (per_cu < 1) per_cu = 1;
    grid_blocks = cus * per_cu;
  }
  Params p{};
  for (int i = 0; i < 24; ++i) p.in[i] = (const float*)d_in[i];
  p.out = (float*)d_out;
  p.ws = (char*)d_ws;
  if (ws_size < WS_TOTAL) fprintf(stderr, "workspace too small: %zu < %zu\n", ws_size, (size_t)WS_TOTAL);
  (void)hipMemsetAsync((char*)d_ws + O_BAR, 0, XCD_BAR_WORDS * 4, stream);
  void* args[] = {&p};
  hipError_t e = hipLaunchCooperativeKernel((void*)yoco_fwd, dim3(grid_blocks), dim3(256), args, 0, stream);
  if (e != hipSuccess) fprintf(stderr, "cooperative launch failed: %s (grid %d)\n", hipGetErrorString(e), grid_blocks);
}
```

```cpp
#include <hip/hip_runtime.h>
#include <hip/hip_cooperative_groups.h>
#include <stdint.h>
#include <stdio.h>
namespace cg = cooperative_groups;

typedef __attribute__((ext_vector_type(8))) short bf16x8;
typedef __attribute__((ext_vector_type(4))) short s16x4;
typedef __attribute__((ext_vector_type(4))) float f32x4;
typedef unsigned short u16;
#define DI __device__ __forceinline__

#define DESYNC_COND (blockIdx.x >= 256)
#ifndef ATT_SAFE
#define ATT_SAFE 0
#endif
#ifndef REPS_ATTN
#define REPS_ATTN 1
#endif
#ifndef REPS_BIN
#define REPS_BIN 1
#endif
#ifndef REPS_SSM
#define REPS_SSM 1
#endif
#ifndef REPS_P0
#define REPS_P0 1
#endif
constexpr int NTOK = 8192, DM = 2048, SEQ = 4096, EW = 1024;
constexpr int PROJ_LD = 8320, BIN_N = 8240, KV_LD = 3072;
constexpr float DN_ALPHA = 1.681792830507429f;
constexpr float LN_EPS = 1e-5f;
constexpr float SCALE2 = 0.08838834764831845f * 1.4426950408889634f;

constexpr size_t al256(size_t x) { return (x + 255) & ~(size_t)255; }
constexpr size_t O_WAIN = 0;
constexpr size_t O_WGLU = O_WAIN + al256((size_t)2 * 2048 * 2048 * 2);
constexpr size_t O_WAOUT = O_WGLU + al256((size_t)2 * 1024 * 1024 * 2);
constexpr size_t O_WKV = O_WAOUT + al256((size_t)2 * 2048 * 1024 * 2);
constexpr size_t O_WC1 = O_WKV + al256((size_t)3072 * 2048 * 2);
constexpr size_t O_WC2 = O_WC1 + al256((size_t)2 * 128 * 4096 * 2);
constexpr size_t O_WBIN = O_WC2 + al256((size_t)2 * 128 * 128 * 2);
constexpr size_t O_WBOUT = O_WBIN + al256((size_t)2 * PROJ_LD * 2048 * 2);
constexpr size_t O_XB = O_WBOUT + al256((size_t)2 * 2048 * 2048 * 2);
constexpr size_t O_XF = O_XB + al256((size_t)NTOK * DM * 2);
constexpr size_t O_KV = O_XF + al256((size_t)NTOK * DM * 4);
constexpr size_t O_T1 = O_KV + al256((size_t)NTOK * KV_LD * 2);
constexpr size_t O_KCVC = O_T1 + al256((size_t)2 * 2 * 2048 * 128 * 4);
constexpr size_t O_C1B = O_KCVC + al256((size_t)2 * 2048 * 128 * 2);
constexpr size_t O_C1P = O_C1B + al256((size_t)2 * 128 * 4);
constexpr size_t O_BAR = O_C1P + al256((size_t)64 * 128 * 4);
constexpr size_t O_STATS = O_BAR + al256((size_t)4096 * 4);
constexpr size_t O_YB = O_STATS + al256((size_t)NTOK * 8);
constexpr size_t O_UNION = O_YB + al256((size_t)NTOK * DM * 2);
constexpr size_t O_UZ = O_UNION;
constexpr size_t O_G = O_UZ + al256((size_t)NTOK * 2048 * 2);
constexpr size_t O_V = O_G + al256((size_t)NTOK * 1024 * 2);
constexpr size_t O_S = O_V + al256((size_t)NTOK * 1024 * 2);
constexpr size_t O_HIN = O_S + al256((size_t)64 * 128 * 128 * 4);
constexpr size_t O_W1 = O_HIN + al256((size_t)64 * 128 * 128 * 2);
constexpr size_t O_W3T = O_W1 + al256((size_t)2 * 64 * 128 * 1024 * 2);
constexpr size_t O_KTAB = O_W3T + al256((size_t)2 * 64 * 1024 * 128 * 2);
constexpr size_t O_A64 = O_KTAB + al256((size_t)2 * 64 * 64 * 256 * 2);
constexpr size_t O_S5END = O_A64 + al256((size_t)2 * 64 * 64 * 8);
constexpr size_t O_PROJ = O_UNION;
constexpr size_t O_PROJEND = O_PROJ + al256((size_t)NTOK * PROJ_LD * 2);
constexpr size_t WS_TOTAL = (O_S5END > O_PROJEND ? O_S5END : O_PROJEND);

struct Params {
  const float* in[24];
  float* out;
  char* ws;
};

DI u16 f2bf(float f) { uint32_t u = __float_as_uint(f); u += 0x7fffu + ((u >> 16) & 1u); return (u16)(u >> 16); }
typedef float f32x2_t __attribute__((ext_vector_type(2)));
typedef __bf16 bf16x2_t __attribute__((ext_vector_type(2)));
DI uint32_t pack2(float a, float b) { f32x2_t v = {a, b}; bf16x2_t h = __builtin_convertvector(v, bf16x2_t); return __builtin_bit_cast(uint32_t, h); }
DI float bflo(uint32_t v) { return __uint_as_float(v << 16); }
DI float bfhi(uint32_t v) { return __uint_as_float(v & 0xffff0000u); }
DI float bf2f(u16 h) { return __uint_as_float(((uint32_t)h) << 16); }
DI uint4 ldg16(const void* p) { return *(const uint4*)p; }
DI uint4 ldg_o(const void* base, uint32_t byte_off) { return *(const uint4*)((const char*)base + byte_off); }
DI float sigm(float x) { return __builtin_amdgcn_rcpf(1.f + __expf(-x)); }
DI float silu(float x) { return x * sigm(x); }
DI float gelu_tanh(float x) { float u = 0.7978845608028654f * (x + 0.044715f * x * x * x); return x * sigm(2.f * u); }
DI void st_bf4(u16* p, f32x4 v) { uint2 o; o.x = pack2(v[0], v[1]); o.y = pack2(v[2], v[3]); *(uint2*)p = o; }
DI f32x4 ld_bf4(const u16* p) { uint2 o = *(const uint2*)p; f32x4 r; r[0] = bflo(o.x); r[1] = bfhi(o.x); r[2] = bflo(o.y); r[3] = bfhi(o.y); return r; }

DI int tid_l() { int t = threadIdx.x; asm volatile("" : "+v"(t)); return t; }


#define XB_TMO      128
#define XB_XCNT(j)  (256  + 64 * (j))
#define XB_XSUB(j)  (1280 + 64 * (j))
#define XB_XGEN(j)  (2304 + 64 * (j))
#define XB_TOP      3328
#define XB_TOPGEN   3392
#define XCD_BAR_WORDS 3456
#define XB_SPIN_CAP (1u << 22)
#define LAS __attribute__((address_space(3)))
DI unsigned xb_ld(unsigned* p) { return __hip_atomic_load(p, __ATOMIC_RELAXED, __HIP_MEMORY_SCOPE_AGENT); }
DI unsigned xb_add(unsigned* p, unsigned v) { return __hip_atomic_fetch_add(p, v, __ATOMIC_RELAXED, __HIP_MEMORY_SCOPE_AGENT); }
DI unsigned xb_xcc_id() { return (unsigned)__builtin_amdgcn_s_getreg((3 << 11) | 20) & 0xFu; }
#define XB_SPIN(cond, bar) do { unsigned _sp = 0; while (cond) { __builtin_amdgcn_s_sleep(1); \
    if ((++_sp & 255u) == 0u) { if (xb_ld(&(bar)[XB_TMO])) break; if (_sp > XB_SPIN_CAP) { atomicAdd(&(bar)[XB_TMO], 1u); break; } } } } while (0)
struct XcdBarrier { unsigned* bar; unsigned x; volatile LAS unsigned* st; };
DI XcdBarrier xcd_barrier_post(unsigned* bar, volatile LAS unsigned* st) {
  XcdBarrier b; b.bar = bar; b.x = xb_xcc_id(); b.st = st;
  if (threadIdx.x == 0) (void)xb_add(&bar[XB_XCNT(b.x)], 1u);
  return b;
}
DI void xcd_barrier_complete(unsigned* bar, unsigned x, unsigned& nloc, unsigned& nx) {
  const unsigned G = gridDim.x * gridDim.y * gridDim.z;
  unsigned sum, cnt, mine, sp = 0u;
  for (;;) {
    sum = 0u; cnt = 0u; mine = 0u;
#pragma unroll
    for (unsigned j = 0; j < 16; ++j) { const unsigned c = xb_ld(&bar[XB_XCNT(j)]); sum += c; cnt += (c > 0u) ? 1u : 0u; mine = (j == x) ? c : mine; }
    if (sum == G) break;
    __builtin_amdgcn_s_sleep(1);
    if ((++sp & 255u) == 0u) { if (xb_ld(&bar[XB_TMO])) break; if (sp > XB_SPIN_CAP) { atomicAdd(&bar[XB_TMO], 1u); break; } }
  }
  nloc = mine > 0u ? mine : 1u; nx = cnt > 0u ? cnt : 1u;
}
DI void xcd_barrier(const XcdBarrier& b) {
  asm volatile("s_waitcnt vmcnt(0)" ::: "memory");
  __syncthreads();
  if (threadIdx.x == 0) {
    unsigned* bar = b.bar;
    __builtin_amdgcn_s_waitcnt(0);
    unsigned nloc = b.st[0], nx = b.st[1];
    if (nloc == 0u) { xcd_barrier_complete(bar, b.x, nloc, nx); b.st[0] = nloc; b.st[1] = nx; }
    const unsigned old = xb_add(&bar[XB_XSUB(b.x)], 1u);
    const unsigned gen = old / nloc;
    if (old + 1u == (gen + 1u) * nloc) {
      __builtin_amdgcn_fence(__ATOMIC_RELEASE, "agent");
      asm volatile("s_waitcnt vmcnt(0)" ::: "memory");
      const unsigned og = xb_add(&bar[XB_TOP], 1u);
      const unsigned tg = og / nx;
      if (og + 1u == (tg + 1u) * nx) xb_add(&bar[XB_TOPGEN], 1u);
      else XB_SPIN(xb_ld(&bar[XB_TOPGEN]) == tg, bar);
      __builtin_amdgcn_fence(__ATOMIC_ACQUIRE, "agent");
      xb_add(&bar[XB_XGEN(b.x)], 1u);
      asm volatile("s_waitcnt vmcnt(0)" ::: "memory");
    } else {
      XB_SPIN(xb_ld(&bar[XB_XGEN(b.x)]) == gen, bar);
      __builtin_amdgcn_fence(__ATOMIC_ACQUIRE, "agent");
      asm volatile("s_waitcnt vmcnt(0)" ::: "memory");
    }
  }
  __syncthreads();
}

template <int DEPTH = 2, bool STAGED = true, class KMAP, class LA, class LW, class EPI>
DI void gemm_tile(u16* smem, int m0, int n0, int nks, KMAP kmap, LA loadA, LW loadW, EPI epi) {
  const int tid = tid_l(), lane = tid & 63, wave = tid >> 6;
  const int wm = wave >> 1, wn = wave & 1, l15 = lane & 15, quad = lane >> 4;
  u16* sX = smem;
  u16* sW = smem + 2 * 128 * 64;
  f32x4 acc[4][4];
#pragma unroll
  for (int i = 0; i < 4; ++i)
#pragma unroll
    for (int j = 0; j < 4; ++j) acc[i][j] = f32x4{0.f, 0.f, 0.f, 0.f};
  uint4 ra0[4], rw0[4], ra1[4], rw1[4];
  const int lrow = tid >> 3, lkc = (tid & 7) * 8;
  const int wpos = (((tid & 7) ^ ((tid >> 4) & 7)) * 8);
  const int rsw = (l15 >> 1) & 7;
  const int rp0 = ((quad ^ rsw) * 8), rp1 = (((4 + quad) ^ rsw) * 8);
#define G_LOAD(RA, RW, KS) { const int k0_ = __builtin_amdgcn_readfirstlane(kmap(KS)); _Pragma("unroll") for (int i = 0; i < 4; ++i) { RA[i] = loadA(m0 + lrow + i * 32, k0_, lkc); RW[i] = loadW(n0 + lrow + i * 32, k0_, lkc); } }
#define G_STORE(RA, RW, BUF) { u16* dx_ = sX + (BUF) * 128 * 64; u16* dw_ = sW + (BUF) * 128 * 64; _Pragma("unroll") for (int i = 0; i < 4; ++i) { \
    *(uint4*)(dx_ + (lrow + i * 32) * 64 + wpos) = RA[i]; *(uint4*)(dw_ + (lrow + i * 32) * 64 + wpos) = RW[i]; } }
#define G_COMPUTE(BUF, FENCE) { const u16* bx = sX + (BUF) * 128 * 64 + (wm * 64 + l15) * 64; const u16* bw = sW + (BUF) * 128 * 64 + (wn * 64 + l15) * 64; \
    bf16x8 xf[2][4], wf[2][4]; \
    _Pragma("unroll") for (int i = 0; i < 4; ++i) { \
      xf[0][i] = *(const bf16x8*)(bx + i * 16 * 64 + rp0); wf[0][i] = *(const bf16x8*)(bw + i * 16 * 64 + rp0); } \
    _Pragma("unroll") for (int i = 0; i < 4; ++i) { \
      xf[1][i] = *(const bf16x8*)(bx + i * 16 * 64 + rp1); wf[1][i] = *(const bf16x8*)(bw + i * 16 * 64 + rp1); } \
    if (FENCE) __builtin_amdgcn_sched_barrier(0); \
    _Pragma("unroll") for (int kk = 0; kk < 2; ++kk) { \
      _Pragma("unroll") for (int ni = 0; ni < 4; ++ni) _Pragma("unroll") for (int mi = 0; mi < 4; ++mi) \
          acc[ni][mi] = __builtin_amdgcn_mfma_f32_16x16x32_bf16(wf[kk][ni], xf[kk][mi], acc[ni][mi], 0, 0, 0); \
      if (FENCE) __builtin_amdgcn_sched_barrier(0); } }
#define G_PATTERN { __builtin_amdgcn_sched_group_barrier(0x100, 16, 0); \
    _Pragma("unroll") for (int q_ = 0; q_ < 8; ++q_) { __builtin_amdgcn_sched_group_barrier(0x008, 2, 0); __builtin_amdgcn_sched_group_barrier(0x020, 1, 0); } \
    _Pragma("unroll") for (int q_ = 0; q_ < 8; ++q_) { __builtin_amdgcn_sched_group_barrier(0x008, 2, 0); __builtin_amdgcn_sched_group_barrier(0x200, 1, 0); } }
  if (DEPTH == 2) {
    G_LOAD(ra0, rw0, 0);
    G_LOAD(ra1, rw1, 1);
    G_STORE(ra0, rw0, 0);
    __syncthreads();
    for (int ks = 0; ks < nks; ks += 2) {
      G_LOAD(ra0, rw0, (ks + 2 < nks ? ks + 2 : nks - 1));
      G_COMPUTE(0, 0);
      G_STORE(ra1, rw1, 1);
      G_PATTERN;
      __syncthreads();
      G_LOAD(ra1, rw1, (ks + 3 < nks ? ks + 3 : nks - 1));
      G_COMPUTE(1, 0);
      G_STORE(ra0, rw0, 0);
      G_PATTERN;
      __syncthreads();
    }
  } else {
    G_LOAD(ra0, rw0, 0);
    G_STORE(ra0, rw0, 0);
    __syncthreads();
    for (int ks = 0; ks < nks; ++ks) {
      const int buf = ks & 1;
      if (ks + 1 < nks) G_LOAD(ra0, rw0, ks + 1);
      G_COMPUTE(buf, 1);
      if (ks + 1 < nks) G_STORE(ra0, rw0, buf ^ 1);
      __syncthreads();
    }
  }
#undef G_LOAD
#undef G_STORE
#undef G_COMPUTE
#undef G_PATTERN
  if constexpr (!STAGED) {
#pragma unroll
    for (int ni = 0; ni < 4; ++ni)
#pragma unroll
      for (int mi = 0; mi < 4; ++mi)
        epi(m0 + wm * 64 + mi * 16 + l15, n0 + wn * 64 + ni * 16 + quad * 4, acc[ni][mi]);
  } else {
    float* wbuf = (float*)smem + wave * (16 * 68);
    const int rrow = lane >> 4, rcol = (lane & 15) * 4;
#pragma unroll
    for (int mi = 0; mi < 4; ++mi) {
#pragma unroll
      for (int ni = 0; ni < 4; ++ni) *(f32x4*)(wbuf + l15 * 68 + ni * 16 + quad * 4) = acc[ni][mi];
      __builtin_amdgcn_wave_barrier();
#pragma unroll
      for (int j = 0; j < 4; ++j) {
        const f32x4 a = *(const f32x4*)(wbuf + (j * 4 + rrow) * 68 + rcol);
        epi(m0 + wm * 64 + mi * 16 + j * 4 + rrow, n0 + wn * 64 + rcol, a);
      }
    }
    __syncthreads();
  }
}

template <bool HASPRE = false, class LA, class LW, class EPI, class PRE = int>
DI void gemm_tile_w(u16* smem, int m0, int n0, int nks, LA loadA, LW loadW, EPI epi, PRE pre = 0) {
  const int tid = tid_l(), lane = tid & 63, wave = tid >> 6;
  const int wm = wave >> 1, wn = wave & 1, l15 = lane & 15, quad = lane >> 4;
  u16* sX = smem;
  u16* sW = smem + 2 * 128 * 32;
  f32x4 acc[8][4];
#pragma unroll
  for (int i = 0; i < 8; ++i)
#pragma unroll
    for (int j = 0; j < 4; ++j) acc[i][j] = f32x4{0.f, 0.f, 0.f, 0.f};
  uint4 ra0[2], rw0[4], ra1[2], rw1[4];
  const int lrow = tid >> 2, lkc = (tid & 3) * 8;
  const int wpos = ((tid & 3) ^ ((0 - (tid >> 4)) & 3)) * 8;
  const int rpos = (quad ^ ((0 - (l15 >> 2)) & 3)) * 8;
#define W_LOAD(RA, RW, KS) { const int k0_ = __builtin_amdgcn_readfirstlane((KS) * 32); \
    _Pragma("unroll") for (int i = 0; i < 2; ++i) RA[i] = loadA(m0 + lrow + i * 64, k0_, lkc); \
    _Pragma("unroll") for (int i = 0; i < 4; ++i) RW[i] = loadW(n0 + lrow + i * 64, k0_, lkc); }
#define W_STORE(RA, RW, BUF) { u16* dx_ = sX + (BUF) * 128 * 32; u16* dw_ = sW + (BUF) * 256 * 32; \
    _Pragma("unroll") for (int i = 0; i < 2; ++i) *(uint4*)(dx_ + (lrow + i * 64) * 32 + wpos) = RA[i]; \
    _Pragma("unroll") for (int i = 0; i < 4; ++i) *(uint4*)(dw_ + (lrow + i * 64) * 32 + wpos) = RW[i]; }
#define W_COMPUTE(BUF) { const u16* bx = sX + (BUF) * 128 * 32 + (wm * 64 + l15) * 32 + rpos; const u16* bw = sW + (BUF) * 256 * 32 + (wn * 128 + l15) * 32 + rpos; \
    bf16x8 xf[4], wf[8]; \
    _Pragma("unroll") for (int i = 0; i < 4; ++i) xf[i] = *(const bf16x8*)(bx + i * 16 * 32); \
    _Pragma("unroll") for (int i = 0; i < 8; ++i) wf[i] = *(const bf16x8*)(bw + i * 16 * 32); \
    _Pragma("unroll") for (int ni = 0; ni < 8; ++ni) _Pragma("unroll") for (int mi = 0; mi < 4; ++mi) \
        acc[ni][mi] = __builtin_amdgcn_mfma_f32_16x16x32_bf16(wf[ni], xf[mi], acc[ni][mi], 0, 0, 0); }
#define W_PATTERN { __builtin_amdgcn_sched_group_barrier(0x100, 12, 0); \
    _Pragma("unroll") for (int q_ = 0; q_ < 6; ++q_) { __builtin_amdgcn_sched_group_barrier(0x008, 2, 0); __builtin_amdgcn_sched_group_barrier(0x020, 1, 0); } \
    _Pragma("unroll") for (int q_ = 0; q_ < 6; ++q_) { __builtin_amdgcn_sched_group_barrier(0x008, 3, 0); __builtin_amdgcn_sched_group_barrier(0x200, 1, 0); } \
    __builtin_amdgcn_sched_group_barrier(0x008, 2, 0); }
  W_LOAD(ra0, rw0, 0);
  W_LOAD(ra1, rw1, 1);
  W_STORE(ra0, rw0, 0);
  __syncthreads();
  for (int ks = 0; ks < nks; ks += 2) {
    W_LOAD(ra0, rw0, (ks + 2 < nks ? ks + 2 : nks - 1));
    W_COMPUTE(0);
    W_STORE(ra1, rw1, 1);
    W_PATTERN;
    __syncthreads();
    W_LOAD(ra1, rw1, (ks + 3 < nks ? ks + 3 : nks - 1));
    W_COMPUTE(1);
    W_STORE(ra0, rw0, 0);
    W_PATTERN;
    __syncthreads();
  }
#undef W_LOAD
#undef W_STORE
#undef W_COMPUTE
#undef W_PATTERN
  if constexpr (HASPRE) {
    float* wbuf = (float*)smem + wave * (16 * 132);
    const int rrow = lane >> 5, rcol = (lane & 31) * 4;
#pragma unroll
    for (int mi = 0; mi < 4; ++mi) {
#pragma unroll
      for (int ni = 0; ni < 8; ++ni) *(f32x4*)(wbuf + l15 * 132 + ni * 16 + quad * 4) = acc[ni][mi];
      __builtin_amdgcn_wave_barrier();
      f32x4 pv[8];
#pragma unroll
      for (int j = 0; j < 8; ++j) pv[j] = pre(m0 + wm * 64 + mi * 16 + j * 2 + rrow, n0 + wn * 128 + rcol);
#pragma unroll
      for (int j = 0; j < 8; ++j) {
        const f32x4 a = *(const f32x4*)(wbuf + (j * 2 + rrow) * 132 + rcol);
        epi(m0 + wm * 64 + mi * 16 + j * 2 + rrow, n0 + wn * 128 + rcol, a, pv[j]);
      }
    }
    __syncthreads();
  } else {
    float* wbuf = (float*)smem + wave * (16 * 132);
    const int rrow = lane >> 5, rcol = (lane & 31) * 4;
#pragma unroll
    for (int mi = 0; mi < 4; ++mi) {
#pragma unroll
      for (int ni = 0; ni < 8; ++ni) *(f32x4*)(wbuf + l15 * 132 + ni * 16 + quad * 4) = acc[ni][mi];
      __builtin_amdgcn_wave_barrier();
#pragma unroll
      for (int j = 0; j < 8; ++j) {
        const f32x4 a = *(const f32x4*)(wbuf + (j * 2 + rrow) * 132 + rcol);
        epi(m0 + wm * 64 + mi * 16 + j * 2 + rrow, n0 + wn * 128 + rcol, a);
      }
    }
    __syncthreads();
  }
}

DI void tconv(float* tl, const float* src, u16* dst, int K, int N, int Npad, int b0, int nb) {
  const int tid = tid_l();
  const int nkt = K >> 6, nnt = Npad >> 6, ntl = nkt * nnt;
  const int r = tid >> 4, c4 = (tid & 15) * 4;
  float4 v[4];
  int tile = (int)blockIdx.x - b0;
  auto ld = [&](int t) {
    const int kt = t % nkt, nt = t / nkt;
    const int k0 = kt * 64, n0 = nt * 64;
#pragma unroll
    for (int i = 0; i < 4; ++i) {
      v[i] = make_float4(0.f, 0.f, 0.f, 0.f);
      if (n0 + c4 < N) v[i] = *(const float4*)(src + (size_t)(k0 + r + i * 16) * N + n0 + c4);
    }
  };
  if (tile < ntl) ld(tile);
  for (; tile < ntl; tile += nb) {
    const int kt = tile % nkt, nt = tile / nkt;
    const int k0 = kt * 64, n0 = nt * 64;
#pragma unroll
    for (int i = 0; i < 4; ++i) {
      const int k = r + i * 16;
      tl[k * 65 + c4 + 0] = v[i].x; tl[k * 65 + c4 + 1] = v[i].y; tl[k * 65 + c4 + 2] = v[i].z; tl[k * 65 + c4 + 3] = v[i].w;
    }
    if (tile + nb < ntl) ld(tile + nb);
    __syncthreads();
#pragma unroll
    for (int i = 0; i < 2; ++i) {
      const int c = tid + i * 256;
      const int n = c >> 3, k8 = (c & 7) * 8;
      uint4 o;
      o.x = pack2(tl[(k8 + 0) * 65 + n], tl[(k8 + 1) * 65 + n]);
      o.y = pack2(tl[(k8 + 2) * 65 + n], tl[(k8 + 3) * 65 + n]);
      o.z = pack2(tl[(k8 + 4) * 65 + n], tl[(k8 + 5) * 65 + n]);
      o.w = pack2(tl[(k8 + 6) * 65 + n], tl[(k8 + 7) * 65 + n]);
      *(uint4*)(dst + (size_t)(n0 + n) * K + k0 + k8) = o;
    }
    __syncthreads();
  }
}

template <int MODE, class TILE, class BIAS, class EM, class MASK>
DI void attn_loop(u16* sK, u16* sV, uint32_t* imp, int ntiles, TILE tilefn, BIAS biasfn, EM emfn, MASK valid, const bf16x8 (&qf)[2][4],
                  f32x4 (&o)[2][8], float (&mrow)[2], float (&lrow)[2], const float (&linv)[2]) {
  const int tid = tid_l(), lane = tid & 63;
  const int l15 = lane & 15, quad = lane >> 4;
  const int lr = tid >> 4, lc = (tid & 15) * 8;
  uint4 rk[4];
#define K_LOAD(IT) { const u16 *kb_, *vb_; size_t rs_; int kp_; tilefn(IT, kb_, vb_, rs_, kp_); _Pragma("unroll") for (int i = 0; i < 4; ++i) rk[i] = ldg_o(kb_, (uint32_t)((lr + i * 16) * (int)rs_ + lc) * 2u); }
#define V_LOAD_G(IT) { const u16 *kb_, *vb_; size_t rs_; int kp_; tilefn(IT, kb_, vb_, rs_, kp_); _Pragma("unroll") for (int i = 0; i < 4; ++i) rk[i] = ldg_o(vb_, (uint32_t)((lr + i * 16) * (int)rs_ + lc) * 2u); }
#define K_STORE(BUF) { _Pragma("unroll") for (int i = 0; i < 4; ++i) *(uint4*)(sK + (BUF) * 64 * 136 + (lr + i * 16) * 136 + lc) = rk[i]; }
#define V_STORE(BUF) { _Pragma("unroll") for (int i = 0; i < 4; ++i) *(uint4*)(sV + (BUF) * 64 * 144 + (lr + i * 16) * 144 + lc) = rk[i]; }
  auto compute = [&](const int buf, const int it, auto midfn) {
    int kpos0;
    { const u16 *kb, *vb; size_t rs; tilefn(it, kb, vb, rs, kpos0); }
    f32x4 s[4][2];
#pragma unroll
    for (int kc = 0; kc < 4; ++kc) { s[kc][0] = f32x4{0.f, 0.f, 0.f, 0.f}; s[kc][1] = f32x4{0.f, 0.f, 0.f, 0.f}; }
    const u16* kbase = sK + buf * 64 * 136 + l15 * 136 + quad * 8;
    {
      bf16x8 kf[2][2];
      kf[0][0] = *(const bf16x8*)(kbase);
      kf[0][1] = *(const bf16x8*)(kbase + 32);
#pragma unroll
      for (int h = 0; h < 8; ++h) {
        const int kc = h >> 1, dh = h & 1;
        if (h < 7) {
          const int kc2 = (h + 1) >> 1, dh2 = (h + 1) & 1;
          kf[(h + 1) & 1][0] = *(const bf16x8*)(kbase + kc2 * 16 * 136 + (dh2 * 2) * 32);
          kf[(h + 1) & 1][1] = *(const bf16x8*)(kbase + kc2 * 16 * 136 + (dh2 * 2 + 1) * 32);
        }
#pragma unroll
        for (int e = 0; e < 2; ++e) {
          const int ds = dh * 2 + e;
          s[kc][0] = __builtin_amdgcn_mfma_f32_16x16x32_bf16(kf[h & 1][e], qf[0][ds], s[kc][0], 0, 0, 0);
          s[kc][1] = __builtin_amdgcn_mfma_f32_16x16x32_bf16(kf[h & 1][e], qf[1][ds], s[kc][1], 0, 0, 0);
        }
        __builtin_amdgcn_sched_barrier(0);
      }
    }
    midfn();
    float mx[2] = {-1e30f, -1e30f};
    if (MODE == 0) {
      const float bias0 = biasfn(it, 0), bias1 = biasfn(it, 1);
      const bool em = ATT_SAFE || emfn(it);
      if (em) {
#pragma unroll
        for (int kc = 0; kc < 4; ++kc)
#pragma unroll
          for (int qs = 0; qs < 2; ++qs)
#pragma unroll
            for (int r = 0; r < 4; ++r) {
              const int kpos = kpos0 + kc * 16 + quad * 4 + r;
              const float x = valid(kpos, qs) ? fmaf(s[kc][qs][r], SCALE2, qs ? bias1 : bias0) : -1e30f;
              s[kc][qs][r] = x;
              mx[qs] = fmaxf(mx[qs], x);
            }
      } else {
        float r0 = -3e38f, r1 = -3e38f;
#pragma unroll
        for (int kc = 0; kc < 4; ++kc)
#pragma unroll
          for (int r = 0; r < 4; ++r) { r0 = fmaxf(r0, s[kc][0][r]); r1 = fmaxf(r1, s[kc][1][r]); }
        mx[0] = fmaf(r0, SCALE2, bias0);
        mx[1] = fmaf(r1, SCALE2, bias1);
      }
      float al[2];
#pragma unroll
      for (int qs = 0; qs < 2; ++qs) {
        float m = mx[qs];
        m = fmaxf(m, __shfl_xor(m, 16));
        m = fmaxf(m, __shfl_xor(m, 32));
        const float mnew = fmaxf(mrow[qs], m);
        al[qs] = __builtin_amdgcn_exp2f(mrow[qs] - mnew);
        mrow[qs] = mnew;
      }
      if (__builtin_amdgcn_ballot_w64(al[0] < 1.f || al[1] < 1.f) != 0ull) {
#pragma unroll
        for (int qs = 0; qs < 2; ++qs) {
          lrow[qs] *= al[qs];
#pragma unroll
          for (int dt = 0; dt < 8; ++dt) o[qs][dt] *= al[qs];
        }
      }
      if (em) {
#pragma unroll
        for (int kc = 0; kc < 4; ++kc)
#pragma unroll
          for (int qs = 0; qs < 2; ++qs)
#pragma unroll
            for (int r = 0; r < 4; ++r) {
              float pv = __builtin_amdgcn_exp2f(s[kc][qs][r] - mrow[qs]);
              if (ATT_SAFE) pv = (s[kc][qs][r] > -1e29f) ? pv : 0.f;
              lrow[qs] += pv;
              s[kc][qs][r] = pv;
            }
      } else {
        const float c0 = bias0 - mrow[0], c1 = bias1 - mrow[1];
#pragma unroll
        for (int kc = 0; kc < 4; ++kc)
#pragma unroll
          for (int qs = 0; qs < 2; ++qs)
#pragma unroll
            for (int r = 0; r < 4; ++r) {
              const float pv = __builtin_amdgcn_exp2f(fmaf(s[kc][qs][r], SCALE2, qs ? c1 : c0));
              lrow[qs] += pv;
              s[kc][qs][r] = pv;
            }
      }
    } else {
#pragma unroll
      for (int kc = 0; kc < 4; ++kc)
#pragma unroll
        for (int qs = 0; qs < 2; ++qs)
#pragma unroll
          for (int r = 0; r < 4; ++r) {
            const int kpos = kpos0 + kc * 16 + quad * 4 + r;
            const float x = valid(kpos, qs) ? s[kc][qs][r] * SCALE2 : -1e30f;
            s[kc][qs][r] = x;
            mx[qs] = fmaxf(mx[qs], x);
          }
      if (MODE == 1) {
#pragma unroll
        for (int qs = 0; qs < 2; ++qs) {
          float m = mx[qs];
          m = fmaxf(m, __shfl_xor(m, 16));
          m = fmaxf(m, __shfl_xor(m, 32));
          const float mnew = fmaxf(mrow[qs], m);
          const float alpha = __builtin_amdgcn_exp2f(mrow[qs] - mnew);
          mrow[qs] = mnew;
          lrow[qs] *= alpha;
        }
      }
#pragma unroll
      for (int kc = 0; kc < 4; ++kc)
#pragma unroll
        for (int qs = 0; qs < 2; ++qs)
#pragma unroll
          for (int r = 0; r < 4; ++r) {
            const float x = s[kc][qs][r];
            float pv = (x > -1e29f) ? __builtin_amdgcn_exp2f(x - mrow[qs]) : 0.f;
            if (MODE == 2) pv *= linv[qs];
            else lrow[qs] += pv;
            s[kc][qs][r] = pv;
          }
    }
    if (MODE == 2) {
#pragma unroll
      for (int kc = 0; kc < 4; ++kc)
#pragma unroll
        for (int qs = 0; qs < 2; ++qs) {
          const int jb = (kpos0 >> 2) + kc * 4 + quad;
          const float a = s[kc][qs][0] + s[kc][qs][1] + s[kc][qs][2] + s[kc][qs][3];
          const float b3 = s[kc][qs][3];
          if (jb < 64) atomicAdd(&imp[(qs * 16 + l15) * 65 + jb], (uint32_t)(a * 67108864.f + 0.5f));
          if (jb + 1 < 64) atomicAdd(&imp[(qs * 16 + l15) * 65 + jb + 1], (uint32_t)(b3 * 67108864.f + 0.5f));
        }
    }
    if (MODE != 1) {
      bf16x8 pb[2][2];
#pragma unroll
      for (int j = 0; j < 2; ++j)
#pragma unroll
        for (int qs = 0; qs < 2; ++qs) {
          union { bf16x8 v; uint32_t u[4]; } cv;
          cv.u[0] = pack2(s[2 * j][qs][0], s[2 * j][qs][1]);
          cv.u[1] = pack2(s[2 * j][qs][2], s[2 * j][qs][3]);
          cv.u[2] = pack2(s[2 * j + 1][qs][0], s[2 * j + 1][qs][1]);
          cv.u[3] = pack2(s[2 * j + 1][qs][2], s[2 * j + 1][qs][3]);
          pb[j][qs] = cv.v;
        }
      const u16* vbase = sV + buf * 64 * 144 + (4 * quad + (l15 >> 2)) * 144 + (l15 & 3) * 4;
      bf16x8 vf[2][4];
#define V_LOAD(DST, G) { _Pragma("unroll") for (int d = 0; d < 4; ++d) { const u16* a0 = vbase + (32 * ((G) >> 1)) * 144 + (((G) & 1) * 4 + d) * 16; \
        s16x4 lo = __builtin_amdgcn_ds_read_tr16_b64_v4i16((__attribute__((address_space(3))) s16x4*)(a0)); \
        s16x4 hi = __builtin_amdgcn_ds_read_tr16_b64_v4i16((__attribute__((address_space(3))) s16x4*)(a0 + 16 * 144)); \
        bf16x8 t; t[0] = lo[0]; t[1] = lo[1]; t[2] = lo[2]; t[3] = lo[3]; t[4] = hi[0]; t[5] = hi[1]; t[6] = hi[2]; t[7] = hi[3]; DST[d] = t; } }
      V_LOAD(vf[0], 0);
#pragma unroll
      for (int g = 0; g < 4; ++g) {
        if (g < 3) V_LOAD(vf[(g + 1) & 1], g + 1);
#pragma unroll
        for (int d = 0; d < 4; ++d) {
          const int dt = (g & 1) * 4 + d;
          o[0][dt] = __builtin_amdgcn_mfma_f32_16x16x32_bf16(vf[g & 1][d], pb[g >> 1][0], o[0][dt], 0, 0, 0);
          o[1][dt] = __builtin_amdgcn_mfma_f32_16x16x32_bf16(vf[g & 1][d], pb[g >> 1][1], o[1][dt], 0, 0, 0);
        }
        __builtin_amdgcn_sched_barrier(0);
      }
#undef V_LOAD
    }
  };
  {
    uint4 rv0[4];
    const u16 *kb_, *vb_; size_t rs_; int kp_;
    tilefn(0, kb_, vb_, rs_, kp_);
#pragma unroll
    for (int i = 0; i < 4; ++i) {
      rk[i] = ldg_o(kb_, (uint32_t)((lr + i * 16) * (int)rs_ + lc) * 2u);
      if (MODE != 1) rv0[i] = ldg_o(vb_, (uint32_t)((lr + i * 16) * (int)rs_ + lc) * 2u);
    }
    K_STORE(0);
    if (MODE != 1) {
#pragma unroll
      for (int i = 0; i < 4; ++i) *(uint4*)(sV + (lr + i * 16) * 144 + lc) = rv0[i];
    }
  }
  __syncthreads();
  for (int it = 0; it < ntiles; ++it) {
    const int buf = it & 1;
    const bool more = (it + 1 < ntiles);
    if (more) K_LOAD(it + 1);
    compute(buf, it, [&]() { if (more) { K_STORE(buf ^ 1); if (MODE != 1) V_LOAD_G(it + 1); } });
    if (more && MODE != 1) V_STORE(buf ^ 1);
    __syncthreads();
  }
#undef K_LOAD
#undef V_LOAD_G
#undef K_STORE
#undef V_STORE
}

__global__ void __launch_bounds__(256, 2) yoco_fwd(Params p) {
  cg::grid_group grid = cg::this_grid();
  __shared__ __attribute__((aligned(16))) u16 smem[40192];
  __shared__ uint4 xb_words;
  if (threadIdx.x == 0) xb_words = make_uint4(0u, 0u, 0u, 0u);
  __syncthreads();
  XcdBarrier xb = xcd_barrier_post((unsigned*)(p.ws + O_BAR), (volatile LAS unsigned*)&xb_words);
  char* ws = p.ws;
  u16* W_AIN = (u16*)(ws + O_WAIN);
  u16* W_GLU = (u16*)(ws + O_WGLU);
  u16* W_AOUT = (u16*)(ws + O_WAOUT);
  u16* W_KV = (u16*)(ws + O_WKV);
  u16* W_C1 = (u16*)(ws + O_WC1);
  u16* W_C2 = (u16*)(ws + O_WC2);
  u16* W_BIN = (u16*)(ws + O_WBIN);
  u16* W_BOUT = (u16*)(ws + O_WBOUT);
  u16* XB = (u16*)(ws + O_XB);
  float* XF = (float*)(ws + O_XF);
  u16* KV = (u16*)(ws + O_KV);
  float* T1P = (float*)(ws + O_T1);
  u16* KCVC = (u16*)(ws + O_KCVC);
  float* C1B = (float*)(ws + O_C1B);
  u16* YB = (u16*)(ws + O_YB);
  float2* STATS = (float2*)(ws + O_STATS);
  u16* UZ = (u16*)(ws + O_UZ);
  u16* GB = (u16*)(ws + O_G);
  u16* VB = (u16*)(ws + O_V);
  float* SB = (float*)(ws + O_S);
  u16* HIN = (u16*)(ws + O_HIN);
  u16* W1 = (u16*)(ws + O_W1);
  u16* W3T = (u16*)(ws + O_W3T);
  u16* KTAB = (u16*)(ws + O_KTAB);
  float2* A64 = (float2*)(ws + O_A64);
  u16* PROJ = (u16*)(ws + O_PROJ);

  float* tl = (float*)smem;
  auto do_jobs = [&](unsigned mask, int b0, int nb) {
      for (int job = 0; job < 15; ++job) {
        if (!((mask >> job) & 1u)) continue;

        const float* src; u16* dst; int K, N, Np;
        switch (job) {
          case 0: src = p.in[1]; dst = W_AIN; K = 2048; N = 2048; Np = 2048; break;
          case 1: src = p.in[1] + (size_t)2048 * 2048; dst = W_AIN + (size_t)2048 * 2048; K = 2048; N = 2048; Np = 2048; break;
          case 2: src = p.in[10]; dst = W_GLU; K = 1024; N = 1024; Np = 1024; break;
          case 3: src = p.in[10] + (size_t)1024 * 1024; dst = W_GLU + (size_t)1024 * 1024; K = 1024; N = 1024; Np = 1024; break;
          case 4: src = p.in[12]; dst = W_AOUT; K = 1024; N = 2048; Np = 2048; break;
          case 5: src = p.in[12] + (size_t)1024 * 2048; dst = W_AOUT + (size_t)2048 * 1024; K = 1024; N = 2048; Np = 2048; break;
          case 6: src = p.in[13]; dst = W_KV; K = 2048; N = 3072; Np = 3072; break;
          case 7: src = p.in[15]; dst = W_C1; K = 4096; N = 128; Np = 128; break;
          case 8: src = p.in[18]; dst = W_C1 + (size_t)128 * 4096; K = 4096; N = 128; Np = 128; break;
          case 9: src = p.in[16]; dst = W_C2; K = 128; N = 128; Np = 128; break;
          case 10: src = p.in[19]; dst = W_C2 + (size_t)128 * 128; K = 128; N = 128; Np = 128; break;
          case 11: src = p.in[20]; dst = W_BIN; K = 2048; N = BIN_N; Np = PROJ_LD; break;
          case 12: src = p.in[20] + (size_t)2048 * BIN_N; dst = W_BIN + (size_t)PROJ_LD * 2048; K = 2048; N = BIN_N; Np = PROJ_LD; break;
          case 13: src = p.in[21]; dst = W_BOUT; K = 2048; N = 2048; Np = 2048; break;
          default: src = p.in[21] + (size_t)2048 * 2048; dst = W_BOUT + (size_t)2048 * 2048; K = 2048; N = 2048; Np = 2048; break;
        }
        if ((int)blockIdx.x >= b0) tconv(tl, src, dst, K, N, Np, b0, nb);
      }
  };
  for (int rep0 = 0; rep0 < REPS_P0; ++rep0) {
    const int tid = tid_l(), lane = tid & 63, wave = tid >> 6; (void)lane; (void)wave;
    do_jobs((1u << 0) | (1u << 2) | (1u << 4) | (1u << 7) | (1u << 8) | (1u << 9) | (1u << 10), 0, (int)gridDim.x);
    {
      const float4* x4 = (const float4*)p.in[0];
      uint2* xb2 = (uint2*)XB;
      const size_t n4 = (size_t)NTOK * DM / 4;
      for (size_t i = (size_t)blockIdx.x * 256 + tid; i < n4; i += (size_t)gridDim.x * 256) {
        float4 v = x4[i];
        uint2 o; o.x = pack2(v.x, v.y); o.y = pack2(v.z, v.w);
        xb2[i] = o;
      }
    }
    {
      float* C1P = (float*)(ws + O_C1P);
      float* red = (float*)smem;
      for (int item = blockIdx.x; item < 64; item += gridDim.x) {
        const int kvs = item >> 5, part = item & 31;
        const float* pos = p.in[kvs ? 17 : 14];
        const float* w1 = p.in[kvs ? 18 : 15];
        const int j = tid & 127, half = tid >> 7;
        const int i0 = part * 128 + half * 64;
        float acc = 0.f;
#pragma unroll 16
        for (int i = 0; i < 64; ++i) acc += pos[i0 + i] * w1[(size_t)(i0 + i) * 128 + j];
        __syncthreads();
        red[tid] = acc;
        __syncthreads();
        if (tid < 128) C1P[(size_t)item * 128 + tid] = red[tid] + red[tid + 128];
        __syncthreads();
      }
    }
    {
      float2* sE = (float2*)smem;
      float2* sCo = sE + 64;
      float2* sM = sCo + 64;
      float2* sC = sM + 1024;
      float2* sBb = sC + 1024;
      const int nper = 4;
      for (int w = blockIdx.x; w < 128 * nper; w += gridDim.x) {
        const int lg = w / nper, j0 = w % nper;
        const float* lam_re = p.in[2] + (size_t)lg * 64;
        const float* lam_im = p.in[3] + (size_t)lg * 64;
        const float dt = __expf(p.in[4][lg]);
        const float* b_re = p.in[5] + (size_t)lg * 1024;
        const float* b_im = p.in[6] + (size_t)lg * 1024;
        const float* c_re = p.in[7] + (size_t)lg * 1024;
        const float* c_im = p.in[8] + (size_t)lg * 1024;
        __syncthreads();
#pragma unroll
        for (int i = 0; i < 4; ++i) sC[tid + i * 256] = make_float2(c_re[tid + i * 256], c_im[tid + i * 256]);
        float lr = 0.f, li = 0.f;
        if (tid < 64) {
          lr = lam_re[tid]; li = lam_im[tid];
          const float mag = expf(lr * dt);
          float sn, cs;
          sincosf(li * dt, &sn, &cs);
          const float ar = mag * cs, ai = mag * sn;
          const float inv = 1.f / (lr * lr + li * li);
          sCo[tid] = make_float2(((ar - 1.f) * lr + ai * li) * inv, (ai * lr - (ar - 1.f) * li) * inv);
        }
        __syncthreads();
#pragma unroll
        for (int i = 0; i < 4; ++i) {
          const int idx = tid + i * 256;
          const float br = b_re[idx], bi = b_im[idx];
          const float2 co = sCo[idx >> 4];
          sBb[idx] = make_float2(co.x * br - co.y * bi, co.x * bi + co.y * br);
        }
        for (int j = j0; j < 65; j += nper) {
          if (tid < 64) {
            const float fj = (float)j;
            const float mj = expf(lr * dt * fj);
            float sj, cj;
            if (j == 64) sincosf(li * dt * fj, &sj, &cj);
            else __sincosf(li * dt * fj, &sj, &cj);
            sE[tid] = make_float2(mj * cj, mj * sj);
            if (j == 64) A64[(size_t)lg * 64 + tid] = make_float2(mj * cj, mj * sj);
          }
          __syncthreads();
#pragma unroll
          for (int i = 0; i < 4; ++i) {
            const int idx = tid + i * 256;
            const int pp = idx >> 4, ci = idx & 15;
            const float2 bb = sBb[idx];
            const float2 e = sE[pp];
            const float mr = e.x * bb.x - e.y * bb.y, mi = e.x * bb.y + e.y * bb.x;
            sM[idx] = make_float2(mr, mi);
            if (j < 64) {
              const int s = 63 - j;
              u16* w1p = W1 + (size_t)lg * 128 * 1024;
              w1p[(size_t)pp * 1024 + s * 16 + ci] = f2bf(mr);
              w1p[(size_t)(64 + pp) * 1024 + s * 16 + ci] = f2bf(mi);
            }
          }
          __syncthreads();
          if (j < 64) {
            const int co = tid >> 4, ci = tid & 15;
            float acc = 0.f;
            for (int pp = 0; pp < 64; ++pp) {
              const float2 m = sM[pp * 16 + ci];
              const float2 c = sC[co * 64 + pp];
              acc += c.x * m.x - c.y * m.y;
            }
            KTAB[(((size_t)lg * 64 + j) * 16 + co) * 16 + ci] = f2bf(acc);
          }
          if (j >= 1) {
            const int t = j - 1;
            u16* w3p = W3T + (size_t)lg * 1024 * 128;
#pragma unroll
            for (int i = 0; i < 4; ++i) {
              const int idx = tid + i * 256;
              const int co = idx >> 6, pp = idx & 63;
              const float cr = sC[idx].x, ci = sC[idx].y;
              const float2 e = sE[pp];
              const float re = cr * e.x - ci * e.y, im = cr * e.y + ci * e.x;
              w3p[(size_t)(t * 16 + co) * 128 + pp] = f2bf(re);
              w3p[(size_t)(t * 16 + co) * 128 + 64 + pp] = f2bf(-im);
            }
          }
          __syncthreads();
        }
      }
    }
  }
  grid.sync();

  auto kmap64 = [](int ks) { return ks * 64; };

  for (int l = 0; l < 2; ++l) {
    const float* xres = (l == 0) ? p.in[0] : XF;
    {
      const int tid = tid_l(), lane = tid & 63, wave = tid >> 6; (void)lane; (void)wave;
      if (l == 0 && blockIdx.x == 0) {
        const float* C1P = (const float*)(ws + O_C1P);
        float a = 0.f;
        for (int part = 0; part < 32; ++part) a += C1P[((size_t)(tid >> 7) * 32 + part) * 128 + (tid & 127)];
        C1B[tid] = a;
      }
      const u16* Wt = W_AIN + (size_t)l * 2048 * 2048;
      for (int tile = blockIdx.x; tile < 64 * 8; tile += gridDim.x) {
        const int mt = tile & 63, nt = tile >> 6;
        gemm_tile_w(smem, mt * 128, nt * 256, 64,
                  [=](int m, int k0, int kc) { return ldg_o(XB + k0, (uint32_t)(m * 2048 + kc) * 2u); },
                  [=](int n, int k0, int kc) { return ldg_o(Wt + k0, (uint32_t)(n * 2048 + kc) * 2u); },
                  [=](int m, int n, f32x4 v) { st_bf4(UZ + (size_t)m * 2048 + n, v); });
      }
    }
    xcd_barrier(xb);
    {
      float* sS = (float*)smem;
      if (l == 0) do_jobs((1u << 1) | (1u << 3) | (1u << 5) | (1u << 6) | (1u << 11), 64, (int)gridDim.x - 64);
      else do_jobs((1u << 12), 64, (int)gridDim.x - 64);
      for (int g = blockIdx.x; g < 64; g += gridDim.x) {
        const u16* w1p = W1 + ((size_t)l * 64 + g) * 128 * 1024;
        gemm_tile<1, false>(smem, 0, 0, 16, kmap64,
                  [=](int m, int k0, int kc) { return ldg_o(UZ + (size_t)(k0 >> 4) * 2048 + g * 16, (uint32_t)((m * 64 + (kc >> 4)) * 2048 + (kc & 15)) * 2u); },
                  [=](int n, int k0, int kc) { return ldg_o(w1p + k0, (uint32_t)(n * 1024 + kc) * 2u); },
                  [=](int m, int n, f32x4 v) { *(f32x4*)(sS + m * 132 + n) = v; });
        __syncthreads();
        const int tid = tid_l();
        if (tid < 128) {
          const int b = tid >> 6, pp = tid & 63;
          const float2 a = A64[((size_t)l * 64 + g) * 64 + pp];
          float hr = 0.f, hi = 0.f;
          const float* sp = sS + (b * 64) * 132;
          u16* hp = HIN + ((size_t)g * 128 + b * 64) * 128;
#pragma unroll 4
          for (int c = 0; c < 64; ++c) {
            hp[c * 128 + pp] = f2bf(hr);
            hp[c * 128 + 64 + pp] = f2bf(hi);
            const float sr = sp[c * 132 + pp], si = sp[c * 132 + 64 + pp];
            const float nr = a.x * hr - a.y * hi + sr;
            const float ni = a.x * hi + a.y * hr + si;
            hr = nr; hi = ni;
          }
        }
        __syncthreads();
      }
    }
    xcd_barrier(xb);
    {
      const float* dsk = p.in[9] + (size_t)l * 1024;
      for (int tile = blockIdx.x; tile < 64 * 8; tile += gridDim.x) {
        const int g = tile >> 3, nt = (tile < 256) ? 7 - (tile & 7) : (tile & 7);
        const int nks1 = 2 * nt + 2;
        const u16* ktab = KTAB + ((size_t)l * 64 + g) * 64 * 256;
        const u16* w3p = W3T + ((size_t)l * 64 + g) * 1024 * 128;
        const u16* hp = HIN + (size_t)g * 128 * 128;
        gemm_tile(smem, 0, nt * 128, nks1 + 2,
                  [=](int ks) { return ks < nks1 ? ks * 64 : 1024 + (ks - nks1) * 64; },
                  [=](int m, int k0, int kc) {
                    if (k0 < 1024) return ldg_o(UZ + (size_t)(k0 >> 4) * 2048 + g * 16, (uint32_t)((m * 64 + (kc >> 4)) * 2048 + (kc & 15)) * 2u);
                    return ldg_o(hp + (k0 - 1024), (uint32_t)(m * 128 + kc) * 2u);
                  },
                  [=](int n, int k0, int kc) {
                    if (k0 < 1024) {
                      const int lag = (n >> 4) - (kc >> 4) - (k0 >> 4);
                      if (lag < 0) return make_uint4(0u, 0u, 0u, 0u);
                      return ldg_o(ktab, (uint32_t)((lag * 16 + (n & 15)) * 16 + (kc & 15)) * 2u);
                    }
                    return ldg_o(w3p + (k0 - 1024), (uint32_t)(n * 128 + kc) * 2u);
                  },
                  [=](int m, int n, f32x4 v) {
                    const int t = n >> 4, co = n & 15;
                    const size_t tok = (size_t)m * 64 + t;
                    const int ch = g * 16 + co;
                    const f32x4 u = ld_bf4(UZ + tok * 2048 + ch);
                    const f32x4 d = *(const f32x4*)(dsk + ch);
                    f32x4 r;
#pragma unroll
                    for (int i = 0; i < 4; ++i) r[i] = gelu_tanh(v[i] + d[i] * u[i]);
                    st_bf4(GB + tok * 1024 + ch, r);
                  });
      }
    }
    xcd_barrier(xb);
    {
      const u16* Wt = W_GLU + (size_t)l * 1024 * 1024;
      const float* bg = p.in[11] + (size_t)l * 1024;
      for (int tile = blockIdx.x; tile < 64 * 8; tile += gridDim.x) {
        const int mt = tile & 63, nt = tile >> 6;
        gemm_tile(smem, mt * 128, nt * 128, 16, kmap64,
                  [=](int m, int k0, int kc) { return ldg_o(GB + k0, (uint32_t)(m * 1024 + kc) * 2u); },
                  [=](int n, int k0, int kc) { return ldg_o(Wt + k0, (uint32_t)(n * 1024 + kc) * 2u); },
                  [=](int m, int n, f32x4 v) {
                    const f32x4 gg = ld_bf4(GB + (size_t)m * 1024 + n);
                    const f32x4 zz = ld_bf4(UZ + (size_t)m * 2048 + 1024 + n);
                    const f32x4 bb = *(const f32x4*)(bg + n);
                    f32x4 r;
#pragma unroll
                    for (int i = 0; i < 4; ++i) r[i] = gg[i] * sigm(v[i] + bb[i]) * silu(zz[i]);
                    st_bf4(VB + (size_t)m * 1024 + n, r);
                  });
      }
    }
    xcd_barrier(xb);
    {
      const u16* Wt = W_AOUT + (size_t)l * 2048 * 1024;
      for (int tile = blockIdx.x; tile < 64 * 8; tile += gridDim.x) {
        const int mt = tile & 63, nt = tile >> 6;
        const float2* stp = STATS;
        const float* pgam = p.in[22] + (size_t)(l > 0 ? l - 1 : 0) * 2048;
        const float* pbet = p.in[23] + (size_t)(l > 0 ? l - 1 : 0) * 2048;
        gemm_tile_w<true>(smem, mt * 128, nt * 256, 32,
                  [=](int m, int k0, int kc) { return ldg_o(VB + k0, (uint32_t)(m * 1024 + kc) * 2u); },
                  [=](int n, int k0, int kc) { return ldg_o(Wt + k0, (uint32_t)(n * 1024 + kc) * 2u); },
                  [=](int m, int n, f32x4 v, f32x4 xr) {
                    if (l > 0) {
                      const float2 st = stp[m];
                      const f32x4 gg = *(const f32x4*)(pgam + n);
                      const f32x4 bb = *(const f32x4*)(pbet + n);
#pragma unroll
                      for (int i = 0; i < 4; ++i) xr[i] = (xr[i] - st.x) * st.y * gg[i] + bb[i];
                    }
                    f32x4 r;
#pragma unroll
                    for (int i = 0; i < 4; ++i) r[i] = DN_ALPHA * xr[i] + v[i];
                    *(f32x4*)((char*)XF + (uint32_t)(m * 2048 + n) * 4u) = r;
                  },
                  [=](int m, int n) { return *(const f32x4*)((const char*)xres + (uint32_t)(m * 2048 + n) * 4u); });
      }
    }
    xcd_barrier(xb);
    {
      const int tid = tid_l(), lane = tid & 63, wave = tid >> 6; (void)lane; (void)wave;
      const float* lg_ = p.in[22] + (size_t)l * 2048;
      const float* lb_ = p.in[23] + (size_t)l * 2048;
      for (int row = blockIdx.x * 4 + wave; row < NTOK; row += gridDim.x * 4) {
        float* xr = XF + (size_t)row * 2048;
        f32x4 v[8];
        float sum = 0.f;
#pragma unroll
        for (int i = 0; i < 8; ++i) { v[i] = *(const f32x4*)(xr + i * 256 + lane * 4); sum += v[i][0] + v[i][1] + v[i][2] + v[i][3]; }
#pragma unroll
        for (int o = 32; o >= 1; o >>= 1) sum += __shfl_xor(sum, o);
        const float mu = sum * (1.f / 2048.f);
        float sq = 0.f;
#pragma unroll
        for (int i = 0; i < 8; ++i)
#pragma unroll
          for (int e = 0; e < 4; ++e) { const float d = v[i][e] - mu; sq += d * d; }
#pragma unroll
        for (int o = 32; o >= 1; o >>= 1) sq += __shfl_xor(sq, o);
        const float rstd = rsqrtf(sq * (1.f / 2048.f) + LN_EPS);
#pragma unroll
        for (int i = 0; i < 8; ++i) {
          const int c = i * 256 + lane * 4;
          const f32x4 gg = *(const f32x4*)(lg_ + c);
          const f32x4 bb = *(const f32x4*)(lb_ + c);
          f32x4 r;
#pragma unroll
          for (int e = 0; e < 4; ++e) r[e] = (v[i][e] - mu) * rstd * gg[e] + bb[e];
          st_bf4(XB + (size_t)row * 2048 + c, r);
        }
        if (lane == 0) STATS[row] = make_float2(mu, rstd);
      }
    }
    xcd_barrier(xb);
  }

  {
    for (int tile = blockIdx.x; tile < 64 * 24; tile += gridDim.x) {
      const int mt = tile & 63, nt = tile >> 6;
      gemm_tile(smem, mt * 128, nt * 128, 32, kmap64,
                [=](int m, int k0, int kc) { return ldg_o(XB + k0, (uint32_t)(m * 2048 + kc) * 2u); },
                [=](int n, int k0, int kc) { return ldg_o(W_KV + k0, (uint32_t)(n * 2048 + kc) * 2u); },
                [=](int m, int n, f32x4 v) { st_bf4(KV + (size_t)m * KV_LD + n, v); });
    }
  }
  xcd_barrier(xb);
  for (int lb = 0; lb < 2; ++lb) {
    const int layer = 2 + lb;
    {
      const u16* Wt = W_BIN + (size_t)lb * PROJ_LD * 2048;
      if (lb == 0 && blockIdx.x >= 64 && blockIdx.x < 128) {
        const int ct = blockIdx.x - 64;
        const int half = ct >> 5, kvs = (ct >> 4) & 1, mt = ct & 15;
        const u16* Wc = W_C1 + (size_t)kvs * 128 * 4096;
        float* t1 = T1P + ((size_t)(half * 2 + kvs)) * 2048 * 128;
        gemm_tile<1>(smem, mt * 128, 0, 32, [=](int ks) { return half * 2048 + ks * 64; },
                  [=](int m, int k0, int kc) {
                    const int b = m >> 10, n = (m >> 2) & 255, g = m & 3;
                    int tok = n * 16 + (k0 >> 7);
                    tok = tok > 4095 ? 4095 : tok;
                    return ldg_o(KV + kvs * 512 + (k0 & 127), (uint32_t)((b * 4096 + tok) * KV_LD + g * 128 + kc) * 2u);
                  },
                  [=](int n, int k0, int kc) { return ldg_o(Wc + k0, (uint32_t)(n * 4096 + kc) * 2u); },
                  [=](int m, int n, f32x4 v) { *(f32x4*)(t1 + (size_t)m * 128 + n) = v; });
      }
      for (int rep = 0; rep < REPS_BIN; ++rep)
      for (int tile = blockIdx.x; tile < 64 * 32; tile += gridDim.x) {
        const int mt = tile & 63, nt = tile >> 6;
        gemm_tile_w(smem, mt * 128, nt * 256, 64,
                  [=](int m, int k0, int kc) { return ldg_o(XB + k0, (uint32_t)(m * 2048 + kc) * 2u); },
                  [=](int n, int k0, int kc) { return ldg_o(Wt + k0, (uint32_t)(n * 2048 + kc) * 2u); },
                  [=](int m, int n, f32x4 v) { st_bf4(PROJ + (size_t)m * PROJ_LD + n, v); });
      }
      for (int tile = blockIdx.x; tile < 64; tile += gridDim.x) {
        const int mt = tile & 63, nt = 64;
        gemm_tile(smem, mt * 128, nt * 128, 32, kmap64,
                  [=](int m, int k0, int kc) { return ldg_o(XB + k0, (uint32_t)(m * 2048 + kc) * 2u); },
                  [=](int n, int k0, int kc) { return ldg_o(Wt + k0, (uint32_t)(n * 2048 + kc) * 2u); },
                  [=](int m, int n, f32x4 v) { st_bf4(PROJ + (size_t)m * PROJ_LD + n, v); });
      }
    }
    xcd_barrier(xb);
    if (lb == 0) {
      do_jobs((1u << 13) | (1u << 14), 32, (int)gridDim.x - 32);
      for (int tile = blockIdx.x; tile < 32; tile += gridDim.x) {
        const int kvs = tile >> 4, mt = tile & 15;
        const u16* Wt = W_C2 + (size_t)kvs * 128 * 128;
        const float* t1a = T1P + ((size_t)kvs) * 2048 * 128;
        const float* t1b = T1P + ((size_t)(2 + kvs)) * 2048 * 128;
        const float* cb = C1B + kvs * 128;
        u16* kc_ = KCVC + (size_t)kvs * 2048 * 128;
        gemm_tile<1>(smem, mt * 128, 0, 2, kmap64,
                  [=](int m, int k0, int kc) {
                    const int k = k0 + kc;
                    const f32x4 a0 = *(const f32x4*)(t1a + (size_t)m * 128 + k), a1 = *(const f32x4*)(t1a + (size_t)m * 128 + k + 4);
                    const f32x4 b0 = *(const f32x4*)(t1b + (size_t)m * 128 + k), b1 = *(const f32x4*)(t1b + (size_t)m * 128 + k + 4);
                    const f32x4 c0 = *(const f32x4*)(cb + k), c1 = *(const f32x4*)(cb + k + 4);
                    uint4 r;
                    r.x = pack2(gelu_tanh(a0[0] + b0[0] + c0[0]), gelu_tanh(a0[1] + b0[1] + c0[1]));
                    r.y = pack2(gelu_tanh(a0[2] + b0[2] + c0[2]), gelu_tanh(a0[3] + b0[3] + c0[3]));
                    r.z = pack2(gelu_tanh(a1[0] + b1[0] + c1[0]), gelu_tanh(a1[1] + b1[1] + c1[1]));
                    r.w = pack2(gelu_tanh(a1[2] + b1[2] + c1[2]), gelu_tanh(a1[3] + b1[3] + c1[3]));
                    return r;
                  },
                  [=](int n, int k0, int kc) { return ldg_o(Wt + k0, (uint32_t)(n * 128 + kc) * 2u); },
                  [=](int m, int n, f32x4 v) {
                    if (((m >> 2) & 255) == 255) v = f32x4{0.f, 0.f, 0.f, 0.f};
                    st_bf4(kc_ + (size_t)m * 128 + n, v);
                  });
      }
      xcd_barrier(xb);
    }
#ifndef NO_ATTN
    {
      u16* sK = smem;
      u16* sV = smem + 2 * 64 * 136;
      uint32_t* imp = (uint32_t*)(smem + 2 * 64 * 136 + 2 * 64 * 144);
      unsigned long long* selm = (unsigned long long*)(imp + 32 * 65);
      const int tid = tid_l(), lane = tid & 63, wave = tid >> 6;
      const int l15 = lane & 15, quad = lane >> 4;
      const u16* KC = KCVC;
      const u16* VC = KCVC + (size_t)2048 * 128;
      for (int rep = 0; rep < REPS_ATTN; ++rep)
      for (int item = blockIdx.x; item < 1024; item += gridDim.x) {
        const int qt = (item < 512) ? (127 - (item >> 3)) : ((item - 512) >> 3);
        const int bg = item & 7, b = bg >> 2, g = bg & 3;
        const int t0 = qt * 32, h = g * 4 + wave;
        const size_t tokbase = (size_t)b * SEQ;
        const int cur = t0 >> 6;
        if (DESYNC_COND) __builtin_amdgcn_s_sleep(60);
        for (int i = tid; i < 32 * 65; i += 256) imp[i] = 0u;
        bf16x8 qf[2][4];
#pragma unroll
        for (int qs = 0; qs < 2; ++qs)
#pragma unroll
          for (int ds = 0; ds < 4; ++ds) {
            uint4 v = ldg16(PROJ + (tokbase + t0 + qs * 16 + l15) * PROJ_LD + h * 128 + ds * 32 + quad * 8);
            union { uint4 u; bf16x8 v; } cv; cv.u = v; qf[qs][ds] = cv.v;
          }
        const int tq0 = t0 + l15, tq1 = t0 + 16 + l15;
        f32x4 o[2][8];
        float mrow[2], lrow[2], linv[2];
        auto zero_o = [&]() {
#pragma unroll
          for (int qs = 0; qs < 2; ++qs)
#pragma unroll
            for (int dt = 0; dt < 8; ++dt) o[qs][dt] = f32x4{0.f, 0.f, 0.f, 0.f};
        };
        auto finish_l = [&]() {
#pragma unroll
          for (int qs = 0; qs < 2; ++qs) {
            float lsum = lrow[qs];
            lsum += __shfl_xor(lsum, 16);
            lsum += __shfl_xor(lsum, 32);
            linv[qs] = 1.f / fmaxf(lsum, 1e-30f);
          }
        };
        auto emit = [&](int br, bool first, bool scale_l) {
          float* wbuf = (float*)smem + wave * (16 * 132);
          const int rrow = lane >> 5, rcol = (lane & 31) * 4;
          const int tb = (int)tokbase + t0;
          const uint32_t zoff0 = (uint32_t)((tb + rrow) * PROJ_LD + 2048 + br * 2048 + h * 128 + rcol) * 2u;
          const uint32_t yoff0 = (uint32_t)((tb + rrow) * 2048 + h * 128 + rcol) * 2u;
          const u16 graw0 = *(const u16*)((const char*)PROJ + (uint32_t)((tb + l15) * PROJ_LD + 8192 + br * 16 + h) * 2u);
          const u16 graw1 = *(const u16*)((const char*)PROJ + (uint32_t)((tb + 16 + l15) * PROJ_LD + 8192 + br * 16 + h) * 2u);
#pragma unroll
          for (int qs = 0; qs < 2; ++qs) {
            const float gate = sigm(bf2f(qs ? graw1 : graw0));
            const float sc = scale_l ? gate * linv[qs] : gate;
#pragma unroll
            for (int dt = 0; dt < 8; ++dt) *(f32x4*)(wbuf + l15 * 132 + dt * 16 + quad * 4) = o[qs][dt] * sc;
            __builtin_amdgcn_wave_barrier();
#pragma unroll 4
            for (int j = 0; j < 8; ++j) {
              const uint32_t zo = zoff0 + (uint32_t)((qs * 16 + j * 2) * PROJ_LD) * 2u;
              const uint32_t yo = yoff0 + (uint32_t)((qs * 16 + j * 2) * 2048) * 2u;
              const f32x4 a = *(const f32x4*)(wbuf + (j * 2 + rrow) * 132 + rcol);
              const f32x4 zz = ld_bf4((const u16*)((const char*)PROJ + zo));
              u16* yp = (u16*)((char*)YB + yo);
              f32x4 r;
#pragma unroll
              for (int e = 0; e < 4; ++e) r[e] = a[e] * silu(zz[e]);
              if (!first) {
                const f32x4 old = ld_bf4(yp);
#pragma unroll
                for (int e = 0; e < 4; ++e) r[e] += old[e];
              }
              st_bf4(yp, r);
            }
          }
          __syncthreads();
        };
#ifndef NO_CMP
        {
          int nmax = t0 >> 4; if (nmax > 254) nmax = 254;
          const int ntl = (nmax >> 6) + 1;
          auto tilefn = [&](int i, const u16*& kb, const u16*& vb, size_t& rs, int& kp) {
            const size_t off = (((size_t)b * 256 + i * 64) * 4 + g) * 128;
            kb = KC + off; vb = VC + off; rs = 512; kp = i * 64;
          };
          auto valid = [&](int kpos, int qs) { return kpos * 16 + 31 <= (qs ? tq1 : tq0); };
          mrow[0] = mrow[1] = -1e30f; lrow[0] = lrow[1] = 0.f; linv[0] = linv[1] = 1.f;
          auto nobias = [](int, int) { return 0.f; };
          auto allem = [](int) { return true; };
          attn_loop<1>(sK, sV, imp, ntl, tilefn, nobias, allem, valid, qf, o, mrow, lrow, linv);
          finish_l();
          zero_o();
          attn_loop<2>(sK, sV, imp, ntl, tilefn, nobias, allem, valid, qf, o, mrow, lrow, linv);
          emit(0, true, false);
        }
#endif
        {
#pragma unroll 1
          for (int tt = 0; tt < 8; ++tt) {
            const int tok = wave * 8 + tt;
            unsigned long long mask;
            if (cur < 16) {
              mask = (2ull << cur) - 1ull;
            } else {
              const uint32_t v = imp[tok * 65 + lane];
              const bool cand = (lane >= 1) && (lane <= cur - 2);
              const unsigned long long cm = __ballot(cand);
              uint32_t T = 0u;
#pragma unroll 1
              for (int bit = 30; bit >= 0; --bit) {
                const uint32_t tr = T | (1u << bit);
                const unsigned long long m = __ballot(v >= tr) & cm;
                if (__popcll(m) >= 13) T = tr;
              }
              const unsigned long long gt = __ballot(v > T) & cm;
              unsigned long long eq = __ballot(v == T) & cm;
              int need = 13 - (int)__popcll(gt);
              unsigned long long pick = 0ull;
              while (need > 0 && eq != 0ull) {
                const unsigned long long low = eq & (0ull - eq);
                pick |= low; eq ^= low; --need;
              }
              mask = gt | pick | 1ull | (1ull << cur) | (1ull << (cur - 1));
            }
            if (lane == 0) selm[tok] = mask;
          }
          __syncthreads();
        }
        const unsigned long long sm0 = selm[l15], sm1 = selm[16 + l15];
#ifndef NO_SEL
        {
          auto tilefn = [&](int i, const u16*& kb, const u16*& vb, size_t& rs, int& kp) {
            const size_t off = (tokbase + (size_t)i * 64) * KV_LD + 1024 + g * 128;
            kb = KV + off; vb = KV + off + 512; rs = KV_LD; kp = i * 64;
          };
          auto valid = [&](int kpos, int qs) { return kpos <= (qs ? tq1 : tq0); };
          auto biasfn = [&](int i, int qs) { return (((qs ? sm1 : sm0) >> i) & 1ull) ? 0.f : -1e30f; };
          auto emfn = [&](int i) { return i == cur; };
          mrow[0] = mrow[1] = -1e30f; lrow[0] = lrow[1] = 0.f;
          zero_o();
          attn_loop<0>(sK, sV, imp, cur + 1, tilefn, biasfn, emfn, valid, qf, o, mrow, lrow, linv);
          finish_l();
          emit(1, false, true);
        }
#endif
#ifndef NO_WIN
        {
          int jt0 = (t0 - 511) >> 6; if (jt0 < 0) jt0 = 0;
          auto tilefn = [&](int i, const u16*& kb, const u16*& vb, size_t& rs, int& kp) {
            const size_t off = (tokbase + (size_t)(jt0 + i) * 64) * KV_LD + 2048 + g * 128;
            kb = KV + off; vb = KV + off + 512; rs = KV_LD; kp = (jt0 + i) * 64;
          };
          auto valid = [&](int kpos, int qs) {
            const int t = qs ? tq1 : tq0;
            return (kpos <= t) && (kpos > t - 512);
          };
          auto biasfn = [](int, int) { return 0.f; };
          auto emfn = [&](int i) { const int kp = (jt0 + i) * 64; return !((kp + 63 <= t0) && (kp > t0 + 31 - 512)); };
          mrow[0] = mrow[1] = -1e30f; lrow[0] = lrow[1] = 0.f;
          zero_o();
          attn_loop<0>(sK, sV, imp, cur - jt0 + 1, tilefn, biasfn, emfn, valid, qf, o, mrow, lrow, linv);
          finish_l();
          emit(2, false, true);
        }
#endif
        __syncthreads();
      }
    }
#endif
    xcd_barrier(xb);
    {
      const u16* Wt = W_BOUT + (size_t)lb * 2048 * 2048;
      for (int tile = blockIdx.x; tile < 64 * 8; tile += gridDim.x) {
        const int mt = tile & 63, nt = tile >> 6;
        const float2* stp = STATS;
        const float* pgam = p.in[22] + (size_t)(layer - 1) * 2048;
        const float* pbet = p.in[23] + (size_t)(layer - 1) * 2048;
        gemm_tile_w<true>(smem, mt * 128, nt * 256, 64,
                  [=](int m, int k0, int kc) { return ldg_o(YB + k0, (uint32_t)(m * 2048 + kc) * 2u); },
                  [=](int n, int k0, int kc) { return ldg_o(Wt + k0, (uint32_t)(n * 2048 + kc) * 2u); },
                  [=](int m, int n, f32x4 v, f32x4 xr) {
                    const float2 st = stp[m];
                    const f32x4 gg = *(const f32x4*)(pgam + n);
                    const f32x4 bb = *(const f32x4*)(pbet + n);
                    f32x4 r;
#pragma unroll
                    for (int i = 0; i < 4; ++i) r[i] = DN_ALPHA * ((xr[i] - st.x) * st.y * gg[i] + bb[i]) + v[i];
                    *(f32x4*)((char*)XF + (uint32_t)(m * 2048 + n) * 4u) = r;
                  },
                  [=](int m, int n) { return *(const f32x4*)((const char*)XF + (uint32_t)(m * 2048 + n) * 4u); });
      }
    }
    xcd_barrier(xb);
    {
      const int tid = tid_l(), lane = tid & 63, wave = tid >> 6; (void)lane; (void)wave;
      const float* lg_ = p.in[22] + (size_t)layer * 2048;
      const float* lb_ = p.in[23] + (size_t)layer * 2048;
      const bool last = (lb == 1);
      for (int row = blockIdx.x * 4 + wave; row < NTOK; row += gridDim.x * 4) {
        float* xr = XF + (size_t)row * 2048;
        float* orow = last ? (p.out + (size_t)row * 2048) : xr;
        f32x4 v[8];
        float sum = 0.f;
#pragma unroll
        for (int i = 0; i < 8; ++i) { v[i] = *(const f32x4*)(xr + i * 256 + lane * 4); sum += v[i][0] + v[i][1] + v[i][2] + v[i][3]; }
#pragma unroll
        for (int o = 32; o >= 1; o >>= 1) sum += __shfl_xor(sum, o);
        const float mu = sum * (1.f / 2048.f);
        float sq = 0.f;
#pragma unroll
        for (int i = 0; i < 8; ++i)
#pragma unroll
          for (int e = 0; e < 4; ++e) { const float d = v[i][e] - mu; sq += d * d; }
#pragma unroll
        for (int o = 32; o >= 1; o >>= 1) sq += __shfl_xor(sq, o);
        const float rstd = rsqrtf(sq * (1.f / 2048.f) + LN_EPS);
#pragma unroll
        for (int i = 0; i < 8; ++i) {
          const int c = i * 256 + lane * 4;
          const f32x4 gg = *(const f32x4*)(lg_ + c);
          const f32x4 bb = *(const f32x4*)(lb_ + c);
          f32x4 r;
#pragma unroll
          for (int e = 0; e < 4; ++e) r[e] = (v[i][e] - mu) * rstd * gg[e] + bb[e];
          if (last) *(f32x4*)(orow + c) = r;
          else st_bf4(XB + (size_t)row * 2048 + c, r);
        }
        if (!last && lane == 0) STATS[row] = make_float2(mu, rstd);
      }
    }
    if (lb == 0) xcd_barrier(xb);
  }
}

extern "C" void kernel_launch(void* const* d_in, const int* in_sizes, int n_in, void* d_out, int out_size, void* d_ws,
                              size_t ws_size, hipStream_t stream) {
  static int grid_blocks = 0;
  if (!grid_blocks) {
    int dev = 0, cus = 0, per_cu = 0;
    hipGetDevice(&dev);
    hipDeviceGetAttribute(&cus, hipDeviceAttributeMultiprocessorCount, dev);
    hipOccupancyMaxActiveBlocksPerMultiprocessor(&per_cu, yoco_fwd, 256, 0);
    if (per_cu > 2) per_cu = 2;
    if (per_cu < 1) per_cu = 1;
    grid_blocks = cus * per_cu;
  }
  Params p{};
  for (int i = 0; i < 24; ++i) p.in[i] = (const float*)d_in[i];
  p.out = (float*)d_out;
  p.ws = (char*)d_ws;
  if (ws_size < WS_TOTAL) fprintf(stderr, "workspace too small: %zu < %zu\n", ws_size, (size_t)WS_TOTAL);
  (void)hipMemsetAsync((char*)d_ws + O_BAR, 0, XCD_BAR_WORDS * 4, stream);
  void* args[] = {&p};
  hipError_t e = hipLaunchCooperativeKernel((void*)yoco_fwd, dim3(grid_blocks), dim3(256), args, 0, stream);
  if (e != hipSuccess) fprintf(stderr, "cooperative launch failed: %s (grid %d)\n", hipGetErrorString(e), grid_blocks);
}
```

```cpp
#include <hip/hip_runtime.h>
#include <hip/hip_cooperative_groups.h>
#include <stdint.h>
#include <stdio.h>
namespace cg = cooperative_groups;

typedef __attribute__((ext_vector_type(8))) short bf16x8;
typedef __attribute__((ext_vector_type(4))) short s16x4;
typedef __attribute__((ext_vector_type(4))) float f32x4;
typedef unsigned short u16;
#define DI __device__ __forceinline__

#define DESYNC_COND (blockIdx.x >= 256)
#ifndef ATT_SAFE
#define ATT_SAFE 0
#endif
#ifndef REPS_ATTN
#define REPS_ATTN 1
#endif
#ifndef REPS_BIN
#define REPS_BIN 1
#endif
#ifndef REPS_SSM
#define REPS_SSM 1
#endif
#ifndef REPS_P0
#define REPS_P0 1
#endif
constexpr int NTOK = 8192, DM = 2048, SEQ = 4096, EW = 1024;
constexpr int PROJ_LD = 8320, BIN_N = 8240, KV_LD = 3072;
constexpr float DN_ALPHA = 1.681792830507429f;
constexpr float LN_EPS = 1e-5f;
constexpr float SCALE2 = 0.08838834764831845f * 1.4426950408889634f;

constexpr size_t al256(size_t x) { return (x + 255) & ~(size_t)255; }
constexpr size_t O_WAIN = 0;
constexpr size_t O_WGLU = O_WAIN + al256((size_t)2 * 2048 * 2048 * 2);
constexpr size_t O_WAOUT = O_WGLU + al256((size_t)2 * 1024 * 1024 * 2);
constexpr size_t O_WKV = O_WAOUT + al256((size_t)2 * 2048 * 1024 * 2);
constexpr size_t O_WC1 = O_WKV + al256((size_t)3072 * 2048 * 2);
constexpr size_t O_WC2 = O_WC1 + al256((size_t)2 * 128 * 4096 * 2);
constexpr size_t O_WBIN = O_WC2 + al256((size_t)2 * 128 * 128 * 2);
constexpr size_t O_WBOUT = O_WBIN + al256((size_t)2 * PROJ_LD * 2048 * 2);
constexpr size_t O_XB = O_WBOUT + al256((size_t)2 * 2048 * 2048 * 2);
constexpr size_t O_XF = O_XB + al256((size_t)NTOK * DM * 2);
constexpr size_t O_KV = O_XF + al256((size_t)NTOK * DM * 4);
constexpr size_t O_T1 = O_KV + al256((size_t)NTOK * KV_LD * 2);
constexpr size_t O_KCVC = O_T1 + al256((size_t)2 * 2 * 2048 * 128 * 4);
constexpr size_t O_C1B = O_KCVC + al256((size_t)2 * 2048 * 128 * 2);
constexpr size_t O_C1P = O_C1B + al256((size_t)2 * 128 * 4);
constexpr size_t O_BAR = O_C1P + al256((size_t)64 * 128 * 4);
constexpr size_t O_STATS = O_BAR + al256((size_t)4096 * 4);
constexpr size_t O_YB = O_STATS + al256((size_t)NTOK * 8);
constexpr size_t O_UNION = O_YB + al256((size_t)NTOK * DM * 2);
constexpr size_t O_UZ = O_UNION;
constexpr size_t O_G = O_UZ + al256((size_t)NTOK * 2048 * 2);
constexpr size_t O_V = O_G + al256((size_t)NTOK * 1024 * 2);
constexpr size_t O_S = O_V + al256((size_t)NTOK * 1024 * 2);
constexpr size_t O_HIN = O_S + al256((size_t)64 * 128 * 128 * 4);
constexpr size_t O_W1 = O_HIN + al256((size_t)64 * 128 * 128 * 2);
constexpr size_t O_W3T = O_W1 + al256((size_t)2 * 64 * 128 * 1024 * 2);
constexpr size_t O_KTAB = O_W3T + al256((size_t)2 * 64 * 1024 * 128 * 2);
constexpr size_t O_A64 = O_KTAB + al256((size_t)2 * 64 * 64 * 256 * 2);
constexpr size_t O_S5END = O_A64 + al256((size_t)2 * 64 * 64 * 8);
constexpr size_t O_PROJ = O_UNION;
constexpr size_t O_PROJEND = O_PROJ + al256((size_t)NTOK * PROJ_LD * 2);
constexpr size_t WS_TOTAL = (O_S5END > O_PROJEND ? O_S5END : O_PROJEND);

struct Params {
  const float* in[24];
  float* out;
  char* ws;
};

DI u16 f2bf(float f) { uint32_t u = __float_as_uint(f); u += 0x7fffu + ((u >> 16) & 1u); return (u16)(u >> 16); }
typedef float f32x2_t __attribute__((ext_vector_type(2)));
typedef __bf16 bf16x2_t __attribute__((ext_vector_type(2)));
DI uint32_t pack2(float a, float b) { f32x2_t v = {a, b}; bf16x2_t h = __builtin_convertvector(v, bf16x2_t); return __builtin_bit_cast(uint32_t, h); }
DI float bflo(uint32_t v) { return __uint_as_float(v << 16); }
DI float bfhi(uint32_t v) { return __uint_as_float(v & 0xffff0000u); }
DI float bf2f(u16 h) { return __uint_as_float(((uint32_t)h) << 16); }
DI uint4 ldg16(const void* p) { return *(const uint4*)p; }
DI uint4 ldg_o(const void* base, uint32_t byte_off) { return *(const uint4*)((const char*)base + byte_off); }
DI float sigm(float x) { return __builtin_amdgcn_rcpf(1.f + __expf(-x)); }
DI float silu(float x) { return x * sigm(x); }
DI float gelu_tanh(float x) { float u = 0.7978845608028654f * (x + 0.044715f * x * x * x); return x * sigm(2.f * u); }
DI void st_bf4(u16* p, f32x4 v) { uint2 o; o.x = pack2(v[0], v[1]); o.y = pack2(v[2], v[3]); *(uint2*)p = o; }
DI f32x4 ld_bf4(const u16* p) { uint2 o = *(const uint2*)p; f32x4 r; r[0] = bflo(o.x); r[1] = bfhi(o.x); r[2] = bflo(o.y); r[3] = bfhi(o.y); return r; }

DI int tid_l() { int t = threadIdx.x; asm volatile("" : "+v"(t)); return t; }


#define XB_TMO      128
#define XB_XCNT(j)  (256  + 64 * (j))
#define XB_XSUB(j)  (1280 + 64 * (j))
#define XB_XGEN(j)  (2304 + 64 * (j))
#define XB_TOP      3328
#define XB_TOPGEN   3392
#define XCD_BAR_WORDS 3456
#define XB_SPIN_CAP (1u << 22)
#define LAS __attribute__((address_space(3)))
DI unsigned xb_ld(unsigned* p) { return __hip_atomic_load(p, __ATOMIC_RELAXED, __HIP_MEMORY_SCOPE_AGENT); }
DI unsigned xb_add(unsigned* p, unsigned v) { return __hip_atomic_fetch_add(p, v, __ATOMIC_RELAXED, __HIP_MEMORY_SCOPE_AGENT); }
DI unsigned xb_xcc_id() { return (unsigned)__builtin_amdgcn_s_getreg((3 << 11) | 20) & 0xFu; }
#define XB_SPIN(cond, bar) do { unsigned _sp = 0; while (cond) { __builtin_amdgcn_s_sleep(1); \
    if ((++_sp & 255u) == 0u) { if (xb_ld(&(bar)[XB_TMO])) break; if (_sp > XB_SPIN_CAP) { atomicAdd(&(bar)[XB_TMO], 1u); break; } } } } while (0)
struct XcdBarrier { unsigned* bar; unsigned x; volatile LAS unsigned* st; };
DI XcdBarrier xcd_barrier_post(unsigned* bar, volatile LAS unsigned* st) {
  XcdBarrier b; b.bar = bar; b.x = xb_xcc_id(); b.st = st;
  if (threadIdx.x == 0) (void)xb_add(&bar[XB_XCNT(b.x)], 1u);
  return b;
}
DI void xcd_barrier_complete(unsigned* bar, unsigned x, unsigned& nloc, unsigned& nx) {
  const unsigned G = gridDim.x * gridDim.y * gridDim.z;
  unsigned sum, cnt, mine, sp = 0u;
  for (;;) {
    sum = 0u; cnt = 0u; mine = 0u;
#pragma unroll
    for (unsigned j = 0; j < 16; ++j) { const unsigned c = xb_ld(&bar[XB_XCNT(j)]); sum += c; cnt += (c > 0u) ? 1u : 0u; mine = (j == x) ? c : mine; }
    if (sum == G) break;
    __builtin_amdgcn_s_sleep(1);
    if ((++sp & 255u) == 0u) { if (xb_ld(&bar[XB_TMO])) break; if (sp > XB_SPIN_CAP) { atomicAdd(&bar[XB_TMO], 1u); break; } }
  }
  nloc = mine > 0u ? mine : 1u; nx = cnt > 0u ? cnt : 1u;
}
DI void xcd_barrier(const XcdBarrier& b) {
  asm volatile("s_waitcnt vmcnt(0)" ::: "memory");
  __syncthreads();
  if (threadIdx.x == 0) {
    unsigned* bar = b.bar;
    __builtin_amdgcn_s_waitcnt(0);
    unsigned nloc = b.st[0], nx = b.st[1];
    if (nloc == 0u) { xcd_barrier_complete(bar, b.x, nloc, nx); b.st[0] = nloc; b.st[1] = nx; }
    const unsigned old = xb_add(&bar[XB_XSUB(b.x)], 1u);
    const unsigned gen = old / nloc;
    if (old + 1u == (gen + 1u) * nloc) {
      __builtin_amdgcn_fence(__ATOMIC_RELEASE, "agent");
      asm volatile("s_waitcnt vmcnt(0)" ::: "memory");
      const unsigned og = xb_add(&bar[XB_TOP], 1u);
      const unsigned tg = og / nx;
      if (og + 1u == (tg + 1u) * nx) xb_add(&bar[XB_TOPGEN], 1u);
      else XB_SPIN(xb_ld(&bar[XB_TOPGEN]) == tg, bar);
      __builtin_amdgcn_fence(__ATOMIC_ACQUIRE, "agent");
      xb_add(&bar[XB_XGEN(b.x)], 1u);
      asm volatile("s_waitcnt vmcnt(0)" ::: "memory");
    } else {
      XB_SPIN(xb_ld(&bar[XB_XGEN(b.x)]) == gen, bar);
      __builtin_amdgcn_fence(__ATOMIC_ACQUIRE, "agent");
      asm volatile("s_waitcnt vmcnt(0)" ::: "memory");
    }
  }
  __syncthreads();
}

template <int DEPTH = 2, bool STAGED = true, class KMAP, class LA, class LW, class EPI>
DI void gemm_tile(u16* smem, int m0, int n0, int nks, KMAP kmap, LA loadA, LW loadW, EPI epi) {
  const int tid = tid_l(), lane = tid & 63, wave = tid >> 6;
  const int wm = wave >> 1, wn = wave & 1, l15 = lane & 15, quad = lane >> 4;
  u16* sX = smem;
  u16* sW = smem + 2 * 128 * 64;
  f32x4 acc[4][4];
#pragma unroll
  for (int i = 0; i < 4; ++i)
#pragma unroll
    for (int j = 0; j < 4; ++j) acc[i][j] = f32x4{0.f, 0.f, 0.f, 0.f};
  uint4 ra0[4], rw0[4], ra1[4], rw1[4];
  const int lrow = tid >> 3, lkc = (tid & 7) * 8;
  const int wpos = (((tid & 7) ^ ((tid >> 4) & 7)) * 8);
  const int rsw = (l15 >> 1) & 7;
  const int rp0 = ((quad ^ rsw) * 8), rp1 = (((4 + quad) ^ rsw) * 8);
#define G_LOAD(RA, RW, KS) { const int k0_ = __builtin_amdgcn_readfirstlane(kmap(KS)); _Pragma("unroll") for (int i = 0; i < 4; ++i) { RA[i] = loadA(m0 + lrow + i * 32, k0_, lkc); RW[i] = loadW(n0 + lrow + i * 32, k0_, lkc); } }
#define G_STORE(RA, RW, BUF) { u16* dx_ = sX + (BUF) * 128 * 64; u16* dw_ = sW + (BUF) * 128 * 64; _Pragma("unroll") for (int i = 0; i < 4; ++i) { \
    *(uint4*)(dx_ + (lrow + i * 32) * 64 + wpos) = RA[i]; *(uint4*)(dw_ + (lrow + i * 32) * 64 + wpos) = RW[i]; } }
#define G_COMPUTE(BUF, FENCE) { const u16* bx = sX + (BUF) * 128 * 64 + (wm * 64 + l15) * 64; const u16* bw = sW + (BUF) * 128 * 64 + (wn * 64 + l15) * 64; \
    bf16x8 xf[2][4], wf[2][4]; \
    _Pragma("unroll") for (int i = 0; i < 4; ++i) { \
      xf[0][i] = *(const bf16x8*)(bx + i * 16 * 64 + rp0); wf[0][i] = *(const bf16x8*)(bw + i * 16 * 64 + rp0); } \
    _Pragma("unroll") for (int i = 0; i < 4; ++i) { \
      xf[1][i] = *(const bf16x8*)(bx + i * 16 * 64 + rp1); wf[1][i] = *(const bf16x8*)(bw + i * 16 * 64 + rp1); } \
    if (FENCE) __builtin_amdgcn_sched_barrier(0); \
    _Pragma("unroll") for (int kk = 0; kk < 2; ++kk) { \
      _Pragma("unroll") for (int ni = 0; ni < 4; ++ni) _Pragma("unroll") for (int mi = 0; mi < 4; ++mi) \
          acc[ni][mi] = __builtin_amdgcn_mfma_f32_16x16x32_bf16(wf[kk][ni], xf[kk][mi], acc[ni][mi], 0, 0, 0); \
      if (FENCE) __builtin_amdgcn_sched_barrier(0); } }
#define G_PATTERN { __builtin_amdgcn_sched_group_barrier(0x100, 16, 0); \
    _Pragma("unroll") for (int q_ = 0; q_ < 8; ++q_) { __builtin_amdgcn_sched_group_barrier(0x008, 2, 0); __builtin_amdgcn_sched_group_barrier(0x020, 1, 0); } \
    _Pragma("unroll") for (int q_ = 0; q_ < 8; ++q_) { __builtin_amdgcn_sched_group_barrier(0x008, 2, 0); __builtin_amdgcn_sched_group_barrier(0x200, 1, 0); } }
  if (DEPTH == 2) {
    G_LOAD(ra0, rw0, 0);
    G_LOAD(ra1, rw1, 1);
    G_STORE(ra0, rw0, 0);
    __syncthreads();
    for (int ks = 0; ks < nks; ks += 2) {
      G_LOAD(ra0, rw0, (ks + 2 < nks ? ks + 2 : nks - 1));
      G_COMPUTE(0, 0);
      G_STORE(ra1, rw1, 1);
      G_PATTERN;
      __syncthreads();
      G_LOAD(ra1, rw1, (ks + 3 < nks ? ks + 3 : nks - 1));
      G_COMPUTE(1, 0);
      G_STORE(ra0, rw0, 0);
      G_PATTERN;
      __syncthreads();
    }
  } else {
    G_LOAD(ra0, rw0, 0);
    G_STORE(ra0, rw0, 0);
    __syncthreads();
    for (int ks = 0; ks < nks; ++ks) {
      const int buf = ks & 1;
      if (ks + 1 < nks) G_LOAD(ra0, rw0, ks + 1);
      G_COMPUTE(buf, 1);
      if (ks + 1 < nks) G_STORE(ra0, rw0, buf ^ 1);
      __syncthreads();
    }
  }
#undef G_LOAD
#undef G_STORE
#undef G_COMPUTE
#undef G_PATTERN
  if constexpr (!STAGED) {
#pragma unroll
    for (int ni = 0; ni < 4; ++ni)
#pragma unroll
      for (int mi = 0; mi < 4; ++mi)
        epi(m0 + wm * 64 + mi * 16 + l15, n0 + wn * 64 + ni * 16 + quad * 4, acc[ni][mi]);
  } else {
    float* wbuf = (float*)smem + wave * (16 * 68);
    const int rrow = lane >> 4, rcol = (lane & 15) * 4;
#pragma unroll
    for (int mi = 0; mi < 4; ++mi) {
#pragma unroll
      for (int ni = 0; ni < 4; ++ni) *(f32x4*)(wbuf + l15 * 68 + ni * 16 + quad * 4) = acc[ni][mi];
      __builtin_amdgcn_wave_barrier();
#pragma unroll
      for (int j = 0; j < 4; ++j) {
        const f32x4 a = *(const f32x4*)(wbuf + (j * 4 + rrow) * 68 + rcol);
        epi(m0 + wm * 64 + mi * 16 + j * 4 + rrow, n0 + wn * 64 + rcol, a);
      }
    }
    __syncthreads();
  }
}

template <bool HASPRE = false, class LA, class LW, class EPI, class PRE = int>
DI void gemm_tile_w(u16* smem, int m0, int n0, int nks, LA loadA, LW loadW, EPI epi, PRE pre = 0) {
  const int tid = tid_l(), lane = tid & 63, wave = tid >> 6;
  const int wm = wave >> 1, wn = wave & 1, l15 = lane & 15, quad = lane >> 4;
  u16* sX = smem;
  u16* sW = smem + 2 * 128 * 32;
  f32x4 acc[8][4];
#pragma unroll
  for (int i = 0; i < 8; ++i)
#pragma unroll
    for (int j = 0; j < 4; ++j) acc[i][j] = f32x4{0.f, 0.f, 0.f, 0.f};
  uint4 ra0[2], rw0[4], ra1[2], rw1[4];
  const int lrow = tid >> 2, lkc = (tid & 3) * 8;
  const int wpos = ((tid & 3) ^ ((0 - (tid >> 4)) & 3)) * 8;
  const int rpos = (quad ^ ((0 - (l15 >> 2)) & 3)) * 8;
#define W_LOAD(RA, RW, KS) { const int k0_ = __builtin_amdgcn_readfirstlane((KS) * 32); \
    _Pragma("unroll") for (int i = 0; i < 2; ++i) RA[i] = loadA(m0 + lrow + i * 64, k0_, lkc); \
    _Pragma("unroll") for (int i = 0; i < 4; ++i) RW[i] = loadW(n0 + lrow + i * 64, k0_, lkc); }
#define W_STORE(RA, RW, BUF) { u16* dx_ = sX + (BUF) * 128 * 32; u16* dw_ = sW + (BUF) * 256 * 32; \
    _Pragma("unroll") for (int i = 0; i < 2; ++i) *(uint4*)(dx_ + (lrow + i * 64) * 32 + wpos) = RA[i]; \
    _Pragma("unroll") for (int i = 0; i < 4; ++i) *(uint4*)(dw_ + (lrow + i * 64) * 32 + wpos) = RW[i]; }
#define W_COMPUTE(BUF) { const u16* bx = sX + (BUF) * 128 * 32 + (wm * 64 + l15) * 32 + rpos; const u16* bw = sW + (BUF) * 256 * 32 + (wn * 128 + l15) * 32 + rpos; \
    bf16x8 xf[4], wf[8]; \
    _Pragma("unroll") for (int i = 0; i < 4; ++i) xf[i] = *(const bf16x8*)(bx + i * 16 * 32); \
    _Pragma("unroll") for (int i = 0; i < 8; ++i) wf[i] = *(const bf16x8*)(bw + i * 16 * 32); \
    _Pragma("unroll") for (int ni = 0; ni < 8; ++ni) _Pragma("unroll") for (int mi = 0; mi < 4; ++mi) \
        acc[ni][mi] = __builtin_amdgcn_mfma_f32_16x16x32_bf16(wf[ni], xf[mi], acc[ni][mi], 0, 0, 0); }
#define W_PATTERN { __builtin_amdgcn_sched_group_barrier(0x100, 12, 0); \
    _Pragma("unroll") for (int q_ = 0; q_ < 6; ++q_) { __builtin_amdgcn_sched_group_barrier(0x008, 2, 0); __builtin_amdgcn_sched_group_barrier(0x020, 1, 0); } \
    _Pragma("unroll") for (int q_ = 0; q_ < 6; ++q_) { __builtin_amdgcn_sched_group_barrier(0x008, 3, 0); __builtin_amdgcn_sched_group_barrier(0x200, 1, 0); } \
    __builtin_amdgcn_sched_group_barrier(0x008, 2, 0); }
  W_LOAD(ra0, rw0, 0);
  W_LOAD(ra1, rw1, 1);
  W_STORE(ra0, rw0, 0);
  __syncthreads();
  for (int ks = 0; ks < nks; ks += 2) {
    W_LOAD(ra0, rw0, (ks + 2 < nks ? ks + 2 : nks - 1));
    W_COMPUTE(0);
    W_STORE(ra1, rw1, 1);
    W_PATTERN;
    __syncthreads();
    W_LOAD(ra1, rw1, (ks + 3 < nks ? ks + 3 : nks - 1));
    W_COMPUTE(1);
    W_STORE(ra0, rw0, 0);
    W_PATTERN;
    __syncthreads();
  }
#undef W_LOAD
#undef W_STORE
#undef W_COMPUTE
#undef W_PATTERN
  if constexpr (HASPRE) {
    float* wbuf = (float*)smem + wave * (16 * 132);
    const int rrow = lane >> 5, rcol = (lane & 31) * 4;
#pragma unroll
    for (int mi = 0; mi < 4; ++mi) {
#pragma unroll
      for (int ni = 0; ni < 8; ++ni) *(f32x4*)(wbuf + l15 * 132 + ni * 16 + quad * 4) = acc[ni][mi];
      __builtin_amdgcn_wave_barrier();
      f32x4 pv[8];
#pragma unroll
      for (int j = 0; j < 8; ++j) pv[j] = pre(m0 + wm * 64 + mi * 16 + j * 2 + rrow, n0 + wn * 128 + rcol);
#pragma unroll
      for (int j = 0; j < 8; ++j) {
        const f32x4 a = *(const f32x4*)(wbuf + (j * 2 + rrow) * 132 + rcol);
        epi(m0 + wm * 64 + mi * 16 + j * 2 + rrow, n0 + wn * 128 + rcol, a, pv[j]);
      }
    }
    __syncthreads();
  } else {
    float* wbuf = (float*)smem + wave * (16 * 132);
    const int rrow = lane >> 5, rcol = (lane & 31) * 4;
#pragma unroll
    for (int mi = 0; mi < 4; ++mi) {
#pragma unroll
      for (int ni = 0; ni < 8; ++ni) *(f32x4*)(wbuf + l15 * 132 + ni * 16 + quad * 4) = acc[ni][mi];
      __builtin_amdgcn_wave_barrier();
#pragma unroll
      for (int j = 0; j < 8; ++j) {
        const f32x4 a = *(const f32x4*)(wbuf + (j * 2 + rrow) * 132 + rcol);
        epi(m0 + wm * 64 + mi * 16 + j * 2 + rrow, n0 + wn * 128 + rcol, a);
      }
    }
    __syncthreads();
  }
}

DI void tconv(float* tl, const float* src, u16* dst, int K, int N, int Npad, int b0, int nb) {
  const int tid = tid_l();
  const int nkt = K >> 6, nnt = Npad >> 6, ntl = nkt * nnt;
  const int r = tid >> 4, c4 = (tid & 15) * 4;
  float4 v[4];
  int tile = (int)blockIdx.x - b0;
  auto ld = [&](int t) {
    const int kt = t % nkt, nt = t / nkt;
    const int k0 = kt * 64, n0 = nt * 64;
#pragma unroll
    for (int i = 0; i < 4; ++i) {
      v[i] = make_float4(0.f, 0.f, 0.f, 0.f);
      if (n0 + c4 < N) {
        const f32x4 t = __builtin_nontemporal_load((const f32x4*)(src + (size_t)(k0 + r + i * 16) * N + n0 + c4));
        v[i] = make_float4(t[0], t[1], t[2], t[3]);
      }
    }
  };
  if (tile < ntl) ld(tile);
  for (; tile < ntl; tile += nb) {
    const int kt = tile % nkt, nt = tile / nkt;
    const int k0 = kt * 64, n0 = nt * 64;
#pragma unroll
    for (int i = 0; i < 4; ++i) {
      const int k = r + i * 16;
      tl[k * 65 + c4 + 0] = v[i].x; tl[k * 65 + c4 + 1] = v[i].y; tl[k * 65 + c4 + 2] = v[i].z; tl[k * 65 + c4 + 3] = v[i].w;
    }
    if (tile + nb < ntl) ld(tile + nb);
    __syncthreads();
#pragma unroll
    for (int i = 0; i < 2; ++i) {
      const int c = tid + i * 256;
      const int n = c >> 3, k8 = (c & 7) * 8;
      uint4 o;
      o.x = pack2(tl[(k8 + 0) * 65 + n], tl[(k8 + 1) * 65 + n]);
      o.y = pack2(tl[(k8 + 2) * 65 + n], tl[(k8 + 3) * 65 + n]);
      o.z = pack2(tl[(k8 + 4) * 65 + n], tl[(k8 + 5) * 65 + n]);
      o.w = pack2(tl[(k8 + 6) * 65 + n], tl[(k8 + 7) * 65 + n]);
      *(uint4*)(dst + (size_t)(n0 + n) * K + k0 + k8) = o;
    }
    __syncthreads();
  }
}

template <int MODE, class TILE, class BIAS, class EM, class MASK>
DI void attn_loop(u16* sK, u16* sV, uint32_t* imp, int ntiles, TILE tilefn, BIAS biasfn, EM emfn, MASK valid, const bf16x8 (&qf)[2][4],
                  f32x4 (&o)[2][8], float (&mrow)[2], float (&lrow)[2], const float (&linv)[2]) {
  const int tid = tid_l(), lane = tid & 63;
  const int l15 = lane & 15, quad = lane >> 4;
  const int lr = tid >> 4, lc = (tid & 15) * 8;
  uint4 rk[4];
#define K_LOAD(IT) { const u16 *kb_, *vb_; size_t rs_; int kp_; tilefn(IT, kb_, vb_, rs_, kp_); _Pragma("unroll") for (int i = 0; i < 4; ++i) rk[i] = ldg_o(kb_, (uint32_t)((lr + i * 16) * (int)rs_ + lc) * 2u); }
#define V_LOAD_G(IT) { const u16 *kb_, *vb_; size_t rs_; int kp_; tilefn(IT, kb_, vb_, rs_, kp_); _Pragma("unroll") for (int i = 0; i < 4; ++i) rk[i] = ldg_o(vb_, (uint32_t)((lr + i * 16) * (int)rs_ + lc) * 2u); }
#define K_STORE(BUF) { _Pragma("unroll") for (int i = 0; i < 4; ++i) *(uint4*)(sK + (BUF) * 64 * 136 + (lr + i * 16) * 136 + lc) = rk[i]; }
#define V_STORE(BUF) { _Pragma("unroll") for (int i = 0; i < 4; ++i) *(uint4*)(sV + (BUF) * 64 * 144 + (lr + i * 16) * 144 + lc) = rk[i]; }
  auto compute = [&](const int buf, const int it, auto midfn) {
    int kpos0;
    { const u16 *kb, *vb; size_t rs; tilefn(it, kb, vb, rs, kpos0); }
    f32x4 s[4][2];
#pragma unroll
    for (int kc = 0; kc < 4; ++kc) { s[kc][0] = f32x4{0.f, 0.f, 0.f, 0.f}; s[kc][1] = f32x4{0.f, 0.f, 0.f, 0.f}; }
    const u16* kbase = sK + buf * 64 * 136 + l15 * 136 + quad * 8;
    {
      bf16x8 kf[2][2];
      kf[0][0] = *(const bf16x8*)(kbase);
      kf[0][1] = *(const bf16x8*)(kbase + 32);
#pragma unroll
      for (int h = 0; h < 8; ++h) {
        const int kc = h >> 1, dh = h & 1;
        if (h < 7) {
          const int kc2 = (h + 1) >> 1, dh2 = (h + 1) & 1;
          kf[(h + 1) & 1][0] = *(const bf16x8*)(kbase + kc2 * 16 * 136 + (dh2 * 2) * 32);
          kf[(h + 1) & 1][1] = *(const bf16x8*)(kbase + kc2 * 16 * 136 + (dh2 * 2 + 1) * 32);
        }
#pragma unroll
        for (int e = 0; e < 2; ++e) {
          const int ds = dh * 2 + e;
          s[kc][0] = __builtin_amdgcn_mfma_f32_16x16x32_bf16(kf[h & 1][e], qf[0][ds], s[kc][0], 0, 0, 0);
          s[kc][1] = __builtin_amdgcn_mfma_f32_16x16x32_bf16(kf[h & 1][e], qf[1][ds], s[kc][1], 0, 0, 0);
        }
        __builtin_amdgcn_sched_barrier(0);
      }
    }
    midfn();
    float mx[2] = {-1e30f, -1e30f};
    if (MODE == 0) {
      const float bias0 = biasfn(it, 0), bias1 = biasfn(it, 1);
      const bool em = ATT_SAFE || emfn(it);
      if (em) {
#pragma unroll
        for (int kc = 0; kc < 4; ++kc)
#pragma unroll
          for (int qs = 0; qs < 2; ++qs)
#pragma unroll
            for (int r = 0; r < 4; ++r) {
              const int kpos = kpos0 + kc * 16 + quad * 4 + r;
              const float x = valid(kpos, qs) ? fmaf(s[kc][qs][r], SCALE2, qs ? bias1 : bias0) : -1e30f;
              s[kc][qs][r] = x;
              mx[qs] = fmaxf(mx[qs], x);
            }
      } else {
        float r0 = -3e38f, r1 = -3e38f;
#pragma unroll
        for (int kc = 0; kc < 4; ++kc)
#pragma unroll
          for (int r = 0; r < 4; ++r) { r0 = fmaxf(r0, s[kc][0][r]); r1 = fmaxf(r1, s[kc][1][r]); }
        mx[0] = fmaf(r0, SCALE2, bias0);
        mx[1] = fmaf(r1, SCALE2, bias1);
      }
      float al[2];
#pragma unroll
      for (int qs = 0; qs < 2; ++qs) {
        float m = mx[qs];
        m = fmaxf(m, __shfl_xor(m, 16));
        m = fmaxf(m, __shfl_xor(m, 32));
        const float mnew = fmaxf(mrow[qs], m);
        al[qs] = __builtin_amdgcn_exp2f(mrow[qs] - mnew);
        mrow[qs] = mnew;
      }
      if (__builtin_amdgcn_ballot_w64(al[0] < 1.f || al[1] < 1.f) != 0ull) {
#pragma unroll
        for (int qs = 0; qs < 2; ++qs) {
          lrow[qs] *= al[qs];
#pragma unroll
          for (int dt = 0; dt < 8; ++dt) o[qs][dt] *= al[qs];
        }
      }
      if (em) {
#pragma unroll
        for (int kc = 0; kc < 4; ++kc)
#pragma unroll
          for (int qs = 0; qs < 2; ++qs)
#pragma unroll
            for (int r = 0; r < 4; ++r) {
              float pv = __builtin_amdgcn_exp2f(s[kc][qs][r] - mrow[qs]);
              if (ATT_SAFE) pv = (s[kc][qs][r] > -1e29f) ? pv : 0.f;
              lrow[qs] += pv;
              s[kc][qs][r] = pv;
            }
      } else {
        const float c0 = bias0 - mrow[0], c1 = bias1 - mrow[1];
#pragma unroll
        for (int kc = 0; kc < 4; ++kc)
#pragma unroll
          for (int qs = 0; qs < 2; ++qs)
#pragma unroll
            for (int r = 0; r < 4; ++r) {
              const float pv = __builtin_amdgcn_exp2f(fmaf(s[kc][qs][r], SCALE2, qs ? c1 : c0));
              lrow[qs] += pv;
              s[kc][qs][r] = pv;
            }
      }
    } else {
#pragma unroll
      for (int kc = 0; kc < 4; ++kc)
#pragma unroll
        for (int qs = 0; qs < 2; ++qs)
#pragma unroll
          for (int r = 0; r < 4; ++r) {
            const int kpos = kpos0 + kc * 16 + quad * 4 + r;
            const float x = valid(kpos, qs) ? s[kc][qs][r] * SCALE2 : -1e30f;
            s[kc][qs][r] = x;
            mx[qs] = fmaxf(mx[qs], x);
          }
      if (MODE == 1) {
#pragma unroll
        for (int qs = 0; qs < 2; ++qs) {
          float m = mx[qs];
          m = fmaxf(m, __shfl_xor(m, 16));
          m = fmaxf(m, __shfl_xor(m, 32));
          const float mnew = fmaxf(mrow[qs], m);
          const float alpha = __builtin_amdgcn_exp2f(mrow[qs] - mnew);
          mrow[qs] = mnew;
          lrow[qs] *= alpha;
        }
      }
#pragma unroll
      for (int kc = 0; kc < 4; ++kc)
#pragma unroll
        for (int qs = 0; qs < 2; ++qs)
#pragma unroll
          for (int r = 0; r < 4; ++r) {
            const float x = s[kc][qs][r];
            float pv = (x > -1e29f) ? __builtin_amdgcn_exp2f(x - mrow[qs]) : 0.f;
            if (MODE == 2) pv *= linv[qs];
            else lrow[qs] += pv;
            s[kc][qs][r] = pv;
          }
    }
    if (MODE == 2) {
#pragma unroll
      for (int kc = 0; kc < 4; ++kc)
#pragma unroll
        for (int qs = 0; qs < 2; ++qs) {
          const int jb = (kpos0 >> 2) + kc * 4 + quad;
          const float a = s[kc][qs][0] + s[kc][qs][1] + s[kc][qs][2] + s[kc][qs][3];
          const float b3 = s[kc][qs][3];
          if (jb < 64) atomicAdd(&imp[(qs * 16 + l15) * 65 + jb], (uint32_t)(a * 67108864.f + 0.5f));
          if (jb + 1 < 64) atomicAdd(&imp[(qs * 16 + l15) * 65 + jb + 1], (uint32_t)(b3 * 67108864.f + 0.5f));
        }
    }
    if (MODE != 1) {
      bf16x8 pb[2][2];
#pragma unroll
      for (int j = 0; j < 2; ++j)
#pragma unroll
        for (int qs = 0; qs < 2; ++qs) {
          union { bf16x8 v; uint32_t u[4]; } cv;
          cv.u[0] = pack2(s[2 * j][qs][0], s[2 * j][qs][1]);
          cv.u[1] = pack2(s[2 * j][qs][2], s[2 * j][qs][3]);
          cv.u[2] = pack2(s[2 * j + 1][qs][0], s[2 * j + 1][qs][1]);
          cv.u[3] = pack2(s[2 * j + 1][qs][2], s[2 * j + 1][qs][3]);
          pb[j][qs] = cv.v;
        }
      const u16* vbase = sV + buf * 64 * 144 + (4 * quad + (l15 >> 2)) * 144 + (l15 & 3) * 4;
      bf16x8 vf[2][4];
#define V_LOAD(DST, G) { _Pragma("unroll") for (int d = 0; d < 4; ++d) { const u16* a0 = vbase + (32 * ((G) >> 1)) * 144 + (((G) & 1) * 4 + d) * 16; \
        s16x4 lo = __builtin_amdgcn_ds_read_tr16_b64_v4i16((__attribute__((address_space(3))) s16x4*)(a0)); \
        s16x4 hi = __builtin_amdgcn_ds_read_tr16_b64_v4i16((__attribute__((address_space(3))) s16x4*)(a0 + 16 * 144)); \
        bf16x8 t; t[0] = lo[0]; t[1] = lo[1]; t[2] = lo[2]; t[3] = lo[3]; t[4] = hi[0]; t[5] = hi[1]; t[6] = hi[2]; t[7] = hi[3]; DST[d] = t; } }
      V_LOAD(vf[0], 0);
#pragma unroll
      for (int g = 0; g < 4; ++g) {
        if (g < 3) V_LOAD(vf[(g + 1) & 1], g + 1);
#pragma unroll
        for (int d = 0; d < 4; ++d) {
          const int dt = (g & 1) * 4 + d;
          o[0][dt] = __builtin_amdgcn_mfma_f32_16x16x32_bf16(vf[g & 1][d], pb[g >> 1][0], o[0][dt], 0, 0, 0);
          o[1][dt] = __builtin_amdgcn_mfma_f32_16x16x32_bf16(vf[g & 1][d], pb[g >> 1][1], o[1][dt], 0, 0, 0);
        }
        __builtin_amdgcn_sched_barrier(0);
      }
#undef V_LOAD
    }
  };
  {
    uint4 rv0[4];
    const u16 *kb_, *vb_; size_t rs_; int kp_;
    tilefn(0, kb_, vb_, rs_, kp_);
#pragma unroll
    for (int i = 0; i < 4; ++i) {
      rk[i] = ldg_o(kb_, (uint32_t)((lr + i * 16) * (int)rs_ + lc) * 2u);
      if (MODE != 1) rv0[i] = ldg_o(vb_, (uint32_t)((lr + i * 16) * (int)rs_ + lc) * 2u);
    }
    K_STORE(0);
    if (MODE != 1) {
#pragma unroll
      for (int i = 0; i < 4; ++i) *(uint4*)(sV + (lr + i * 16) * 144 + lc) = rv0[i];
    }
  }
  __syncthreads();
  for (int it = 0; it < ntiles; ++it) {
    const int buf = it & 1;
    const bool more = (it + 1 < ntiles);
    if (more) K_LOAD(it + 1);
    compute(buf, it, [&]() { if (more) { K_STORE(buf ^ 1); if (MODE != 1) V_LOAD_G(it + 1); } });
    if (more && MODE != 1) V_STORE(buf ^ 1);
    __syncthreads();
  }
#undef K_LOAD
#undef V_LOAD_G
#undef K_STORE
#undef V_STORE
}

__global__ void __launch_bounds__(256, 2) yoco_fwd(Params p) {
  cg::grid_group grid = cg::this_grid();
  __shared__ __attribute__((aligned(16))) u16 smem[40192];
  __shared__ uint4 xb_words;
  if (threadIdx.x == 0) xb_words = make_uint4(0u, 0u, 0u, 0u);
  __syncthreads();
  XcdBarrier xb = xcd_barrier_post((unsigned*)(p.ws + O_BAR), (volatile LAS unsigned*)&xb_words);
  char* ws = p.ws;
  u16* W_AIN = (u16*)(ws + O_WAIN);
  u16* W_GLU = (u16*)(ws + O_WGLU);
  u16* W_AOUT = (u16*)(ws + O_WAOUT);
  u16* W_KV = (u16*)(ws + O_WKV);
  u16* W_C1 = (u16*)(ws + O_WC1);
  u16* W_C2 = (u16*)(ws + O_WC2);
  u16* W_BIN = (u16*)(ws + O_WBIN);
  u16* W_BOUT = (u16*)(ws + O_WBOUT);
  u16* XB = (u16*)(ws + O_XB);
  float* XF = (float*)(ws + O_XF);
  u16* KV = (u16*)(ws + O_KV);
  float* T1P = (float*)(ws + O_T1);
  u16* KCVC = (u16*)(ws + O_KCVC);
  float* C1B = (float*)(ws + O_C1B);
  u16* YB = (u16*)(ws + O_YB);
  float2* STATS = (float2*)(ws + O_STATS);
  u16* UZ = (u16*)(ws + O_UZ);
  u16* GB = (u16*)(ws + O_G);
  u16* VB = (u16*)(ws + O_V);
  float* SB = (float*)(ws + O_S);
  u16* HIN = (u16*)(ws + O_HIN);
  u16* W1 = (u16*)(ws + O_W1);
  u16* W3T = (u16*)(ws + O_W3T);
  u16* KTAB = (u16*)(ws + O_KTAB);
  float2* A64 = (float2*)(ws + O_A64);
  u16* PROJ = (u16*)(ws + O_PROJ);

  float* tl = (float*)smem;
  auto do_jobs = [&](unsigned mask, int b0, int nb) {
      for (int job = 0; job < 15; ++job) {
        if (!((mask >> job) & 1u)) continue;

        const float* src; u16* dst; int K, N, Np;
        switch (job) {
          case 0: src = p.in[1]; dst = W_AIN; K = 2048; N = 2048; Np = 2048; break;
          case 1: src = p.in[1] + (size_t)2048 * 2048; dst = W_AIN + (size_t)2048 * 2048; K = 2048; N = 2048; Np = 2048; break;
          case 2: src = p.in[10]; dst = W_GLU; K = 1024; N = 1024; Np = 1024; break;
          case 3: src = p.in[10] + (size_t)1024 * 1024; dst = W_GLU + (size_t)1024 * 1024; K = 1024; N = 1024; Np = 1024; break;
          case 4: src = p.in[12]; dst = W_AOUT; K = 1024; N = 2048; Np = 2048; break;
          case 5: src = p.in[12] + (size_t)1024 * 2048; dst = W_AOUT + (size_t)2048 * 1024; K = 1024; N = 2048; Np = 2048; break;
          case 6: src = p.in[13]; dst = W_KV; K = 2048; N = 3072; Np = 3072; break;
          case 7: src = p.in[15]; dst = W_C1; K = 4096; N = 128; Np = 128; break;
          case 8: src = p.in[18]; dst = W_C1 + (size_t)128 * 4096; K = 4096; N = 128; Np = 128; break;
          case 9: src = p.in[16]; dst = W_C2; K = 128; N = 128; Np = 128; break;
          case 10: src = p.in[19]; dst = W_C2 + (size_t)128 * 128; K = 128; N = 128; Np = 128; break;
          case 11: src = p.in[20]; dst = W_BIN; K = 2048; N = BIN_N; Np = PROJ_LD; break;
          case 12: src = p.in[20] + (size_t)2048 * BIN_N; dst = W_BIN + (size_t)PROJ_LD * 2048; K = 2048; N = BIN_N; Np = PROJ_LD; break;
          case 13: src = p.in[21]; dst = W_BOUT; K = 2048; N = 2048; Np = 2048; break;
          default: src = p.in[21] + (size_t)2048 * 2048; dst = W_BOUT + (size_t)2048 * 2048; K = 2048; N = 2048; Np = 2048; break;
        }
        if ((int)blockIdx.x >= b0) tconv(tl, src, dst, K, N, Np, b0, nb);
      }
  };
  for (int rep0 = 0; rep0 < REPS_P0; ++rep0) {
    const int tid = tid_l(), lane = tid & 63, wave = tid >> 6; (void)lane; (void)wave;
    do_jobs((1u << 0) | (1u << 2) | (1u << 4) | (1u << 7) | (1u << 8) | (1u << 9) | (1u << 10), 0, (int)gridDim.x);
    {
      const float4* x4 = (const float4*)p.in[0];
      uint2* xb2 = (uint2*)XB;
      const size_t n4 = (size_t)NTOK * DM / 4;
      for (size_t i = (size_t)blockIdx.x * 256 + tid; i < n4; i += (size_t)gridDim.x * 256) {
        float4 v = x4[i];
        uint2 o; o.x = pack2(v.x, v.y); o.y = pack2(v.z, v.w);
        xb2[i] = o;
      }
    }
    {
      float* C1P = (float*)(ws + O_C1P);
      float* red = (float*)smem;
      for (int item = blockIdx.x; item < 64; item += gridDim.x) {
        const int kvs = item >> 5, part = item & 31;
        const float* pos = p.in[kvs ? 17 : 14];
        const float* w1 = p.in[kvs ? 18 : 15];
        const int j = tid & 127, half = tid >> 7;
        const int i0 = part * 128 + half * 64;
        float acc = 0.f;
#pragma unroll 16
        for (int i = 0; i < 64; ++i) acc += pos[i0 + i] * w1[(size_t)(i0 + i) * 128 + j];
        __syncthreads();
        red[tid] = acc;
        __syncthreads();
        if (tid < 128) C1P[(size_t)item * 128 + tid] = red[tid] + red[tid + 128];
        __syncthreads();
      }
    }
    {
      float2* sE = (float2*)smem;
      float2* sCo = sE + 64;
      float2* sM = sCo + 64;
      float2* sC = sM + 1024;
      float2* sBb = sC + 1024;
      const int nper = 4;
      for (int w = blockIdx.x; w < 128 * nper; w += gridDim.x) {
        const int lg = w / nper, j0 = w % nper;
        const float* lam_re = p.in[2] + (size_t)lg * 64;
        const float* lam_im = p.in[3] + (size_t)lg * 64;
        const float dt = __expf(p.in[4][lg]);
        const float* b_re = p.in[5] + (size_t)lg * 1024;
        const float* b_im = p.in[6] + (size_t)lg * 1024;
        const float* c_re = p.in[7] + (size_t)lg * 1024;
        const float* c_im = p.in[8] + (size_t)lg * 1024;
        __syncthreads();
#pragma unroll
        for (int i = 0; i < 4; ++i) sC[tid + i * 256] = make_float2(c_re[tid + i * 256], c_im[tid + i * 256]);
        float lr = 0.f, li = 0.f;
        if (tid < 64) {
          lr = lam_re[tid]; li = lam_im[tid];
          const float mag = expf(lr * dt);
          float sn, cs;
          sincosf(li * dt, &sn, &cs);
          const float ar = mag * cs, ai = mag * sn;
          const float inv = 1.f / (lr * lr + li * li);
          sCo[tid] = make_float2(((ar - 1.f) * lr + ai * li) * inv, (ai * lr - (ar - 1.f) * li) * inv);
        }
        __syncthreads();
#pragma unroll
        for (int i = 0; i < 4; ++i) {
          const int idx = tid + i * 256;
          const float br = b_re[idx], bi = b_im[idx];
          const float2 co = sCo[idx >> 4];
          sBb[idx] = make_float2(co.x * br - co.y * bi, co.x * bi + co.y * br);
        }
        for (int j = j0; j < 65; j += nper) {
          if (tid < 64) {
            const float fj = (float)j;
            const float mj = expf(lr * dt * fj);
            float sj, cj;
            if (j == 64) sincosf(li * dt * fj, &sj, &cj);
            else __sincosf(li * dt * fj, &sj, &cj);
            sE[tid] = make_float2(mj * cj, mj * sj);
            if (j == 64) A64[(size_t)lg * 64 + tid] = make_float2(mj * cj, mj * sj);
          }
          __syncthreads();
#pragma unroll
          for (int i = 0; i < 4; ++i) {
            const int idx = tid + i * 256;
            const int pp = idx >> 4, ci = idx & 15;
            const float2 bb = sBb[idx];
            const float2 e = sE[pp];
            const float mr = e.x * bb.x - e.y * bb.y, mi = e.x * bb.y + e.y * bb.x;
            sM[idx] = make_float2(mr, mi);
            if (j < 64) {
              const int s = 63 - j;
              u16* w1p = W1 + (size_t)lg * 128 * 1024;
              w1p[(size_t)pp * 1024 + s * 16 + ci] = f2bf(mr);
              w1p[(size_t)(64 + pp) * 1024 + s * 16 + ci] = f2bf(mi);
            }
          }
          __syncthreads();
          if (j < 64) {
            const int co = tid >> 4, ci = tid & 15;
            float acc = 0.f;
            for (int pp = 0; pp < 64; ++pp) {
              const float2 m = sM[pp * 16 + ci];
              const float2 c = sC[co * 64 + pp];
              acc += c.x * m.x - c.y * m.y;
            }
            KTAB[(((size_t)lg * 64 + j) * 16 + co) * 16 + ci] = f2bf(acc);
          }
          if (j >= 1) {
            const int t = j - 1;
            u16* w3p = W3T + (size_t)lg * 1024 * 128;
#pragma unroll
            for (int i = 0; i < 4; ++i) {
              const int idx = tid + i * 256;
              const int co = idx >> 6, pp = idx & 63;
              const float cr = sC[idx].x, ci = sC[idx].y;
              const float2 e = sE[pp];
              const float re = cr * e.x - ci * e.y, im = cr * e.y + ci * e.x;
              w3p[(size_t)(t * 16 + co) * 128 + pp] = f2bf(re);
              w3p[(size_t)(t * 16 + co) * 128 + 64 + pp] = f2bf(-im);
            }
          }
          __syncthreads();
        }
      }
    }
  }
  grid.sync();

  auto kmap64 = [](int ks) { return ks * 64; };

  for (int l = 0; l < 2; ++l) {
    const float* xres = (l == 0) ? p.in[0] : XF;
    {
      const int tid = tid_l(), lane = tid & 63, wave = tid >> 6; (void)lane; (void)wave;
      if (l == 0 && blockIdx.x == 0) {
        const float* C1P = (const float*)(ws + O_C1P);
        float a = 0.f;
        for (int part = 0; part < 32; ++part) a += C1P[((size_t)(tid >> 7) * 32 + part) * 128 + (tid & 127)];
        C1B[tid] = a;
      }
      const u16* Wt = W_AIN + (size_t)l * 2048 * 2048;
      for (int tile = blockIdx.x; tile < 64 * 8; tile += gridDim.x) {
        const int mt = tile & 63, nt = tile >> 6;
        gemm_tile_w(smem, mt * 128, nt * 256, 64,
                  [=](int m, int k0, int kc) { return ldg_o(XB + k0, (uint32_t)(m * 2048 + kc) * 2u); },
                  [=](int n, int k0, int kc) { return ldg_o(Wt + k0, (uint32_t)(n * 2048 + kc) * 2u); },
                  [=](int m, int n, f32x4 v) { st_bf4(UZ + (size_t)m * 2048 + n, v); });
      }
    }
    xcd_barrier(xb);
    {
      float* sS = (float*)smem;
      if (l == 0) do_jobs((1u << 1) | (1u << 3) | (1u << 5) | (1u << 6) | (1u << 11), 64, (int)gridDim.x - 64);
      else do_jobs((1u << 12), 64, (int)gridDim.x - 64);
      for (int g = blockIdx.x; g < 64; g += gridDim.x) {
        const u16* w1p = W1 + ((size_t)l * 64 + g) * 128 * 1024;
        gemm_tile<1, false>(smem, 0, 0, 16, kmap64,
                  [=](int m, int k0, int kc) { return ldg_o(UZ + (size_t)(k0 >> 4) * 2048 + g * 16, (uint32_t)((m * 64 + (kc >> 4)) * 2048 + (kc & 15)) * 2u); },
                  [=](int n, int k0, int kc) { return ldg_o(w1p + k0, (uint32_t)(n * 1024 + kc) * 2u); },
                  [=](int m, int n, f32x4 v) { *(f32x4*)(sS + m * 132 + n) = v; });
        __syncthreads();
        const int tid = tid_l();
        if (tid < 128) {
          const int b = tid >> 6, pp = tid & 63;
          const float2 a = A64[((size_t)l * 64 + g) * 64 + pp];
          float hr = 0.f, hi = 0.f;
          const float* sp = sS + (b * 64) * 132;
          u16* hp = HIN + ((size_t)g * 128 + b * 64) * 128;
#pragma unroll 4
          for (int c = 0; c < 64; ++c) {
            hp[c * 128 + pp] = f2bf(hr);
            hp[c * 128 + 64 + pp] = f2bf(hi);
            const float sr = sp[c * 132 + pp], si = sp[c * 132 + 64 + pp];
            const float nr = a.x * hr - a.y * hi + sr;
            const float ni = a.x * hi + a.y * hr + si;
            hr = nr; hi = ni;
          }
        }
        __syncthreads();
      }
    }
    xcd_barrier(xb);
    {
      const float* dsk = p.in[9] + (size_t)l * 1024;
      for (int tile = blockIdx.x; tile < 64 * 8; tile += gridDim.x) {
        const int g = tile >> 3, nt = (tile < 256) ? 7 - (tile & 7) : (tile & 7);
        const int nks1 = 2 * nt + 2;
        const u16* ktab = KTAB + ((size_t)l * 64 + g) * 64 * 256;
        const u16* w3p = W3T + ((size_t)l * 64 + g) * 1024 * 128;
        const u16* hp = HIN + (size_t)g * 128 * 128;
        gemm_tile(smem, 0, nt * 128, nks1 + 2,
                  [=](int ks) { return ks < nks1 ? ks * 64 : 1024 + (ks - nks1) * 64; },
                  [=](int m, int k0, int kc) {
                    if (k0 < 1024) return ldg_o(UZ + (size_t)(k0 >> 4) * 2048 + g * 16, (uint32_t)((m * 64 + (kc >> 4)) * 2048 + (kc & 15)) * 2u);
                    return ldg_o(hp + (k0 - 1024), (uint32_t)(m * 128 + kc) * 2u);
                  },
                  [=](int n, int k0, int kc) {
                    if (k0 < 1024) {
                      const int lag = (n >> 4) - (kc >> 4) - (k0 >> 4);
                      if (lag < 0) return make_uint4(0u, 0u, 0u, 0u);
                      return ldg_o(ktab, (uint32_t)((lag * 16 + (n & 15)) * 16 + (kc & 15)) * 2u);
                    }
                    return ldg_o(w3p + (k0 - 1024), (uint32_t)(n * 128 + kc) * 2u);
                  },
                  [=](int m, int n, f32x4 v) {
                    const int t = n >> 4, co = n & 15;
                    const size_t tok = (size_t)m * 64 + t;
                    const int ch = g * 16 + co;
                    const f32x4 u = ld_bf4(UZ + tok * 2048 + ch);
                    const f32x4 d = *(const f32x4*)(dsk + ch);
                    f32x4 r;
#pragma unroll
                    for (int i = 0; i < 4; ++i) r[i] = gelu_tanh(v[i] + d[i] * u[i]);
                    st_bf4(GB + tok * 1024 + ch, r);
                  });
      }
    }
    xcd_barrier(xb);
    {
      const u16* Wt = W_GLU + (size_t)l * 1024 * 1024;
      const float* bg = p.in[11] + (size_t)l * 1024;
      for (int tile = blockIdx.x; tile < 64 * 8; tile += gridDim.x) {
        const int mt = tile & 63, nt = tile >> 6;
        gemm_tile(smem, mt * 128, nt * 128, 16, kmap64,
                  [=](int m, int k0, int kc) { return ldg_o(GB + k0, (uint32_t)(m * 1024 + kc) * 2u); },
                  [=](int n, int k0, int kc) { return ldg_o(Wt + k0, (uint32_t)(n * 1024 + kc) * 2u); },
                  [=](int m, int n, f32x4 v) {
                    const f32x4 gg = ld_bf4(GB + (size_t)m * 1024 + n);
                    const f32x4 zz = ld_bf4(UZ + (size_t)m * 2048 + 1024 + n);
                    const f32x4 bb = *(const f32x4*)(bg + n);
                    f32x4 r;
#pragma unroll
                    for (int i = 0; i < 4; ++i) r[i] = gg[i] * sigm(v[i] + bb[i]) * silu(zz[i]);
                    st_bf4(VB + (size_t)m * 1024 + n, r);
                  });
      }
    }
    xcd_barrier(xb);
    {
      const u16* Wt = W_AOUT + (size_t)l * 2048 * 1024;
      for (int tile = blockIdx.x; tile < 64 * 8; tile += gridDim.x) {
        const int mt = tile & 63, nt = tile >> 6;
        const float2* stp = STATS;
        const float* pgam = p.in[22] + (size_t)(l > 0 ? l - 1 : 0) * 2048;
        const float* pbet = p.in[23] + (size_t)(l > 0 ? l - 1 : 0) * 2048;
        gemm_tile_w<true>(smem, mt * 128, nt * 256, 32,
                  [=](int m, int k0, int kc) { return ldg_o(VB + k0, (uint32_t)(m * 1024 + kc) * 2u); },
                  [=](int n, int k0, int kc) { return ldg_o(Wt + k0, (uint32_t)(n * 1024 + kc) * 2u); },
                  [=](int m, int n, f32x4 v, f32x4 xr) {
                    if (l > 0) {
                      const float2 st = stp[m];
                      const f32x4 gg = *(const f32x4*)(pgam + n);
                      const f32x4 bb = *(const f32x4*)(pbet + n);
#pragma unroll
                      for (int i = 0; i < 4; ++i) xr[i] = (xr[i] - st.x) * st.y * gg[i] + bb[i];
                    }
                    f32x4 r;
#pragma unroll
                    for (int i = 0; i < 4; ++i) r[i] = DN_ALPHA * xr[i] + v[i];
                    *(f32x4*)((char*)XF + (uint32_t)(m * 2048 + n) * 4u) = r;
                  },
                  [=](int m, int n) { return *(const f32x4*)((const char*)xres + (uint32_t)(m * 2048 + n) * 4u); });
      }
    }
    xcd_barrier(xb);
    {
      const int tid = tid_l(), lane = tid & 63, wave = tid >> 6; (void)lane; (void)wave;
      const float* lg_ = p.in[22] + (size_t)l * 2048;
      const float* lb_ = p.in[23] + (size_t)l * 2048;
      for (int row = blockIdx.x * 4 + wave; row < NTOK; row += gridDim.x * 4) {
        float* xr = XF + (size_t)row * 2048;
        f32x4 v[8];
        float sum = 0.f;
#pragma unroll
        for (int i = 0; i < 8; ++i) { v[i] = *(const f32x4*)(xr + i * 256 + lane * 4); sum += v[i][0] + v[i][1] + v[i][2] + v[i][3]; }
#pragma unroll
        for (int o = 32; o >= 1; o >>= 1) sum += __shfl_xor(sum, o);
        const float mu = sum * (1.f / 2048.f);
        float sq = 0.f;
#pragma unroll
        for (int i = 0; i < 8; ++i)
#pragma unroll
          for (int e = 0; e < 4; ++e) { const float d = v[i][e] - mu; sq += d * d; }
#pragma unroll
        for (int o = 32; o >= 1; o >>= 1) sq += __shfl_xor(sq, o);
        const float rstd = rsqrtf(sq * (1.f / 2048.f) + LN_EPS);
#pragma unroll
        for (int i = 0; i < 8; ++i) {
          const int c = i * 256 + lane * 4;
          const f32x4 gg = *(const f32x4*)(lg_ + c);
          const f32x4 bb = *(const f32x4*)(lb_ + c);
          f32x4 r;
#pragma unroll
          for (int e = 0; e < 4; ++e) r[e] = (v[i][e] - mu) * rstd * gg[e] + bb[e];
          st_bf4(XB + (size_t)row * 2048 + c, r);
        }
        if (lane == 0) STATS[row] = make_float2(mu, rstd);
      }
    }
    xcd_barrier(xb);
  }

  {
    for (int tile = blockIdx.x; tile < 64 * 24; tile += gridDim.x) {
      const int mt = tile & 63, nt = tile >> 6;
      gemm_tile(smem, mt * 128, nt * 128, 32, kmap64,
                [=](int m, int k0, int kc) { return ldg_o(XB + k0, (uint32_t)(m * 2048 + kc) * 2u); },
                [=](int n, int k0, int kc) { return ldg_o(W_KV + k0, (uint32_t)(n * 2048 + kc) * 2u); },
                [=](int m, int n, f32x4 v) { st_bf4(KV + (size_t)m * KV_LD + n, v); });
    }
  }
  xcd_barrier(xb);
  for (int lb = 0; lb < 2; ++lb) {
    const int layer = 2 + lb;
    {
      const u16* Wt = W_BIN + (size_t)lb * PROJ_LD * 2048;
      if (lb == 0 && blockIdx.x >= 64 && blockIdx.x < 128) {
        const int ct = blockIdx.x - 64;
        const int half = ct >> 5, kvs = (ct >> 4) & 1, mt = ct & 15;
        const u16* Wc = W_C1 + (size_t)kvs * 128 * 4096;
        float* t1 = T1P + ((size_t)(half * 2 + kvs)) * 2048 * 128;
        gemm_tile<1>(smem, mt * 128, 0, 32, [=](int ks) { return half * 2048 + ks * 64; },
                  [=](int m, int k0, int kc) {
                    const int b = m >> 10, n = (m >> 2) & 255, g = m & 3;
                    int tok = n * 16 + (k0 >> 7);
                    tok = tok > 4095 ? 4095 : tok;
                    return ldg_o(KV + kvs * 512 + (k0 & 127), (uint32_t)((b * 4096 + tok) * KV_LD + g * 128 + kc) * 2u);
                  },
                  [=](int n, int k0, int kc) { return ldg_o(Wc + k0, (uint32_t)(n * 4096 + kc) * 2u); },
                  [=](int m, int n, f32x4 v) { *(f32x4*)(t1 + (size_t)m * 128 + n) = v; });
      }
      for (int rep = 0; rep < REPS_BIN; ++rep)
      for (int tile = blockIdx.x; tile < 64 * 32; tile += gridDim.x) {
        const int mt = tile & 63, nt = tile >> 6;
        gemm_tile_w(smem, mt * 128, nt * 256, 64,
                  [=](int m, int k0, int kc) { return ldg_o(XB + k0, (uint32_t)(m * 2048 + kc) * 2u); },
                  [=](int n, int k0, int kc) { return ldg_o(Wt + k0, (uint32_t)(n * 2048 + kc) * 2u); },
                  [=](int m, int n, f32x4 v) { st_bf4(PROJ + (size_t)m * PROJ_LD + n, v); });
      }
      for (int tile = blockIdx.x; tile < 64; tile += gridDim.x) {
        const int mt = tile & 63, nt = 64;
        gemm_tile(smem, mt * 128, nt * 128, 32, kmap64,
                  [=](int m, int k0, int kc) { return ldg_o(XB + k0, (uint32_t)(m * 2048 + kc) * 2u); },
                  [=](int n, int k0, int kc) { return ldg_o(Wt + k0, (uint32_t)(n * 2048 + kc) * 2u); },
                  [=](int m, int n, f32x4 v) { st_bf4(PROJ + (size_t)m * PROJ_LD + n, v); });
      }
    }
    xcd_barrier(xb);
    if (lb == 0) {
      do_jobs((1u << 13) | (1u << 14), 32, (int)gridDim.x - 32);
      for (int tile = blockIdx.x; tile < 32; tile += gridDim.x) {
        const int kvs = tile >> 4, mt = tile & 15;
        const u16* Wt = W_C2 + (size_t)kvs * 128 * 128;
        const float* t1a = T1P + ((size_t)kvs) * 2048 * 128;
        const float* t1b = T1P + ((size_t)(2 + kvs)) * 2048 * 128;
        const float* cb = C1B + kvs * 128;
        u16* kc_ = KCVC + (size_t)kvs * 2048 * 128;
        gemm_tile<1>(smem, mt * 128, 0, 2, kmap64,
                  [=](int m, int k0, int kc) {
                    const int k = k0 + kc;
                    const f32x4 a0 = *(const f32x4*)(t1a + (size_t)m * 128 + k), a1 = *(const f32x4*)(t1a + (size_t)m * 128 + k + 4);
                    const f32x4 b0 = *(const f32x4*)(t1b + (size_t)m * 128 + k), b1 = *(const f32x4*)(t1b + (size_t)m * 128 + k + 4);
                    const f32x4 c0 = *(const f32x4*)(cb + k), c1 = *(const f32x4*)(cb + k + 4);
                    uint4 r;
                    r.x = pack2(gelu_tanh(a0[0] + b0[0] + c0[0]), gelu_tanh(a0[1] + b0[1] + c0[1]));
                    r.y = pack2(gelu_tanh(a0[2] + b0[2] + c0[2]), gelu_tanh(a0[3] + b0[3] + c0[3]));
                    r.z = pack2(gelu_tanh(a1[0] + b1[0] + c1[0]), gelu_tanh(a1[1] + b1[1] + c1[1]));
                    r.w = pack2(gelu_tanh(a1[2] + b1[2] + c1[2]), gelu_tanh(a1[3] + b1[3] + c1[3]));
                    return r;
                  },
                  [=](int n, int k0, int kc) { return ldg_o(Wt + k0, (uint32_t)(n * 128 + kc) * 2u); },
                  [=](int m, int n, f32x4 v) {
                    if (((m >> 2) & 255) == 255) v = f32x4{0.f, 0.f, 0.f, 0.f};
                    st_bf4(kc_ + (size_t)m * 128 + n, v);
                  });
      }
      xcd_barrier(xb);
    }
#ifndef NO_ATTN
    {
      u16* sK = smem;
      u16* sV = smem + 2 * 64 * 136;
      uint32_t* imp = (uint32_t*)(smem + 2 * 64 * 136 + 2 * 64 * 144);
      unsigned long long* selm = (unsigned long long*)(imp + 32 * 65);
      const int tid = tid_l(), lane = tid & 63, wave = tid >> 6;
      const int l15 = lane & 15, quad = lane >> 4;
      const u16* KC = KCVC;
      const u16* VC = KCVC + (size_t)2048 * 128;
      for (int rep = 0; rep < REPS_ATTN; ++rep)
      for (int item = blockIdx.x; item < 1024; item += gridDim.x) {
        const int qt = (item < 512) ? (127 - (item >> 3)) : ((item - 512) >> 3);
        const int bg = item & 7, b = bg >> 2, g = bg & 3;
        const int t0 = qt * 32, h = g * 4 + wave;
        const size_t tokbase = (size_t)b * SEQ;
        const int cur = t0 >> 6;
        if (DESYNC_COND) __builtin_amdgcn_s_sleep(60);
        for (int i = tid; i < 32 * 65; i += 256) imp[i] = 0u;
        bf16x8 qf[2][4];
#pragma unroll
        for (int qs = 0; qs < 2; ++qs)
#pragma unroll
          for (int ds = 0; ds < 4; ++ds) {
            uint4 v = ldg16(PROJ + (tokbase + t0 + qs * 16 + l15) * PROJ_LD + h * 128 + ds * 32 + quad * 8);
            union { uint4 u; bf16x8 v; } cv; cv.u = v; qf[qs][ds] = cv.v;
          }
        const int tq0 = t0 + l15, tq1 = t0 + 16 + l15;
        f32x4 o[2][8];
        float mrow[2], lrow[2], linv[2];
        auto zero_o = [&]() {
#pragma unroll
          for (int qs = 0; qs < 2; ++qs)
#pragma unroll
            for (int dt = 0; dt < 8; ++dt) o[qs][dt] = f32x4{0.f, 0.f, 0.f, 0.f};
        };
        auto finish_l = [&]() {
#pragma unroll
          for (int qs = 0; qs < 2; ++qs) {
            float lsum = lrow[qs];
            lsum += __shfl_xor(lsum, 16);
            lsum += __shfl_xor(lsum, 32);
            linv[qs] = 1.f / fmaxf(lsum, 1e-30f);
          }
        };
        auto emit = [&](int br, bool first, bool scale_l) {
          float* wbuf = (float*)smem + wave * (16 * 132);
          const int rrow = lane >> 5, rcol = (lane & 31) * 4;
          const int tb = (int)tokbase + t0;
          const uint32_t zoff0 = (uint32_t)((tb + rrow) * PROJ_LD + 2048 + br * 2048 + h * 128 + rcol) * 2u;
          const uint32_t yoff0 = (uint32_t)((tb + rrow) * 2048 + h * 128 + rcol) * 2u;
          const u16 graw0 = *(const u16*)((const char*)PROJ + (uint32_t)((tb + l15) * PROJ_LD + 8192 + br * 16 + h) * 2u);
          const u16 graw1 = *(const u16*)((const char*)PROJ + (uint32_t)((tb + 16 + l15) * PROJ_LD + 8192 + br * 16 + h) * 2u);
#pragma unroll
          for (int qs = 0; qs < 2; ++qs) {
            const float gate = sigm(bf2f(qs ? graw1 : graw0));
            const float sc = scale_l ? gate * linv[qs] : gate;
#pragma unroll
            for (int dt = 0; dt < 8; ++dt) *(f32x4*)(wbuf + l15 * 132 + dt * 16 + quad * 4) = o[qs][dt] * sc;
            __builtin_amdgcn_wave_barrier();
#pragma unroll 4
            for (int j = 0; j < 8; ++j) {
              const uint32_t zo = zoff0 + (uint32_t)((qs * 16 + j * 2) * PROJ_LD) * 2u;
              const uint32_t yo = yoff0 + (uint32_t)((qs * 16 + j * 2) * 2048) * 2u;
              const f32x4 a = *(const f32x4*)(wbuf + (j * 2 + rrow) * 132 + rcol);
              const f32x4 zz = ld_bf4((const u16*)((const char*)PROJ + zo));
              u16* yp = (u16*)((char*)YB + yo);
              f32x4 r;
#pragma unroll
              for (int e = 0; e < 4; ++e) r[e] = a[e] * silu(zz[e]);
              if (!first) {
                const f32x4 old = ld_bf4(yp);
#pragma unroll
                for (int e = 0; e < 4; ++e) r[e] += old[e];
              }
              st_bf4(yp, r);
            }
          }
          __syncthreads();
        };
#ifndef NO_CMP
        {
          int nmax = t0 >> 4; if (nmax > 254) nmax = 254;
          const int ntl = (nmax >> 6) + 1;
          auto tilefn = [&](int i, const u16*& kb, const u16*& vb, size_t& rs, int& kp) {
            const size_t off = (((size_t)b * 256 + i * 64) * 4 + g) * 128;
            kb = KC + off; vb = VC + off; rs = 512; kp = i * 64;
          };
          auto valid = [&](int kpos, int qs) { return kpos * 16 + 31 <= (qs ? tq1 : tq0); };
          mrow[0] = mrow[1] = -1e30f; lrow[0] = lrow[1] = 0.f; linv[0] = linv[1] = 1.f;
          auto nobias = [](int, int) { return 0.f; };
          auto allem = [](int) { return true; };
          attn_loop<1>(sK, sV, imp, ntl, tilefn, nobias, allem, valid, qf, o, mrow, lrow, linv);
          finish_l();
          zero_o();
          attn_loop<2>(sK, sV, imp, ntl, tilefn, nobias, allem, valid, qf, o, mrow, lrow, linv);
          emit(0, true, false);
        }
#endif
        {
#pragma unroll 1
          for (int tt = 0; tt < 8; ++tt) {
            const int tok = wave * 8 + tt;
            unsigned long long mask;
            if (cur < 16) {
              mask = (2ull << cur) - 1ull;
            } else {
              const uint32_t v = imp[tok * 65 + lane];
              const bool cand = (lane >= 1) && (lane <= cur - 2);
              const unsigned long long cm = __ballot(cand);
              uint32_t T = 0u;
#pragma unroll 1
              for (int bit = 30; bit >= 0; --bit) {
                const uint32_t tr = T | (1u << bit);
                const unsigned long long m = __ballot(v >= tr) & cm;
                if (__popcll(m) >= 13) T = tr;
              }
              const unsigned long long gt = __ballot(v > T) & cm;
              unsigned long long eq = __ballot(v == T) & cm;
              int need = 13 - (int)__popcll(gt);
              unsigned long long pick = 0ull;
              while (need > 0 && eq != 0ull) {
                const unsigned long long low = eq & (0ull - eq);
                pick |= low; eq ^= low; --need;
              }
              mask = gt | pick | 1ull | (1ull << cur) | (1ull << (cur - 1));
            }
            if (lane == 0) selm[tok] = mask;
          }
          __syncthreads();
        }
        const unsigned long long sm0 = selm[l15], sm1 = selm[16 + l15];
#ifndef NO_SEL
        {
          auto tilefn = [&](int i, const u16*& kb, const u16*& vb, size_t& rs, int& kp) {
            const size_t off = (tokbase + (size_t)i * 64) * KV_LD + 1024 + g * 128;
            kb = KV + off; vb = KV + off + 512; rs = KV_LD; kp = i * 64;
          };
          auto valid = [&](int kpos, int qs) { return kpos <= (qs ? tq1 : tq0); };
          auto biasfn = [&](int i, int qs) { return (((qs ? sm1 : sm0) >> i) & 1ull) ? 0.f : -1e30f; };
          auto emfn = [&](int i) { return i == cur; };
          mrow[0] = mrow[1] = -1e30f; lrow[0] = lrow[1] = 0.f;
          zero_o();
          attn_loop<0>(sK, sV, imp, cur + 1, tilefn, biasfn, emfn, valid, qf, o, mrow, lrow, linv);
          finish_l();
          emit(1, false, true);
        }
#endif
#ifndef NO_WIN
        {
          int jt0 = (t0 - 511) >> 6; if (jt0 < 0) jt0 = 0;
          auto tilefn = [&](int i, const u16*& kb, const u16*& vb, size_t& rs, int& kp) {
            const size_t off = (tokbase + (size_t)(jt0 + i) * 64) * KV_LD + 2048 + g * 128;
            kb = KV + off; vb = KV + off + 512; rs = KV_LD; kp = (jt0 + i) * 64;
          };
          auto valid = [&](int kpos, int qs) {
            const int t = qs ? tq1 : tq0;
            return (kpos <= t) && (kpos > t - 512);
          };
          auto biasfn = [](int, int) { return 0.f; };
          auto emfn = [&](int i) { const int kp = (jt0 + i) * 64; return !((kp + 63 <= t0) && (kp > t0 + 31 - 512)); };
          mrow[0] = mrow[1] = -1e30f; lrow[0] = lrow[1] = 0.f;
          zero_o();
          attn_loop<0>(sK, sV, imp, cur - jt0 + 1, tilefn, biasfn, emfn, valid, qf, o, mrow, lrow, linv);
          finish_l();
          emit(2, false, true);
        }
#endif
        __syncthreads();
      }
    }
#endif
    xcd_barrier(xb);
    {
      const u16* Wt = W_BOUT + (size_t)lb * 2048 * 2048;
      for (int tile = blockIdx.x; tile < 64 * 8; tile += gridDim.x) {
        const int mt = tile & 63, nt = tile >> 6;
        const float2* stp = STATS;
        const float* pgam = p.in[22] + (size_t)(layer - 1) * 2048;
        const float* pbet = p.in[23] + (size_t)(layer - 1) * 2048;
        gemm_tile_w<true>(smem, mt * 128, nt * 256, 64,
                  [=](int m, int k0, int kc) { return ldg_o(YB + k0, (uint32_t)(m * 2048 + kc) * 2u); },
                  [=](int n, int k0, int kc) { return ldg_o(Wt + k0, (uint32_t)(n * 2048 + kc) * 2u); },
                  [=](int m, int n, f32x4 v, f32x4 xr) {
                    const float2 st = stp[m];
                    const f32x4 gg = *(const f32x4*)(pgam + n);
                    const f32x4 bb = *(const f32x4*)(pbet + n);
                    f32x4 r;
#pragma unroll
                    for (int i = 0; i < 4; ++i) r[i] = DN_ALPHA * ((xr[i] - st.x) * st.y * gg[i] + bb[i]) + v[i];
                    *(f32x4*)((char*)XF + (uint32_t)(m * 2048 + n) * 4u) = r;
                  },
                  [=](int m, int n) { return *(const f32x4*)((const char*)XF + (uint32_t)(m * 2048 + n) * 4u); });
      }
    }
    xcd_barrier(xb);
    {
      const int tid = tid_l(), lane = tid & 63, wave = tid >> 6; (void)lane; (void)wave;
      const float* lg_ = p.in[22] + (size_t)layer * 2048;
      const float* lb_ = p.in[23] + (size_t)layer * 2048;
      const bool last = (lb == 1);
      for (int row = blockIdx.x * 4 + wave; row < NTOK; row += gridDim.x * 4) {
        float* xr = XF + (size_t)row * 2048;
        float* orow = last ? (p.out + (size_t)row * 2048) : xr;
        f32x4 v[8];
        float sum = 0.f;
#pragma unroll
        for (int i = 0; i < 8; ++i) { v[i] = *(const f32x4*)(xr + i * 256 + lane * 4); sum += v[i][0] + v[i][1] + v[i][2] + v[i][3]; }
#pragma unroll
        for (int o = 32; o >= 1; o >>= 1) sum += __shfl_xor(sum, o);
        const float mu = sum * (1.f / 2048.f);
        float sq = 0.f;
#pragma unroll
        for (int i = 0; i < 8; ++i)
#pragma unroll
          for (int e = 0; e < 4; ++e) { const float d = v[i][e] - mu; sq += d * d; }
#pragma unroll
        for (int o = 32; o >= 1; o >>= 1) sq += __shfl_xor(sq, o);
        const float rstd = rsqrtf(sq * (1.f / 2048.f) + LN_EPS);
#pragma unroll
        for (int i = 0; i < 8; ++i) {
          const int c = i * 256 + lane * 4;
          const f32x4 gg = *(const f32x4*)(lg_ + c);
          const f32x4 bb = *(const f32x4*)(lb_ + c);
          f32x4 r;
#pragma unroll
          for (int e = 0; e < 4; ++e) r[e] = (v[i][e] - mu) * rstd * gg[e] + bb[e];
          if (last) *(f32x4*)(orow + c) = r;
          else st_bf4(XB + (size_t)row * 2048 + c, r);
        }
        if (!last && lane == 0) STATS[row] = make_float2(mu, rstd);
      }
    }
    if (lb == 0) xcd_barrier(xb);
  }
}

extern "C" void kernel_launch(void* const* d_in, const int* in_sizes, int n_in, void* d_out, int out_size, void* d_ws,
                              size_t ws_size, hipStream_t stream) {
  static int grid_blocks = 0;
  if (!grid_blocks) {
    int dev = 0, cus = 0, per_cu = 0;
    hipGetDevice(&dev);
    hipDeviceGetAttribute(&cus, hipDeviceAttributeMultiprocessorCount, dev);
    hipOccupancyMaxActiveBlocksPerMultiprocessor(&per_cu, yoco_fwd, 256, 0);
    if (per_cu > 2) per_cu = 2;
    if (per_cu < 1) per_cu = 1;
    grid_blocks = cus * per_cu;
  }
  Params p{};
  for (int i = 0; i < 24; ++i) p.in[i] = (const float*)d_in[i];
  p.out = (float*)d_out;
  p.ws = (char*)d_ws;
  if (ws_size < WS_TOTAL) fprintf(stderr, "workspace too small: %zu < %zu\n", ws_size, (size_t)WS_TOTAL);
  (void)hipMemsetAsync((char*)d_ws + O_BAR, 0, XCD_BAR_WORDS * 4, stream);
  void* args[] = {&p};
  hipError_t e = hipLaunchCooperativeKernel((void*)yoco_fwd, dim3(grid_blocks), dim3(256), args, 0, stream);
  if (e != hipSuccess) fprintf(stderr, "cooperative launch failed: %s (grid %d)\n", hipGetErrorString(e), grid_blocks);
}
```
